# Optimizing an MI355X kernel written in HIP

```python
import math
import jax, jax.numpy as jnp
from jax import lax
import numpy as np

D_MODEL = 2048
BATCH = 4
SEQ = 4096
DEPTH = 2

CHUNK = 64
QBLK = 128
N_MIXERS = 2
N_LAYERS_A = (DEPTH + 1) // 2
N_LAYERS_B = DEPTH // 2
A_HEADS = 16
A_HEAD_DIM = D_MODEL // A_HEADS
B_HEADS = 16
B_HEAD_DIM = 128
B_V_DIM = 128
Q_LATENT = D_MODEL // 4
KV_LATENT = D_MODEL // 8
IDX_HEADS = 16
IDX_DIM = 64
IDX_TOPK = 256
REL_BUCKETS = 32
REL_MAX_DIST = 128
N_EXPERTS = 64
TOP_K = 8
D_EXPERT = 512
D_SHARED = 512
ROUTED_SCALE = 2.5
EXPERT_BLOCK = 128
DEEPNORM_ALPHA = (2 * DEPTH) ** 0.25
DEEPNORM_BETA = (8 * DEPTH) ** -0.25
LN_EPS = 1e-5
RMS_EPS = 1e-6

kernel_name = "fox_dsa_moe_deepnorm_hybrid"


def layer_norm(x, g, b):
    xf = x.astype(jnp.float32)
    mu = jnp.mean(xf, axis=-1, keepdims=True)
    var = jnp.mean(jnp.square(xf - mu), axis=-1, keepdims=True)
    return ((xf - mu) * lax.rsqrt(var + LN_EPS) * g.astype(jnp.float32) + b.astype(jnp.float32)).astype(x.dtype)


def rms_norm(x, g):
    xf = x.astype(jnp.float32)
    ms = jnp.mean(jnp.square(xf), axis=-1, keepdims=True)
    return (xf * lax.rsqrt(ms + RMS_EPS) * g.astype(jnp.float32)).astype(x.dtype)


def t5_bucket(rel):
    half = REL_BUCKETS // 2
    max_exact = half // 2
    n = jnp.abs(rel)
    large = max_exact + (jnp.log(jnp.maximum(n, 1).astype(jnp.float32) / max_exact)
                         / math.log(REL_MAX_DIST / max_exact) * (half - max_exact)).astype(jnp.int32)
    large = jnp.minimum(large, half - 1)
    return jnp.where(rel > 0, half, 0) + jnp.where(n < max_exact, n, large)


def forgetting_attention(h, w_in, b_f, w_out):
    Bn, S, _ = h.shape
    dA = A_HEADS * A_HEAD_DIM
    proj = h @ w_in
    q = proj[..., :dA].reshape(Bn, S, A_HEADS, A_HEAD_DIM)
    k = proj[..., dA:2 * dA].reshape(Bn, S, A_HEADS, A_HEAD_DIM)
    v = proj[..., 2 * dA:3 * dA].reshape(Bn, S, A_HEADS, A_HEAD_DIM)
    logf = jax.nn.log_sigmoid((proj[..., 3 * dA:] + b_f).astype(jnp.float32))
    F = jnp.cumsum(logf, axis=1)
    F_k = jnp.transpose(F, (0, 2, 1))[:, :, None, :]
    nblk = S // QBLK
    q_blocks = jnp.swapaxes(q.reshape(Bn, nblk, QBLK, A_HEADS, A_HEAD_DIM), 0, 1)
    F_blocks = jnp.swapaxes(F.reshape(Bn, nblk, QBLK, A_HEADS), 0, 1)
    kpos = jnp.arange(S, dtype=jnp.int32)
    scale = A_HEAD_DIM ** -0.5

    def block(args):
        q_blk, F_blk, i = args
        qpos = i * QBLK + jnp.arange(QBLK, dtype=jnp.int32)
        logits = jnp.einsum('bqhd,bshd->bhqs', q_blk, k).astype(jnp.float32) * scale
        logits = logits + jnp.transpose(F_blk, (0, 2, 1))[..., None] - F_k
        logits = jnp.where((kpos[None, :] <= qpos[:, None])[None, None], logits, -jnp.inf)
        p = jax.nn.softmax(logits, axis=-1).astype(v.dtype)
        return jnp.einsum('bhqs,bshd->bqhd', p, v).reshape(Bn, QBLK, dA)

    o = lax.map(block, (q_blocks, F_blocks, jnp.arange(nblk, dtype=jnp.int32)))
    o = jnp.swapaxes(o, 0, 1).reshape(Bn, S, dA)
    return o @ w_out


def indexed_sparse_attention(h, w_in, q_norm, kv_norm, w_uq, w_iq, w_uk, w_uv, w_out, rel_bias):
    Bn, S, _ = h.shape
    topk = min(IDX_TOPK, S // 4)
    proj = h @ w_in
    o1 = Q_LATENT
    o2 = o1 + KV_LATENT
    o3 = o2 + IDX_DIM
    c_q = rms_norm(proj[..., :o1], q_norm)
    c_kv = rms_norm(proj[..., o1:o2], kv_norm)
    k_idx = proj[..., o2:o3]
    w_idx = proj[..., o3:] * (IDX_HEADS ** -0.5)
    q = (c_q @ w_uq).reshape(Bn, S, B_HEADS, B_HEAD_DIM)
    q_lat = jnp.einsum('bthd,hcd->bthc', q, w_uk)
    q_idx = (c_q @ w_iq).reshape(Bn, S, IDX_HEADS, IDX_DIM)
    nblk = S // QBLK
    qi_blocks = jnp.swapaxes(q_idx.reshape(Bn, nblk, QBLK, IDX_HEADS, IDX_DIM), 0, 1)
    wi_blocks = jnp.swapaxes(w_idx.reshape(Bn, nblk, QBLK, IDX_HEADS), 0, 1)
    ql_blocks = jnp.swapaxes(q_lat.reshape(Bn, nblk, QBLK, B_HEADS, KV_LATENT), 0, 1)
    kchunk = jnp.arange(S, dtype=jnp.int32) // CHUNK
    scale = B_HEAD_DIM ** -0.5
    gather_rows = jax.vmap(lambda c, idx: c[idx])

    def block(args):
        qi, wi, ql, i = args
        qpos = i * QBLK + jnp.arange(QBLK, dtype=jnp.int32)
        qchunk = qpos // CHUNK
        sc = jnp.einsum('bqhd,bsd->bqhs', qi, k_idx).astype(jnp.float32)
        I = jnp.einsum('bqhs,bqh->bqs', jax.nn.relu(sc), wi.astype(jnp.float32)) * (IDX_DIM ** -0.5)
        I = jnp.where((kchunk[None, :] <= qchunk[:, None])[None], I, -jnp.inf)
        _, sel = lax.top_k(I, topk)
        cg = gather_rows(c_kv, sel)
        valid = (sel // CHUNK) <= qchunk[None, :, None]
        bias = rel_bias[t5_bucket(sel - qpos[None, :, None])]
        logits = jnp.einsum('bqhc,bqkc->bqhk', ql, cg).astype(jnp.float32) * scale
        logits = logits + jnp.moveaxis(bias, -1, 2).astype(jnp.float32)
        logits = jnp.where(valid[:, :, None, :], logits, -jnp.inf)
        p = jax.nn.softmax(logits, axis=-1).astype(cg.dtype)
        o_lat = jnp.einsum('bqhk,bqkc->bqhc', p, cg)
        return jnp.einsum('bqhc,hcd->bqhd', o_lat, w_uv).reshape(Bn, QBLK, B_HEADS * B_V_DIM)

    o = lax.map(block, (qi_blocks, wi_blocks, ql_blocks, jnp.arange(nblk, dtype=jnp.int32)))
    o = jnp.swapaxes(o, 0, 1).reshape(Bn, S, B_HEADS * B_V_DIM)
    return o @ w_out


def moe_ffn(h, router_w, router_b, w_gate, w_up, w_down, sh_gate, sh_up, sh_down):
    Bn, S, D = h.shape
    x2 = h.reshape(-1, D)
    N = x2.shape[0]
    scores = jax.nn.sigmoid(x2.astype(jnp.float32) @ router_w.astype(jnp.float32))
    _, sel = lax.top_k(scores + router_b.astype(jnp.float32), TOP_K)
    gate = jnp.take_along_axis(scores, sel, axis=-1)
    gate = gate / jnp.sum(gate, axis=-1, keepdims=True) * ROUTED_SCALE
    flat_e = sel.reshape(-1)
    order = jnp.argsort(flat_e)
    e_sorted = flat_e[order]
    tok_sorted = (order // TOP_K).astype(jnp.int32)
    g_sorted = gate.reshape(-1)[order]
    counts = jnp.bincount(flat_e, length=N_EXPERTS)
    padded = (counts + EXPERT_BLOCK - 1) // EXPERT_BLOCK * EXPERT_BLOCK
    pend = jnp.cumsum(padded)
    pstart = pend - padded
    cstart = jnp.cumsum(counts) - counts
    dest = pstart[e_sorted] + jnp.arange(N * TOP_K) - cstart[e_sorted]
    P = N * TOP_K + N_EXPERTS * EXPERT_BLOCK
    nblk = P // EXPERT_BLOCK
    row_tok = jnp.full((P,), N, jnp.int32).at[dest].set(tok_sorted)
    row_g = jnp.zeros((P,), jnp.float32).at[dest].set(g_sorted)
    blk_e = jnp.minimum(jnp.searchsorted(pend, jnp.arange(nblk) * EXPERT_BLOCK, side='right'),
                        N_EXPERTS - 1).astype(jnp.int32)
    xpad = jnp.concatenate([x2, jnp.zeros((1, D), x2.dtype)], axis=0)

    def step(y, inp):
        rows, g, e = inp
        xb = xpad[rows]
        hb = jax.nn.silu(xb @ w_gate[e]) * (xb @ w_up[e])
        yb = (hb @ w_down[e]) * g[:, None].astype(xb.dtype)
        return y.at[rows].add(yb), None

    y0 = jnp.zeros((N + 1, D), x2.dtype)
    y, _ = lax.scan(step, y0, (row_tok.reshape(nblk, EXPERT_BLOCK),
                               row_g.reshape(nblk, EXPERT_BLOCK), blk_e))
    shared = (jax.nn.silu(x2 @ sh_gate) * (x2 @ sh_up)) @ sh_down
    return (y[:N] + shared).reshape(Bn, S, D)


def setup_inputs(seed: int = 0) -> dict:
    key = jax.random.key(seed)
    ks = jax.random.split(key, 32)
    f32 = jnp.float32
    D = D_MODEL
    beta = DEEPNORM_BETA
    dA = A_HEADS * A_HEAD_DIM
    b_width = Q_LATENT + KV_LATENT + IDX_DIM + IDX_HEADS

    def nrm(k, shape, scale):
        return jax.random.normal(k, shape, f32) * scale

    a_w_in = nrm(ks[1], (N_LAYERS_A, D, 3 * dA + A_HEADS), D ** -0.5)
    a_w_in = a_w_in.at[:, :, 2 * dA:3 * dA].multiply(beta)
    return {
        "x": nrm(ks[0], (BATCH, SEQ, D), 1.0),
        "a_w_in": a_w_in,
        "a_b_f": 2.0 + nrm(ks[2], (N_LAYERS_A, A_HEADS), 0.5),
        "a_w_out": nrm(ks[3], (N_LAYERS_A, dA, D), dA ** -0.5 * beta),
        "b_w_in": nrm(ks[4], (N_LAYERS_B, D, b_width), D ** -0.5),
        "b_q_norm": 1.0 + nrm(ks[5], (N_LAYERS_B, Q_LATENT), 0.02),
        "b_kv_norm": 1.0 + nrm(ks[6], (N_LAYERS_B, KV_LATENT), 0.02),
        "b_w_uq": nrm(ks[7], (N_LAYERS_B, Q_LATENT, B_HEADS * B_HEAD_DIM), Q_LATENT ** -0.5),
        "b_w_iq": nrm(ks[8], (N_LAYERS_B, Q_LATENT, IDX_HEADS * IDX_DIM), Q_LATENT ** -0.5),
        "b_w_uk": nrm(ks[9], (N_LAYERS_B, B_HEADS, KV_LATENT, B_HEAD_DIM), KV_LATENT ** -0.5),
        "b_w_uv": nrm(ks[10], (N_LAYERS_B, B_HEADS, KV_LATENT, B_V_DIM), KV_LATENT ** -0.5 * beta),
        "b_w_out": nrm(ks[11], (N_LAYERS_B, B_HEADS * B_V_DIM, D), (B_HEADS * B_V_DIM) ** -0.5 * beta),
        "rel_bias": nrm(ks[12], (REL_BUCKETS, B_HEADS), 0.5),
        "ln1_g": 1.0 + nrm(ks[13], (DEPTH, D), 0.02),
        "ln1_b": nrm(ks[14], (DEPTH, D), 0.02),
        "ln2_g": 1.0 + nrm(ks[15], (DEPTH, D), 0.02),
        "ln2_b": nrm(ks[16], (DEPTH, D), 0.02),
        "router_w": nrm(ks[17], (DEPTH, D, N_EXPERTS), D ** -0.5),
        "router_b": nrm(ks[18], (DEPTH, N_EXPERTS), 0.01),
        "w_gate": nrm(ks[19], (DEPTH, N_EXPERTS, D, D_EXPERT), D ** -0.5),
        "w_up": nrm(ks[20], (DEPTH, N_EXPERTS, D, D_EXPERT), D ** -0.5 * beta),
        "w_down": nrm(ks[21], (DEPTH, N_EXPERTS, D_EXPERT, D), D_EXPERT ** -0.5 * beta),
        "sh_gate": nrm(ks[22], (DEPTH, D, D_SHARED), D ** -0.5),
        "sh_up": nrm(ks[23], (DEPTH, D, D_SHARED), D ** -0.5 * beta),
        "sh_down": nrm(ks[24], (DEPTH, D_SHARED, D), D_SHARED ** -0.5 * beta),
    }


def reference(x, a_w_in, a_b_f, a_w_out, b_w_in, b_q_norm, b_kv_norm, b_w_uq, b_w_iq, b_w_uk,
              b_w_uv, b_w_out, rel_bias, ln1_g, ln1_b, ln2_g, ln2_b, router_w, router_b,
              w_gate, w_up, w_down, sh_gate, sh_up, sh_down):
    for i in range(DEPTH):
        j = i // N_MIXERS
        if i % N_MIXERS == 0:
            m = forgetting_attention(x, a_w_in[j], a_b_f[j], a_w_out[j])
        else:
            m = indexed_sparse_attention(x, b_w_in[j], b_q_norm[j], b_kv_norm[j], b_w_uq[j],
                                         b_w_iq[j], b_w_uk[j], b_w_uv[j], b_w_out[j], rel_bias)
        x = layer_norm(DEEPNORM_ALPHA * x + m, ln1_g[i], ln1_b[i])
        f = moe_ffn(x, router_w[i], router_b[i], w_gate[i], w_up[i], w_down[i],
                    sh_gate[i], sh_up[i], sh_down[i])
        x = layer_norm(DEEPNORM_ALPHA * x + f, ln2_g[i], ln2_b[i])
    return x
```

```cpp
#include <hip/hip_runtime.h>
#include <stdint.h>
#include <stdio.h>

#define LAS __attribute__((address_space(3)))
typedef unsigned short bf16_t;
typedef short bf16x8 __attribute__((ext_vector_type(8)));
typedef short s16x4 __attribute__((ext_vector_type(4)));
typedef float f32x16 __attribute__((ext_vector_type(16)));
typedef float f32x4 __attribute__((ext_vector_type(4)));
typedef float f32x2 __attribute__((ext_vector_type(2)));
typedef unsigned u32x4 __attribute__((ext_vector_type(4)));
typedef unsigned u32x2 __attribute__((ext_vector_type(2)));

constexpr int NTOK = 16384, DM = 2048, SEQ = 4096, NBATCH = 4, NHEAD = 16, HDIM = 128;
constexpr int NEXP = 64, TOPK = 8, DEXP = 512;
constexpr int QLAT = 512, KVLAT = 256, IDXD = 64, IDXH = 16, IDXTOPK = 256, BW = 848;
constexpr float ALPHA = 1.4142135623730951f, LN_EPS = 1e-5f, RMS_EPS = 1e-6f, ROUTED_SCALE = 2.5f;
constexpr int NTHREADS = 512, NWAVES = 8;
#ifndef YS0_FP8
#define YS0_FP8 1
#endif
#ifndef CVT1_SPLIT
#define CVT1_SPLIT 0
#endif
#ifndef CVB
#define CVB 64
#endif
#ifndef GU0_CV
#define GU0_CV 1
#endif
#ifndef CVT0_GU
#define CVT0_GU 8320
#endif
#ifndef CVT0_SPLIT
#define CVT0_SPLIT 0
#endif
#ifndef SPA_CW
#define SPA_CW 2
#endif
constexpr int NBLK = 256;
constexpr int LDS_BYTES = 147456;
constexpr int MAXRT = 576;
constexpr int SH_TILE0 = MAXRT;
constexpr int NSROWS = (MAXRT + 64) * 256;

constexpr size_t MiB = 1048576;
constexpr size_t OFF_CTRL = 0, OFF_ROUTE = 1 * MiB, OFF_WGU = 5 * MiB, OFF_WD = 265 * MiB, MOE_LSTRIDE = 390 * MiB  , OFF_WA = 785 * MiB, OFF_XB = 857 * MiB, OFF_X2F = 921 * MiB, OFF_BIG = 1049 * MiB, WS_END = 1849 * MiB;
constexpr int CW_BAR = 0;
constexpr int CW_NTILES = 4096;
constexpr int CW_TILE_E = 4352;
constexpr int CW_TILE_RT = 5120;
constexpr int CW_HIST = 8192;
constexpr int CTRL_ZERO_BYTES = 16384;
constexpr size_t RT_SEL = 0, RT_GATE = 131072, RT_RANK = 262144, RT_POS = 393216, RT_ROWTOK = 524288;
constexpr size_t FWT_BYTE_OFF = 3 * MiB - 131072;
constexpr size_t RWT_BYTE_OFF = 3 * MiB;
constexpr size_t BG_Q = 0, BG_K = 64 * MiB, BG_V = 128 * MiB, BG_O = 192 * MiB, BG_M = 256 * MiB, BG_LOGF = 384 * MiB, BG_G = 385 * MiB, BG_NRM = 386 * MiB;
constexpr size_t BG_H = 0, BG_YS = 160 * MiB;
constexpr size_t BG_PROJ = 0, BG_CQ = 64 * MiB, BG_CKV = 80 * MiB, BG_KIDX = 88 * MiB, BG_WIDX = 90 * MiB, BG_NSEL = 91 * MiB, BG_QLAT = 96 * MiB, BG_QIDX = 224 * MiB, BG_SEL = 256 * MiB, BG_OLAT = 272 * MiB, BG_M2 = 400 * MiB, BG_O2 = 464 * MiB;
constexpr size_t WA_WINT = 0, WA_WOUTT = 24 * MiB;
constexpr size_t WA_WBINT = 32 * MiB, WA_WQ2T = 36 * MiB, WA_WUVOT = 44 * MiB  , WA_WOUTTB = 60 * MiB;

struct Params {
    const float *x, *a_w_in, *a_b_f, *a_w_out, *b_w_in, *b_q_norm, *b_kv_norm, *b_w_uq, *b_w_iq, *b_w_uk, *b_w_uv, *b_w_out, *rel_bias,
        *ln1_g, *ln1_b, *ln2_g, *ln2_b, *router_w, *router_b, *w_gate, *w_up, *w_down, *sh_gate, *sh_up, *sh_down;
    float* out;
    unsigned char* ws;
};

__device__ __forceinline__ unsigned cvt_pk_bf16(float lo, float hi) { unsigned r; asm volatile("v_cvt_pk_bf16_f32 %0, %1, %2" : "=v"(r) : "v"(lo), "v"(hi)); return r; }
__device__ __forceinline__ bf16x8 pack8(f32x4 a, f32x4 b) {
    u32x4 w = {cvt_pk_bf16(a[0], a[1]), cvt_pk_bf16(a[2], a[3]), cvt_pk_bf16(b[0], b[1]), cvt_pk_bf16(b[2], b[3])};
    return *reinterpret_cast<bf16x8*>(&w);
}
__device__ __forceinline__ void mfma_fence(f32x4& a) { asm volatile("s_nop 15\n\ts_nop 15" : "+v"(a)); }
__device__ __forceinline__ int tidx() { int t = (int)threadIdx.x; asm volatile("" : "+v"(t)); return t; }
__device__ __forceinline__ float bf2f(bf16_t b) { return __uint_as_float(((unsigned)b) << 16); }
__device__ __forceinline__ float wave_sum(float v) {
#pragma unroll
    for (int o = 32; o >= 1; o >>= 1) v += __shfl_xor(v, o);
    return v;
}
__device__ __forceinline__ float wave_max(float v) {
#pragma unroll
    for (int o = 32; o >= 1; o >>= 1) v = fmaxf(v, __shfl_xor(v, o));
    return v;
}

namespace pg8 {
constexpr int BM = 256, BK = 64, HALF = 128, HTB = HALF * BK * 2  , STAGE_BYTES = 8 * HTB, NXCD = 8, WGM = 8;

__host__ __device__ __forceinline__ int lds_byte(int r, int c) { const int st = (r >> 4) * 2 + (c >> 5), rr = r & 15, cc = c & 31, ob = rr * 64 + cc * 2; return st * 1024 + (ob ^ (((ob >> 9) & 1) << 5)); }
__host__ __device__ __forceinline__ void stage_rc(int b, int& R, int& C) { const int st = b / 1024, sb = b % 1024, swz = sb ^ (((sb >> 9) & 1) << 5); R = (st >> 1) * 16 + swz / 64; C = (st & 1) * 32 + (swz % 64) / 2; }
__host__ __device__ __forceinline__ int perm32(int rho) { const int n = rho >> 4, i = rho & 15; return 8 * (i >> 2) + 4 * n + (i & 3); }

struct Unit { int pm, pn, e, idx; };

struct StaticOrder {
    int nM, nN, nwg, G, c;
    __device__ void init(int M, int N, int G_, int c_) { nM = M / BM; nN = N / BM; nwg = nM * nN; G = G_; c = c_; }
    __device__ bool next(int i, Unit& u) const {
        const long L = (long)i * G + c; if (L >= nwg) return false;
        int wgid = (int)L; { const int q = nwg / NXCD, r = nwg % NXCD, xcd = wgid % NXCD, off = wgid / NXCD; wgid = (xcd < r ? xcd * (q + 1) : r * (q + 1) + (xcd - r) * q) + off; }
        const int nig = WGM * nN, gid = wgid / nig, fm = gid * WGM, gsz = (nM - fm) < WGM ? (nM - fm) : WGM;
        u.pm = fm + ((wgid % nig) % gsz); u.pn = (wgid % nig) / gsz; u.e = 0; u.idx = i; return true;
    }
};
struct DenseSched {
    const bf16_t* A; const bf16_t* Bt; int K; StaticOrder so;
    __device__ void init(const bf16_t* A_, const bf16_t* Bt_, int M, int N, int K_, int G_ = NBLK) { A = A_; Bt = Bt_; K = K_; so.init(M, N, G_, blockIdx.x); }
    __device__ __forceinline__ bool next(int i, Unit& u) const { return so.next(i, u); }
    __device__ __forceinline__ int rot() const { return 0; }
    __device__ __forceinline__ int ldk() const { return K; }
    __device__ __forceinline__ size_t kstep_a() const { return BK * 2; }
    __device__ __forceinline__ size_t kstep_b() const { return BK * 2; }
    __device__ __forceinline__ const char* a_base(const Unit& u) const { return (const char*)A + (size_t)u.pm * BM * K * 2; }
    __device__ __forceinline__ const char* b_base(const Unit& u) const { return (const char*)Bt + (size_t)u.pn * BM * K * 2; }
    __device__ __forceinline__ void a_offs(const Unit&, const int (&R)[2], const int (&C)[2], unsigned (&off)[2][2]) const {
#pragma unroll
        for (int h = 0; h < 2; ++h)
#pragma unroll
            for (int i = 0; i < 2; ++i) off[h][i] = (unsigned)((h * HALF + R[i]) * K + C[i]) * 2u;
    }
};
struct BlockDiagSched {
    const bf16_t* A; const bf16_t* Bt; int K, LD; StaticOrder so;
    __device__ void init(const bf16_t* A_, const bf16_t* Bt_, int M, int N, int K_, int LD_) { A = A_; Bt = Bt_; K = K_; LD = LD_; so.init(M, N, NBLK, blockIdx.x); }
    __device__ __forceinline__ bool next(int i, Unit& u) const { return so.next(i, u); }
    __device__ __forceinline__ int rot() const { return 0; }
    __device__ __forceinline__ int ldk() const { return LD; }
    __device__ __forceinline__ size_t kstep_a() const { return BK * 2; }
    __device__ __forceinline__ size_t kstep_b() const { return BK * 2; }
    __device__ __forceinline__ const char* a_base(const Unit& u) const { return (const char*)A + ((size_t)u.pm * BM * LD + (size_t)u.pn * K) * 2; }
    __device__ __forceinline__ const char* b_base(const Unit& u) const { return (const char*)Bt + ((size_t)u.pn * BM * LD + (size_t)u.pn * K) * 2; }
    __device__ __forceinline__ void a_offs(const Unit&, const int (&R)[2], const int (&C)[2], unsigned (&off)[2][2]) const {
#pragma unroll
        for (int h = 0; h < 2; ++h)
#pragma unroll
            for (int i = 0; i < 2; ++i) off[h][i] = (unsigned)((h * HALF + R[i]) * LD + C[i]) * 2u;
    }
};
struct MoeSchedBase {
    const unsigned* ctrl; int npn, ntiles, G, c, tpx, t0, t1, nx, lc;
    __device__ void init_base(const unsigned* ctrl_, int npn_, int part, int nconv = 0) { ctrl = ctrl_; npn = npn_; ntiles = (int)ctrl_[CW_NTILES]; G = NBLK; c = blockIdx.x;
        if ((G & 7) == 0) { const int x = c & 7; nx = (G >> 3) - nconv; lc = c >> 3; tpx = (ntiles + 7) >> 3; t0 = x * tpx; t1 = t0 + tpx < ntiles ? t0 + tpx : ntiles; if (t0 > t1) t0 = t1; }
        else { nx = G; lc = c; tpx = ntiles; t0 = 0; t1 = ntiles; }
        if (part >= 0) { const int ts = t0 + (2 * (t1 - t0) + 2) / 3; if (part == 0) t1 = ts; else t0 = ts; } }
    __device__ __forceinline__ bool next(int i, Unit& u) const {
        const int li = i * nx + lc, T = t0 + li / npn; if (T >= t1) return false;
        u.pn = li % npn; u.e = (int)ctrl[CW_TILE_E + T]; u.pm = (int)ctrl[CW_TILE_RT + T]; u.idx = i; return true;
    }
    __device__ __forceinline__ int rot() const { return 0; }
    __device__ __forceinline__ size_t kstep_a() const { return BK * 2; }
    __device__ __forceinline__ size_t kstep_b() const { return BK * 2; }
};
struct MoeGuSched : MoeSchedBase {
    const bf16_t* A; const bf16_t* Bt; const int* row_tok; int K; LAS int* rowsL;
    __device__ void init(const unsigned* ctrl_, const bf16_t* A_, const bf16_t* Bt_, const int* row_tok_, int part, LAS int* rowsL_, int nconv = 0) { init_base(ctrl_, 4, part, nconv); A = A_; Bt = Bt_; row_tok = row_tok_; K = DM; rowsL = rowsL_;
        const int tid = tidx();
        for (int i = 0; i < 15; ++i) { Unit u; if (!next(i, u)) break; if (tid < 256) rowsL[i * 256 + tid] = row_tok[(size_t)u.pm * BM + tid]; }
        asm volatile("s_waitcnt vmcnt(0) lgkmcnt(0)" ::: "memory"); __syncthreads(); }
    __device__ __forceinline__ int ldk() const { return DM; }
    __device__ __forceinline__ const char* a_base(const Unit&) const { return (const char*)A; }
    __device__ __forceinline__ const char* b_base(const Unit& u) const { return (const char*)Bt + ((size_t)u.e * 1024 + (size_t)u.pn * BM) * DM * 2; }
    __device__ __forceinline__ void a_offs(const Unit& u, const int (&R)[2], const int (&C)[2], unsigned (&off)[2][2]) const {
        const LAS int* rt = rowsL + (u.idx < 15 ? u.idx : 14) * 256;
#pragma unroll
        for (int h = 0; h < 2; ++h)
#pragma unroll
            for (int i = 0; i < 2; ++i) { const int tok = rt[h * HALF + R[i]]; off[h][i] = (unsigned)(tok * DM + C[i]) * 2u; }
    }
};
struct MoeDownSched : MoeSchedBase {
    const bf16_t* A; const bf16_t* Bt; int K;
    __device__ void init(const unsigned* ctrl_, const bf16_t* A_, const bf16_t* Bt_, int part) { init_base(ctrl_, 8, part); A = A_; Bt = Bt_; K = DEXP; }
    __device__ __forceinline__ int ldk() const { return DEXP; }
    __device__ __forceinline__ const char* a_base(const Unit& u) const { return (const char*)A + (size_t)u.pm * BM * DEXP * 2; }
    __device__ __forceinline__ const char* b_base(const Unit& u) const { return (const char*)Bt + ((size_t)u.e * DM + (size_t)u.pn * BM) * DEXP * 2; }
    __device__ __forceinline__ void a_offs(const Unit&, const int (&R)[2], const int (&C)[2], unsigned (&off)[2][2]) const {
#pragma unroll
        for (int h = 0; h < 2; ++h)
#pragma unroll
            for (int i = 0; i < 2; ++i) off[h][i] = (unsigned)((h * HALF + R[i]) * DEXP + C[i]) * 2u;
    }
};

__device__ __forceinline__ unsigned xchg1(unsigned v) { return (unsigned)__builtin_amdgcn_update_dpp(0, (int)v, 0xB1, 0xf, 0xf, false); }
__device__ __forceinline__ float xchg1f(float v) { return __uint_as_float(xchg1(__float_as_uint(v))); }
struct EpiF32 {
    static constexpr int PERM = 0;
    float* C; int ldc;
    __device__ __forceinline__ void operator()(const f32x4 (&acc)[2][2][4][2], const Unit& u, int wr, int wc, int fr, int fq) const {
        const bool odd = (fr & 1) != 0;
        const int rowe = u.pm * BM + wr * 64 + (fr & ~1), col0 = u.pn * BM + wc * 32 + (odd ? 16 : 0) + 4 * fq;
#pragma unroll
        for (int ai = 0; ai < 2; ++ai)
#pragma unroll
            for (int m = 0; m < 4; ++m) { float* rowp = C + (size_t)(rowe + ai * HALF + m * 16) * ldc + col0;
#pragma unroll
                for (int bj = 0; bj < 2; ++bj) {
                    const f32x4 v0 = acc[ai][bj][m][0], v1 = acc[ai][bj][m][1];
                    f32x4 s0, s1;
#pragma unroll
                    for (int k = 0; k < 4; ++k) { const float snd = odd ? v0[k] : v1[k]; const float rcv = xchg1f(snd); s0[k] = odd ? rcv : v0[k]; s1[k] = odd ? v1[k] : rcv; }
                    *(f32x4*)(rowp + bj * HALF) = s0; *(f32x4*)(rowp + ldc + bj * HALF) = s1; } }
    }
};
template <bool NORMS>
struct EpiBf16T {
    static constexpr int PERM = 2;
    bf16_t* O0; int ld0; bf16_t* O1; int ld1; int split0; int split_cols; size_t split_stride;
    float* nrm;
    __device__ __forceinline__ void operator()(const f32x4 (&acc)[2][2][4][2], const Unit& u, int wr, int wc, int fr, int fq) const {
        int colt = u.pn * BM; bf16_t* base = O0; int ldc = ld0;
        int qk = 2;
        if (split_cols) { const int t = colt / split_cols; base += (size_t)t * split_stride; colt -= t * split_cols; qk = t; }
        else if (colt >= split0) { base = O1; ldc = ld1; colt -= split0; }
        const bool odd = (fr & 1) != 0;
        const int col0 = colt + wc * 64 + (odd ? 32 : 0) + 8 * fq;
        const int rowe = u.pm * BM + wr * 64 + (fr & ~1);
#pragma unroll
        for (int ai = 0; ai < 2; ++ai) {
            float mx = 0.f;
#pragma unroll
            for (int m = 0; m < 4; ++m) {
                float lo[8], hi[8], e0[8], e1[8];
#pragma unroll
                for (int k = 0; k < 4; ++k) { lo[k] = acc[ai][0][m][0][k]; lo[4 + k] = acc[ai][0][m][1][k]; hi[k] = acc[ai][1][m][0][k]; hi[4 + k] = acc[ai][1][m][1][k]; }
                if constexpr (NORMS) { float sq = 0.f;
#pragma unroll
                    for (int k = 0; k < 8; ++k) { sq = fmaf(lo[k], lo[k], sq); sq = fmaf(hi[k], hi[k], sq); }
                    sq += __shfl_xor(sq, 16); sq += __shfl_xor(sq, 32); mx = fmaxf(mx, sq); }
#pragma unroll
                for (int k = 0; k < 8; ++k) { const float snd = odd ? lo[k] : hi[k]; const float rcv = xchg1f(snd); e0[k] = odd ? rcv : lo[k]; e1[k] = odd ? hi[k] : rcv; }
                u32x4 s0, s1;
                s0.x = cvt_pk_bf16(e0[0], e0[1]); s0.y = cvt_pk_bf16(e0[2], e0[3]); s0.z = cvt_pk_bf16(e0[4], e0[5]); s0.w = cvt_pk_bf16(e0[6], e0[7]);
                s1.x = cvt_pk_bf16(e1[0], e1[1]); s1.y = cvt_pk_bf16(e1[2], e1[3]); s1.z = cvt_pk_bf16(e1[4], e1[5]); s1.w = cvt_pk_bf16(e1[6], e1[7]);
                bf16_t* rp = base + (size_t)(rowe + ai * HALF + m * 16) * ldc + col0;
                *(u32x4*)rp = s0; *(u32x4*)(rp + ldc) = s1;
            }
            if constexpr (NORMS) {
                mx = fmaxf(mx, __shfl_xor(mx, 1)); mx = fmaxf(mx, __shfl_xor(mx, 2)); mx = fmaxf(mx, __shfl_xor(mx, 4)); mx = fmaxf(mx, __shfl_xor(mx, 8));
                const int Jg = u.pm * 4 + ai * 2 + wr, c = colt + wc * 64;
                if (qk < 2 && fr == 0 && fq == 0) atomicMax((unsigned*)(nrm + ((((size_t)qk * 64 + (Jg >> 6) * 16 + (c >> 7)) * 64 + (Jg & 63)) * 2 + ((c >> 6) & 1))), __float_as_uint(mx));
            }
        }
    }
};
using EpiBf16 = EpiBf16T<false>;
struct EpiFp8 {
    static constexpr int PERM = 2;
    unsigned char* O; int ldc;
    __device__ __forceinline__ void operator()(const f32x4 (&acc)[2][2][4][2], const Unit& u, int wr, int wc, int fr, int fq) const {
        const bool odd = (fr & 1) != 0;
        const int col0 = u.pn * BM + wc * 64 + (odd ? 32 : 0) + 8 * fq;
        const int rowe = u.pm * BM + wr * 64 + (fr & ~1);
#pragma unroll
        for (int ai = 0; ai < 2; ++ai)
#pragma unroll
            for (int m = 0; m < 4; ++m) {
                float lo[8], hi[8];
#pragma unroll
                for (int k = 0; k < 4; ++k) { lo[k] = __builtin_amdgcn_fmed3f(acc[ai][0][m][0][k] * 64.f, -448.f, 448.f); lo[4 + k] = __builtin_amdgcn_fmed3f(acc[ai][0][m][1][k] * 64.f, -448.f, 448.f);
                    hi[k] = __builtin_amdgcn_fmed3f(acc[ai][1][m][0][k] * 64.f, -448.f, 448.f); hi[4 + k] = __builtin_amdgcn_fmed3f(acc[ai][1][m][1][k] * 64.f, -448.f, 448.f); }
                int l0 = __builtin_amdgcn_cvt_pk_fp8_f32(lo[0], lo[1], 0, false); l0 = __builtin_amdgcn_cvt_pk_fp8_f32(lo[2], lo[3], l0, true);
                int l1 = __builtin_amdgcn_cvt_pk_fp8_f32(lo[4], lo[5], 0, false); l1 = __builtin_amdgcn_cvt_pk_fp8_f32(lo[6], lo[7], l1, true);
                int h0 = __builtin_amdgcn_cvt_pk_fp8_f32(hi[0], hi[1], 0, false); h0 = __builtin_amdgcn_cvt_pk_fp8_f32(hi[2], hi[3], h0, true);
                int h1 = __builtin_amdgcn_cvt_pk_fp8_f32(hi[4], hi[5], 0, false); h1 = __builtin_amdgcn_cvt_pk_fp8_f32(hi[6], hi[7], h1, true);
                const unsigned s0 = odd ? (unsigned)l0 : (unsigned)h0, s1 = odd ? (unsigned)l1 : (unsigned)h1;
                const unsigned r0 = xchg1(s0), r1 = xchg1(s1);
                u32x2 e0, e1;
                e0.x = odd ? r0 : (unsigned)l0; e0.y = odd ? r1 : (unsigned)l1; e1.x = odd ? (unsigned)h0 : r0; e1.y = odd ? (unsigned)h1 : r1;
                unsigned char* rp = O + (size_t)(rowe + ai * HALF + m * 16) * ldc + col0;
                *(u32x2*)rp = e0; *(u32x2*)(rp + ldc) = e1;
            }
    }
};
__device__ __forceinline__ float silu_f(float g) { return g * __builtin_amdgcn_rcpf(1.0f + __builtin_amdgcn_exp2f(-1.4426950408889634f * g)); }
struct EpiSwiGLU {
    static constexpr int PERM = 1;
    bf16_t* H;
    __device__ __forceinline__ void operator()(const f32x4 (&acc)[2][2][4][2], const Unit& u, int wr, int wc, int fr, int fq) const {
        const int row0 = u.pm * BM + wr * 64 + fr, col0 = u.pn * HALF + wc * 32 + 8 * fq;
#pragma unroll
        for (int ai = 0; ai < 2; ++ai)
#pragma unroll
            for (int m = 0; m < 4; ++m) { bf16_t* rowp = H + (size_t)(row0 + ai * HALF + m * 16) * DEXP + col0;
                const f32x4 g0 = acc[ai][0][m][0], g1 = acc[ai][0][m][1], u0 = acc[ai][1][m][0], u1 = acc[ai][1][m][1];
                u32x4 w; w.x = cvt_pk_bf16(silu_f(g0[0]) * u0[0], silu_f(g0[1]) * u0[1]); w.y = cvt_pk_bf16(silu_f(g0[2]) * u0[2], silu_f(g0[3]) * u0[3]);
                w.z = cvt_pk_bf16(silu_f(g1[0]) * u1[0], silu_f(g1[1]) * u1[1]); w.w = cvt_pk_bf16(silu_f(g1[2]) * u1[2], silu_f(g1[3]) * u1[3]);
                *(u32x4*)rowp = w; }
    }
};

template <class Epi, class Sched>
__device__ __forceinline__ void gemm_phase(LAS unsigned char* lds, const Sched& S, const Epi& E) {
    const int tid = tidx(), wid = __builtin_amdgcn_readfirstlane(tid >> 6), lane = tid & 63, wr = wid >> 2, wc = wid & 3, fr = lane & 15, fq = lane >> 4;
    const int K = S.K, nt = K / BK;
    int Rr[2], Cc[2]; unsigned voffB[2];
#pragma unroll
    for (int i = 0; i < 2; ++i) { int R, C; stage_rc(tid * 16 + i * 8192, R, C); Rr[i] = R; Cc[i] = C; const int Rb = Epi::PERM == 2 ? (64 * (R >> 5) + perm32(R & 31)) : Epi::PERM ? ((R & ~31) + perm32(R & 31)) : R; voffB[i] = (unsigned)(Rb * S.ldk() + C) * 2u; }
    const size_t kstep = (size_t)(BK * 2);
    const size_t hstep = (size_t)(Epi::PERM == 2 ? 32 : HALF) * S.ldk() * 2;
    const unsigned ldsw = (unsigned)wid * 1024u;
    const int aoff = lds_byte(wr * 64 + fr, fq * 8), boff = lds_byte(wc * 32 + fr, fq * 8);
#define PG8_SA(b, h) (((b) * 2 + (h)) * HTB)
#define PG8_SB(b, h) ((4 + (b) * 2 + (h)) * HTB)
#define PG8_STAGE(bufoff, gbase, voff) do { _Pragma("unroll") for (int _i = 0; _i < 2; ++_i) \
        __builtin_amdgcn_global_load_lds((const unsigned*)((const char*)(gbase) + (voff)[_i]), (LAS unsigned*)(lds + (bufoff) + ldsw + _i * 8192), 16, 0, 0); } while (0)
#define PG8_LDA(dst, b, h) do { _Pragma("unroll") for (int m = 0; m < 4; ++m) _Pragma("unroll") for (int k = 0; k < 2; ++k) dst[m][k] = *(const LAS bf16x8*)(lds + PG8_SA(b, h) + aoff + m * 2048 + k * 1024); } while (0)
#define PG8_LDB(dst, b, h) do { _Pragma("unroll") for (int n = 0; n < 2; ++n) _Pragma("unroll") for (int k = 0; k < 2; ++k) dst[n][k] = *(const LAS bf16x8*)(lds + PG8_SB(b, h) + boff + n * 2048 + k * 1024); } while (0)
#define PG8_MMA(ai, bj, At, Bt) do { __builtin_amdgcn_s_setprio(1); _Pragma("unroll") for (int m = 0; m < 4; ++m) _Pragma("unroll") for (int n = 0; n < 2; ++n) _Pragma("unroll") for (int k = 0; k < 2; ++k) \
        acc[ai][bj][m][n] = __builtin_amdgcn_mfma_f32_16x16x32_bf16(Bt[n][k], At[m][k], acc[ai][bj][m][n], 0, 0, 0); __builtin_amdgcn_s_setprio(0); } while (0)
#define PG8_WAIT_V(n) asm volatile("s_waitcnt vmcnt(" #n ")" ::: "memory")
#define PG8_WAIT_L(n) asm volatile("s_waitcnt lgkmcnt(" #n ")" ::: "memory")
#define PG8_BAR __builtin_amdgcn_s_barrier()
#define PG8_SCHED __builtin_amdgcn_sched_barrier(0)
    Unit cur, nxt; int ui = 0;
    if (!S.next(0, cur)) return;
    f32x4 acc[2][2][4][2];
#pragma unroll
    for (int a = 0; a < 2; ++a)
#pragma unroll
        for (int b = 0; b < 2; ++b)
#pragma unroll
            for (int m = 0; m < 4; ++m)
#pragma unroll
                for (int n = 0; n < 2; ++n) acc[a][b][m][n] = (f32x4){0.f, 0.f, 0.f, 0.f};
    bf16x8 At[4][2], B0[2][2], B1[2][2];
    unsigned offC[2][2], offN[2][2];
    S.a_offs(cur, Rr, Cc, offC);
    const char* cA = S.a_base(cur); const char* cB = S.b_base(cur);
    const int rot = S.rot() & (nt - 1), ntm = nt - 1;
    const size_t kstepA = S.kstep_a(), kstepB = S.kstep_b();
#define PG8_KOFF(t_) ((size_t)(((t_) + rot) & ntm) * kstepB)
#define PG8_KOFFA(t_) ((size_t)(((t_) + rot) & ntm) * kstepA)
    PG8_STAGE(PG8_SB(0, 0), cB + PG8_KOFF(0), voffB); PG8_STAGE(PG8_SA(0, 0), cA + PG8_KOFFA(0), offC[0]); PG8_STAGE(PG8_SB(0, 1), cB + hstep + PG8_KOFF(0), voffB); PG8_STAGE(PG8_SA(0, 1), cA + PG8_KOFFA(0), offC[1]);
    if (wr == 1) PG8_BAR;
    PG8_WAIT_V(4); PG8_BAR;
    PG8_STAGE(PG8_SB(1, 0), cB + PG8_KOFF(1), voffB); PG8_STAGE(PG8_SA(1, 0), cA + PG8_KOFFA(1), offC[0]); PG8_STAGE(PG8_SB(1, 1), cB + hstep + PG8_KOFF(1), voffB);
    PG8_WAIT_V(6); PG8_BAR;
    for (;;) {
        const bool has_next = S.next(ui + 1, nxt);
        const char* nA = has_next ? S.a_base(nxt) : cA; const char* nB = has_next ? S.b_base(nxt) : cB;
        if (has_next) S.a_offs(nxt, Rr, Cc, offN);
        else {
#pragma unroll
            for (int h = 0; h < 2; ++h)
#pragma unroll
                for (int i = 0; i < 2; ++i) offN[h][i] = offC[h][i]; }
        for (int t = 0; t < nt; t += 2) {
            const bool last = (t == nt - 2);
            const char* a1 = cA + PG8_KOFFA(t + 1);
            const char* a2 = (last ? nA : cA) + PG8_KOFFA(t + 2); const char* b2 = (last ? nB : cB) + PG8_KOFF(t + 2);
            const char* a3 = (last ? nA : cA) + PG8_KOFFA(t + 3); const char* b3 = (last ? nB : cB) + PG8_KOFF(t + 3);
            unsigned o2[2][2];
#pragma unroll
            for (int h = 0; h < 2; ++h)
#pragma unroll
                for (int i = 0; i < 2; ++i) o2[h][i] = last ? offN[h][i] : offC[h][i];
            PG8_LDB(B0, 0, 0); PG8_SCHED; PG8_LDA(At, 0, 0); PG8_STAGE(PG8_SA(1, 1), a1, offC[1]);
            PG8_WAIT_L(8); PG8_BAR; PG8_WAIT_L(0); PG8_MMA(0, 0, At, B0); PG8_BAR; PG8_SCHED;
            PG8_LDB(B1, 0, 1); PG8_STAGE(PG8_SB(0, 0), b2, voffB);
            PG8_BAR; PG8_WAIT_L(0); PG8_MMA(0, 1, At, B1); PG8_BAR;
            PG8_LDA(At, 0, 1); PG8_STAGE(PG8_SA(0, 0), a2, o2[0]);
            PG8_BAR; PG8_WAIT_L(0); PG8_MMA(1, 0, At, B0); PG8_BAR; PG8_SCHED;
            PG8_STAGE(PG8_SB(0, 1), b2 + hstep, voffB);
            PG8_WAIT_V(6); PG8_BAR; PG8_MMA(1, 1, At, B1); PG8_BAR;
            PG8_LDB(B0, 1, 0); PG8_SCHED; PG8_LDA(At, 1, 0); PG8_STAGE(PG8_SA(0, 1), a2, o2[1]);
            PG8_WAIT_L(8); PG8_BAR; PG8_WAIT_L(0); PG8_MMA(0, 0, At, B0); PG8_BAR; PG8_SCHED;
            PG8_LDB(B1, 1, 1); PG8_STAGE(PG8_SB(1, 0), b3, voffB);
            PG8_BAR; PG8_WAIT_L(0); PG8_MMA(0, 1, At, B1); PG8_BAR;
            PG8_LDA(At, 1, 1); PG8_STAGE(PG8_SA(1, 0), a3, o2[0]);
            PG8_BAR; PG8_WAIT_L(0); PG8_MMA(1, 0, At, B0); PG8_BAR; PG8_SCHED;
            PG8_STAGE(PG8_SB(1, 1), b3 + hstep, voffB);
            PG8_WAIT_V(6); PG8_BAR; PG8_MMA(1, 1, At, B1); PG8_BAR;
        }
        E(acc, cur, wr, wc, fr, fq);
        if (!has_next) break;
#pragma unroll
        for (int a = 0; a < 2; ++a)
#pragma unroll
            for (int b = 0; b < 2; ++b)
#pragma unroll
                for (int m = 0; m < 4; ++m)
#pragma unroll
                    for (int n = 0; n < 2; ++n) acc[a][b][m][n] = (f32x4){0.f, 0.f, 0.f, 0.f};
        cur = nxt; cA = nA; cB = nB; ++ui;
#pragma unroll
        for (int h = 0; h < 2; ++h)
#pragma unroll
            for (int i = 0; i < 2; ++i) offC[h][i] = offN[h][i];
    }
    PG8_WAIT_V(0);
    if (wr == 0) PG8_BAR;
    PG8_BAR;
#undef PG8_KOFF
#undef PG8_KOFFA
#undef PG8_SA
#undef PG8_SB
#undef PG8_STAGE
#undef PG8_LDA
#undef PG8_LDB
#undef PG8_MMA
#undef PG8_WAIT_V
#undef PG8_WAIT_L
#undef PG8_BAR
#undef PG8_SCHED
}
}

namespace fox {
constexpr int D = 128, LD = DM, NW = 8, QBLK = 32, KVBLK = 64, QB = NW * QBLK;
constexpr int SHM_V = KVBLK * D * 2, SHM_K = KVBLK * D * 2;
constexpr int OFF_WS = 2 * SHM_V + 2 * SHM_K, OFF_G = OFF_WS + NW * 64 * 4, GBUF = SEQ * 4, LDS_BYTES = OFF_G + 2 * GBUF;
constexpr float SCALE = 0.08838834764831845f, THR = 8.f;

#define KSWZ(row, colB) ((row) * 256 + ((colB) ^ (((row) & 7) << 4)))
#define SBAR() __builtin_amdgcn_sched_barrier(0)
__device__ __forceinline__ int v_st(int k, int c) { const int kk = (k & ~0xC) | ((k & 4) << 1) | ((k & 8) >> 1); return ((kk >> 3) * 4 + (c >> 5)) * 512 + ((kk & 7) * 32 + (c & 31)) * 2; }
__device__ __forceinline__ int v_rd_base(int lane) { return ((lane & 3) << 3) | (((lane >> 2) & 3) << 6) | (((lane >> 4) & 1) << 5) | (((lane >> 5) & 1) << 8); }
constexpr int v_rd_off(int d0, int ks, int half) { return d0 * 512 + ks * 4096 + half * 2048; }
__device__ __forceinline__ int crow(int r, int hi) { return (r & 3) + 8 * (r >> 2) + 4 * hi; }
__device__ __forceinline__ bf16x8 load8(const bf16_t* p) { return *reinterpret_cast<const bf16x8*>(p); }

__device__ __forceinline__ void mask_tile(f32x16& p0, f32x16& p1, int dq) {
    const float NEG = -__builtin_inff();
#pragma unroll
    for (int r = 0; r < 16; ++r) {
        const int c = (r & 3) + 8 * (r >> 2);
        if (dq - c < 0) p0[r] = NEG;
        if (dq - c - 32 < 0) p1[r] = NEG;
    }
}
__device__ __forceinline__ void bias_tile(f32x16& p0, f32x16& p1, const float* gl, int hi) {
#pragma unroll
    for (int j = 0; j < 4; ++j) {
        const f32x4 a = *(const f32x4*)(gl + 8 * j + 4 * hi), b = *(const f32x4*)(gl + 32 + 8 * j + 4 * hi);
#pragma unroll
        for (int i = 0; i < 4; ++i) { p0[4 * j + i] += a[i]; p1[4 * j + i] += b[i]; }
    }
}
__device__ __forceinline__ void partialSM(f32x16& p0, f32x16& p1, float& m_reg, float& mn, float& alpha) {
    float pmax = p0[0];
#pragma unroll
    for (int r = 1; r < 16; ++r) pmax = fmaxf(pmax, p0[r]);
#pragma unroll
    for (int r = 0; r < 16; ++r) pmax = fmaxf(pmax, p1[r]);
    { auto rr = __builtin_amdgcn_permlane32_swap(__float_as_uint(pmax), __float_as_uint(pmax), false, false);
      pmax = fmaxf(__uint_as_float(rr[0]), __uint_as_float(rr[1])); }
    constexpr float C2 = 1.4426950408889634f * SCALE;
    if (__builtin_expect(__all((pmax - m_reg) * SCALE <= THR), 1)) { mn = m_reg; alpha = 1.f; }
    else { mn = fmaxf(m_reg, pmax); alpha = __builtin_amdgcn_exp2f((m_reg - mn) * C2); m_reg = mn; }
    const float mnL = -mn * C2;
#pragma unroll
    for (int r = 0; r < 16; ++r) p0[r] = fmaf(p0[r], C2, mnL);
#pragma unroll
    for (int r = 0; r < 16; ++r) p1[r] = fmaf(p1[r], C2, mnL);
#pragma unroll
    for (int r = 0; r < 16; ++r) p0[r] = __builtin_amdgcn_exp2f(p0[r]);
}
__device__ __forceinline__ void finishSM(f32x16& p0, f32x16& p1, float alpha, float& l_reg, bf16x8& pa0, bf16x8& pa1, bf16x8& pa2, bf16x8& pa3) {
#pragma unroll
    for (int r = 0; r < 16; ++r) p1[r] = __builtin_amdgcn_exp2f(p1[r]);
    float ps = 0;
#pragma unroll
    for (int r = 0; r < 16; ++r) ps += p0[r];
#pragma unroll
    for (int r = 0; r < 16; ++r) ps += p1[r];
    { auto rr = __builtin_amdgcn_permlane32_swap(__float_as_uint(ps), __float_as_uint(ps), false, false);
      ps = __uint_as_float(rr[0]) + __uint_as_float(rr[1]); }
    l_reg = l_reg * alpha + ps;
#define PK4(P, B_, OUT) do { unsigned a0 = cvt_pk_bf16(P[B_+0], P[B_+1]), a1 = cvt_pk_bf16(P[B_+2], P[B_+3]);                          \
        unsigned b0 = cvt_pk_bf16(P[B_+4], P[B_+5]), b1 = cvt_pk_bf16(P[B_+6], P[B_+7]);                                             \
        auto r0 = __builtin_amdgcn_permlane32_swap(a0, b0, false, false); auto r1 = __builtin_amdgcn_permlane32_swap(a1, b1, false, false); \
        u32x4 w = {r0[0], r1[0], r0[1], r1[1]}; OUT = *reinterpret_cast<bf16x8*>(&w); } while (0)
    PK4(p0, 0, pa0); PK4(p0, 8, pa1); PK4(p1, 0, pa2); PK4(p1, 8, pa3);
#undef PK4
}
template <int KB>
__device__ __forceinline__ void qkt(f32x16& p0, f32x16& p1, const char* K_lds, int r32, int hi, const bf16x8* qr) {
    p0 = f32x16{}; p1 = f32x16{};
    const char* kb[4];
#pragma unroll
    for (int dd = 0; dd < 4; ++dd) kb[dd] = K_lds + KB * SHM_K + KSWZ(r32, (dd * 16 + hi * 8) * 2);
#pragma unroll
    for (int d0 = 0; d0 < 8; ++d0) { const char* a = kb[d0 & 3] + (d0 >> 2) * 128;
        bf16x8 b0 = *reinterpret_cast<const bf16x8*>(a);
        bf16x8 b1 = *reinterpret_cast<const bf16x8*>(a + 32 * 256);
        p0 = __builtin_amdgcn_mfma_f32_32x32x16_bf16(b0, qr[d0], p0, 0, 0, 0);
        p1 = __builtin_amdgcn_mfma_f32_32x32x16_bf16(b1, qr[d0], p1, 0, 0, 0); }
}
template <int VB>
__device__ __forceinline__ void pv_tile(f32x16* o, int vb0, bf16x8 pa0, bf16x8 pa1, bf16x8 pa2, bf16x8 pa3) {
#define TRRD(dst, off) asm volatile("ds_read_b64_tr_b16 %0, %1 offset:%2" : "=&v"(dst) : "v"(vb0), "i"(off) : "memory")
#define PV_D0(d0) do { s16x4 l0, l1, l2, l3, h0, h1, h2, h3; constexpr int b_ = VB * SHM_V + v_rd_off(d0, 0, 0);     \
        TRRD(l0, b_); TRRD(h0, b_ + 2048); TRRD(l1, b_ + 4096); TRRD(h1, b_ + 6144); TRRD(l2, b_ + 8192); TRRD(h2, b_ + 10240); TRRD(l3, b_ + 12288); TRRD(h3, b_ + 14336); \
        asm volatile("s_waitcnt lgkmcnt(0)" ::: "memory"); SBAR();                                                    \
        o[d0] = __builtin_amdgcn_mfma_f32_32x32x16_bf16(pa0, (bf16x8){l0[0], l0[1], l0[2], l0[3], h0[0], h0[1], h0[2], h0[3]}, o[d0], 0, 0, 0);   \
        o[d0] = __builtin_amdgcn_mfma_f32_32x32x16_bf16(pa1, (bf16x8){l1[0], l1[1], l1[2], l1[3], h1[0], h1[1], h1[2], h1[3]}, o[d0], 0, 0, 0);   \
        o[d0] = __builtin_amdgcn_mfma_f32_32x32x16_bf16(pa2, (bf16x8){l2[0], l2[1], l2[2], l2[3], h2[0], h2[1], h2[2], h2[3]}, o[d0], 0, 0, 0);   \
        o[d0] = __builtin_amdgcn_mfma_f32_32x32x16_bf16(pa3, (bf16x8){l3[0], l3[1], l3[2], l3[3], h3[0], h3[1], h3[2], h3[3]}, o[d0], 0, 0, 0); } while (0)
    PV_D0(0); PV_D0(1); PV_D0(2); PV_D0(3);
#undef PV_D0
#undef TRRD
}

struct BlockRef { const bf16_t* Q; const bf16_t* K; const bf16_t* V; const float* G; bf16_t* O; int P0; int jlo; };
struct Seam { bf16x8 qr[8]; bf16x8 st_v0, st_v1, st_k0, st_k1; int gsel; };
#define ROW(p, k0, rr) ((p) + (size_t)((k0) + (rr)) * LD + sc)
#define VMW() asm volatile("s_waitcnt vmcnt(0)" ::: "memory")
#define VMWN(n) asm volatile("s_waitcnt vmcnt(%0)" :: "i"(n) : "memory")
#define SLOAD_H(Kp, Vp, k0) do { S.st_v0 = load8(ROW(Vp, k0, sr)); S.st_v1 = load8(ROW(Vp, k0, 32 + sr));              \
                         S.st_k0 = load8(ROW(Kp, k0, sr)); S.st_k1 = load8(ROW(Kp, k0, 32 + sr)); } while (0)
#define SWRITE_HK(bf) do { *(bf16x8*)(K_lds + (bf) * SHM_K + kws) = S.st_k0; *(bf16x8*)(K_lds + (bf) * SHM_K + kws + 32 * 256) = S.st_k1; } while (0)
#define GDMA(Gp, gb) do { _Pragma("unroll") for (int k_ = 0; k_ < 2; ++k_) __builtin_amdgcn_global_load_lds((const unsigned*)((const char*)(Gp) + k_ * 8192 + tid * 16), \
                           (LAS unsigned*)((LAS char*)(lds_las) + OFF_G + (gb) * GBUF + k_ * 8192 + wid * 1024), 16, 0, 0); } while (0)
#define SWRITE_HV(bf) do { *(bf16x8*)(V_lds + (bf) * SHM_V + vst0) = S.st_v0; *(bf16x8*)(V_lds + (bf) * SHM_V + vst1) = S.st_v1; } while (0)
#define SWRITE_H(bf) do { SWRITE_HV(bf); SWRITE_HK(bf); } while (0)
__device__ __forceinline__ void fox_prime(const BlockRef& cur, char* lds, Seam& S) {
    const int tid = tidx(), wid = __builtin_amdgcn_readfirstlane(tid >> 6), lane = tid & 63, r32 = lane & 31, hi = lane >> 5;
    const int sr = tid >> 4, sc = (tid & 15) * 8, kws = KSWZ(sr, sc * 2); char* K_lds = lds + 2 * SHM_V; LAS char* lds_las = (LAS char*)lds;
    const int kb0 = cur.jlo * KVBLK;
    S.gsel = 0; GDMA(cur.G, 0);
#pragma unroll
    for (int d0 = 0; d0 < 8; ++d0) S.qr[d0] = load8(cur.Q + (size_t)(wid * QBLK + r32) * LD + d0 * 16 + hi * 8);
    SLOAD_H(cur.K, cur.V, kb0); VMW(); SWRITE_HK(0);
    __syncthreads();
}
__device__ __forceinline__ void fox_block(const BlockRef& cur, const BlockRef& nxt, char* lds, Seam& S) {
    const int tid = tidx(), wid = __builtin_amdgcn_readfirstlane(tid >> 6), lane = tid & 63, r32 = lane & 31, hi = lane >> 5;
    const int j_lo = cur.jlo;
    const int j_hi = (cur.P0 + QB - 1) / KVBLK + 1;
    const int NT = j_hi - j_lo;
    const int kbn = nxt.jlo * KVBLK;
    const int qlo = cur.P0 + wid * QBLK, qm = qlo + r32 - 4 * hi;
    char* V_lds = lds; char* K_lds = lds + 2 * SHM_V; LAS char* lds_las = (LAS char*)lds; const float* G_cur = (const float*)(lds + OFF_G + S.gsel * GBUF);
    float* ws = (float*)(lds + OFF_WS) + wid * 64; float* li_l = ws, * al_l = ws + 32;
    float m_reg = -1e30f, l_reg = 0; f32x16 o[4] = {};
    const int sr = tid >> 4, sc = (tid & 15) * 8, vst0 = v_st(sr, sc), vst1 = v_st(32 + sr, sc), kws = KSWZ(sr, sc * 2);
    const int vb0 = (int)(uintptr_t)V_lds + v_rd_base(lane);
    const bf16_t* Kh = cur.K; const bf16_t* Vh = cur.V;
#define RESC(a) do { if (__any((a) < 1.f)) { if (hi == 0) al_l[r32] = (a); asm volatile("s_waitcnt lgkmcnt(0)" ::: "memory");              \
                     for (int d_ = 0; d_ < 4; ++d_) for (int r = 0; r < 16; ++r) o[d_][r] *= al_l[crow(r, hi)]; } } while (0)
#define KBASE(t) ((j_lo + (t)) * KVBLK)
#define BIASMASK(P0_, P1_, t, KB) do { const int kb_ = KBASE(t); bias_tile(P0_, P1_, G_cur + kb_, hi); if (kb_ + KVBLK - 1 > qlo) mask_tile(P0_, P1_, qm - kb_); } while (0)
    constexpr int NQL = 8;
#define SEAM_K0() do { VMWN(NQL); SWRITE_HK(0); SBAR(); } while (0)
    f32x16 pA0, pA1, pB0, pB1; float mnA, mnB, alA, alB; bf16x8 pa0, pa1, pa2, pa3;
    SWRITE_HV(0); SBAR();
    if (NT > 1) { SLOAD_H(Kh, Vh, KBASE(1)); }
    SBAR(); qkt<0>(pA0, pA1, K_lds, r32, hi, S.qr);
    BIASMASK(pA0, pA1, 0, 0); partialSM(pA0, pA1, m_reg, mnA, alA);
    if (NT > 1) { VMW(); SWRITE_H(1); }
    __syncthreads();
#define HALF_STEP(PX0, PX1, mnX, alX, PY0, PY1, alY, t, KB, VB, SB) do {                                                      \
        SBAR(); qkt<KB>(PX0, PX1, K_lds, r32, hi, S.qr);                                                         \
        finishSM(PY0, PY1, alY, l_reg, pa0, pa1, pa2, pa3); SBAR();                                                           \
        if ((t) + 1 < NT) { SLOAD_H(Kh, Vh, KBASE((t) + 1)); SBAR(); }                                                    \
        pv_tile<VB>(o, vb0, pa0, pa1, pa2, pa3); BIASMASK(PX0, PX1, (t), KB); partialSM(PX0, PX1, m_reg, mnX, alX);          \
        __syncthreads();                                                                                                      \
        if ((t) + 1 < NT) { VMW(); SWRITE_H(SB); }                                                                            \
        RESC(alX); __syncthreads(); } while (0)
    for (int t = 1; t + 1 < NT; t += 2) {
        HALF_STEP(pB0, pB1, mnB, alB, pA0, pA1, alA, t, 1, 0, 0);
        HALF_STEP(pA0, pA1, mnA, alA, pB0, pB1, alB, t + 1, 0, 1, 1);
    }
    const bool even = (NT & 1) == 0;
    if (even) { SBAR(); qkt<1>(pB0, pB1, K_lds, r32, hi, S.qr); SBAR(); }
    GDMA(nxt.G, S.gsel ^ 1); SLOAD_H(nxt.K, nxt.V, kbn); SBAR();
#pragma unroll
    for (int d0 = 0; d0 < 8; ++d0) S.qr[d0] = load8(nxt.Q + (size_t)(wid * QBLK + r32) * LD + d0 * 16 + hi * 8);
    SBAR();
    finishSM(pA0, pA1, alA, l_reg, pa0, pa1, pa2, pa3); SBAR();
    pv_tile<0>(o, vb0, pa0, pa1, pa2, pa3);
    if (even) { BIASMASK(pB0, pB1, NT - 1, 1); partialSM(pB0, pB1, m_reg, mnB, alB); __syncthreads(); RESC(alB);
        finishSM(pB0, pB1, alB, l_reg, pa0, pa1, pa2, pa3); SBAR(); pv_tile<1>(o, vb0, pa0, pa1, pa2, pa3); }
    SBAR(); SEAM_K0();
    if (hi == 0) li_l[r32] = l_reg; asm volatile("s_waitcnt lgkmcnt(0)" ::: "memory");
    float rli[16];
#pragma unroll
    for (int r = 0; r < 16; ++r) rli[r] = __builtin_amdgcn_rcpf(li_l[crow(r, hi)]);
    int lane2 = lane; asm volatile("" : "+v"(lane2));
    const int r32b = lane2 & 31, hib = lane2 >> 5;
    bf16_t* Ow = cur.O + (size_t)(wid * QBLK) * LD + r32b;
#pragma unroll
    for (int r = 0; r < 16; ++r) { const int orow = crow(r, hib);
#pragma unroll
        for (int d0 = 0; d0 < 4; ++d0) { const float v = o[d0][r] * rli[r];
            const float vn = __shfl_xor(v, 1);
            if ((r32b & 1) == 0) *(unsigned*)(Ow + (size_t)orow * LD + d0 * 32) = cvt_pk_bf16(v, vn); } }
    S.gsel ^= 1;
    __syncthreads();
#undef RESC
#undef KBASE
#undef BIASMASK
#undef SEAM_K0
#undef HALF_STEP
}
#undef ROW
#undef VMW
#undef VMWN
#undef SLOAD_H
#undef SWRITE_HK
#undef GDMA
#undef SWRITE_HV
#undef SWRITE_H
#undef KSWZ
#undef SBAR
}

__device__ __forceinline__ int gwave() { return blockIdx.x * NWAVES + (tidx() >> 6); }
__device__ __forceinline__ int nwave() { return NBLK * NWAVES; }

__device__ __forceinline__ void cvt_wtile(LAS unsigned char* tl, const float* src, int ld, int Nvalid, bf16_t* dst, int Kdst, int k0, int n0, int drow0, int lane) {
    const int n = n0 + lane;
    float v[64];
    if (n < Nvalid) {
        const float* sp = src + (size_t)k0 * ld + n;
#pragma unroll
        for (int k = 0; k < 64; ++k) v[k] = __builtin_nontemporal_load(sp + (size_t)k * ld);
    } else {
#pragma unroll
        for (int k = 0; k < 64; ++k) v[k] = 0.f;
    }
    LAS unsigned char* wl = tl + (tidx() >> 6) * 9216;
#pragma unroll
    for (int q = 0; q < 8; ++q) {
        u32x4 w; w.x = cvt_pk_bf16(v[8 * q], v[8 * q + 1]); w.y = cvt_pk_bf16(v[8 * q + 2], v[8 * q + 3]); w.z = cvt_pk_bf16(v[8 * q + 4], v[8 * q + 5]); w.w = cvt_pk_bf16(v[8 * q + 6], v[8 * q + 7]);
        *(LAS u32x4*)(wl + lane * 144 + q * 16) = w;
    }
    const int rr = lane >> 3, ch = lane & 7;
#pragma unroll
    for (int it = 0; it < 8; ++it) {
        const u32x4 w = *(LAS u32x4*)(wl + (it * 8 + rr) * 144 + ch * 16);
        *(u32x4*)(dst + (size_t)(drow0 + it * 8 + rr) * Kdst + k0 + ch * 8) = w;
    }
}
__device__ __forceinline__ void cvt_matrix_tile(LAS float* tl, const float* src, int ld, int K, int Nvalid, bf16_t* dst, int mode, int tile, int ntn) {
    const int kt = tile / ntn, nt_ = tile - kt * ntn, n0 = nt_ * 64;
    int drow0 = n0;
    if (mode == 1) drow0 = (n0 >> 7) * 256 + (n0 & 127);
    else if (mode == 2) drow0 = (n0 >> 7) * 256 + 128 + (n0 & 127);
    cvt_wtile((LAS unsigned char*)tl, src, ld, Nvalid, dst, K, kt * 64, n0, drow0, tidx() & 63);
}
struct CvtRef { const float* sp; size_t ld; bf16_t* dp; int Kdst; };
__device__ __forceinline__ CvtRef cvt_moe_ref(const Params& p, int L, int w, int lane) {
    bf16_t* Wgu = (bf16_t*)(p.ws + OFF_WGU + (size_t)L * MOE_LSTRIDE); bf16_t* Wd = (bf16_t*)(p.ws + OFF_WD + (size_t)L * MOE_LSTRIDE);
    int e, which, tile;
    if (w < 65 * 512) { e = w >> 9; which = (w >> 8) & 1; tile = w & 255; } else { const int v = w - 65 * 512; e = v >> 8; which = 2; tile = v & 255; }
    CvtRef c;
    if (which < 2) {
        const float* src = which == 0 ? (e < 64 ? p.w_gate + ((size_t)L * 64 + e) * DM * DEXP : p.sh_gate + (size_t)L * DM * DEXP) : (e < 64 ? p.w_up + ((size_t)L * 64 + e) * DM * DEXP : p.sh_up + (size_t)L * DM * DEXP);
        const int kt = tile >> 3, n0 = (tile & 7) * 64, drow0 = (n0 >> 7) * 256 + which * 128 + (n0 & 127);
        c.sp = src + (size_t)kt * 64 * DEXP + n0 + lane; c.ld = DEXP; c.Kdst = DM; c.dp = Wgu + (size_t)e * 1024 * DM + (size_t)drow0 * DM + kt * 64;
    } else {
        const float* src = e < 64 ? p.w_down + ((size_t)L * 64 + e) * DEXP * DM : p.sh_down + (size_t)L * DEXP * DM;
        const int kt = tile >> 5, n0 = (tile & 31) * 64;
        c.sp = src + (size_t)kt * 64 * DM + n0 + lane; c.ld = DM; c.Kdst = DEXP; c.dp = Wd + (size_t)e * DM * DEXP + (size_t)n0 * DEXP + kt * 64;
    }
    return c;
}
__device__ __forceinline__ void cvt_ld(const CvtRef& c, float (&v)[64]) {
#pragma unroll
    for (int k = 0; k < 64; ++k) v[k] = __builtin_nontemporal_load(c.sp + (size_t)k * c.ld);
}
__device__ __forceinline__ void cvt_st(const CvtRef& c, const float (&v)[64], LAS unsigned char* wl, int lane) {
#pragma unroll
    for (int q = 0; q < 8; ++q) {
        u32x4 w; w.x = cvt_pk_bf16(v[8 * q], v[8 * q + 1]); w.y = cvt_pk_bf16(v[8 * q + 2], v[8 * q + 3]); w.z = cvt_pk_bf16(v[8 * q + 4], v[8 * q + 5]); w.w = cvt_pk_bf16(v[8 * q + 6], v[8 * q + 7]);
        *(LAS u32x4*)(wl + lane * 144 + q * 16) = w;
    }
    const int rr = lane >> 3, ch = lane & 7;
#pragma unroll
    for (int it = 0; it < 8; ++it) {
        const u32x4 w = *(LAS u32x4*)(wl + (it * 8 + rr) * 144 + ch * 16);
        *(u32x4*)(c.dp + (size_t)(it * 8 + rr) * c.Kdst + ch * 8) = w;
    }
}
__device__ __forceinline__ void cvt_moe_run(const Params& p, LAS unsigned char* wl, int L, int w, const int nw, const int total, const int lane) {
    if (w >= total) return;
    float va[64], vb[64];
    CvtRef ca = cvt_moe_ref(p, L, w, lane), cb = ca;
    cvt_ld(ca, va);
    for (;;) {
        const bool hb = w + nw < total;
        cb = cvt_moe_ref(p, L, hb ? w + nw : w, lane); cvt_ld(cb, vb);
        cvt_st(ca, va, wl, lane);
        if (!hb) break;
        w += nw;
        const bool ha = w + nw < total;
        ca = cvt_moe_ref(p, L, ha ? w + nw : w, lane); cvt_ld(ca, va);
        cvt_st(cb, vb, wl, lane);
        if (!ha) break;
        w += nw;
    }
}
__device__ __forceinline__ void cvt_ld4(const CvtRef& c, int lane, f32x4 (&v)[16]) {
    const float* sp = c.sp + (size_t)(lane >> 4) * c.ld + 4 * (lane & 15);
#pragma unroll
    for (int i = 0; i < 16; ++i) v[i] = __builtin_nontemporal_load((const f32x4*)(sp + (size_t)(4 * i) * c.ld));
}
__device__ __forceinline__ void cvt_st4(const CvtRef& c, const f32x4 (&v)[16], LAS unsigned char* wl, int lane) {
    const int cq = lane & 15, r = lane >> 4;
    LAS unsigned char* wp = wl + (4 * cq + (r & 1)) * 136 + (r >> 1) * 4;
#pragma unroll
    for (int i = 0; i < 16; ++i)
#pragma unroll
        for (int jp = 0; jp < 2; ++jp) {
            const auto sw = __builtin_amdgcn_permlane16_swap(__float_as_uint(v[i][2 * jp]), __float_as_uint(v[i][2 * jp + 1]), false, false);
            *(LAS unsigned*)(wp + jp * 272 + i * 8) = cvt_pk_bf16(__uint_as_float(sw[0]), __uint_as_float(sw[1]));
        }
    const int rr = lane >> 3, ch = lane & 7;
#pragma unroll
    for (int it = 0; it < 8; ++it) {
        const u32x2 w0 = *(LAS u32x2*)(wl + (it * 8 + rr) * 136 + ch * 16), w1 = *(LAS u32x2*)(wl + (it * 8 + rr) * 136 + ch * 16 + 8);
        *(u32x4*)(c.dp + (size_t)(it * 8 + rr) * c.Kdst + ch * 8) = (u32x4){w0.x, w0.y, w1.x, w1.y};
    }
}
__device__ __forceinline__ void cvt_moe_run4(const Params& p, LAS unsigned char* wl, int L, int w, const int nw, const int total, const int lane) {
    if (w >= total) return;
    f32x4 va[16], vb[16];
    CvtRef ca = cvt_moe_ref(p, L, w, 0), cb = ca;
    cvt_ld4(ca, lane, va);
    for (;;) {
        const bool hb = w + nw < total;
        cb = cvt_moe_ref(p, L, hb ? w + nw : w, 0); cvt_ld4(cb, lane, vb);
        cvt_st4(ca, va, wl, lane);
        if (!hb) break;
        w += nw;
        const bool ha = w + nw < total;
        ca = cvt_moe_ref(p, L, ha ? w + nw : w, 0); cvt_ld4(ca, lane, va);
        cvt_st4(cb, vb, wl, lane);
        if (!ha) break;
        w += nw;
    }
}
__device__ __forceinline__ void phase_cvt_moe(const Params& p, LAS unsigned char* lds, int L, int total) {
    const int tid = tidx();
    cvt_moe_run(p, lds + (tid >> 6) * 9216, L, gwave(), nwave(), total, tid & 63);
}
__device__ __forceinline__ void phase_cvt_fox(const Params& p, LAS unsigned char* lds) {
    LAS float* tl = (LAS float*)lds;
    bf16_t* WinT = (bf16_t*)(p.ws + OFF_WA + WA_WINT); bf16_t* WoutT = (bf16_t*)(p.ws + OFF_WA + WA_WOUTT);
    const int t_in = 32 * 96, t_out = 32 * 32;
    for (int w = gwave(); w < t_in + t_out; w += nwave()) {
        if (w < t_in) cvt_matrix_tile(tl, p.a_w_in, 6160, DM, 6144, WinT, 0, w, 96);
        else cvt_matrix_tile(tl, p.a_w_out, DM, DM, DM, WoutT, 0, w - t_in, 32);
    }
    bf16_t* xb = (bf16_t*)(p.ws + OFF_XB);
    const size_t n8 = (size_t)NTOK * DM / 8, stride = (size_t)NBLK * NTHREADS;
    for (size_t i = (size_t)blockIdx.x * NTHREADS + tidx(); i < n8; i += 4 * stride) {
        f32x4 a[4], b[4];
#pragma unroll
        for (int u = 0; u < 4; ++u) { const size_t j = i + u * stride; if (j < n8) { a[u] = __builtin_nontemporal_load((const f32x4*)(p.x + j * 8)); b[u] = __builtin_nontemporal_load((const f32x4*)(p.x + j * 8 + 4)); } }
#pragma unroll
        for (int u = 0; u < 4; ++u) { const size_t j = i + u * stride; if (j < n8) *(bf16x8*)(xb + j * 8) = pack8(a[u], b[u]); }
    }
}
__device__ __forceinline__ void phase_cvt_dsa(const Params& p, LAS unsigned char* lds) {
    LAS float* tl = (LAS float*)lds;
    bf16_t* WbinT = (bf16_t*)(p.ws + OFF_WA + WA_WBINT); bf16_t* Wq2T = (bf16_t*)(p.ws + OFF_WA + WA_WQ2T); bf16_t* WoutTB = (bf16_t*)(p.ws + OFF_WA + WA_WOUTTB); bf16_t* WuvBD = (bf16_t*)(p.ws + OFF_WA + WA_WUVOT);
    const int t0 = 32 * 16, t1 = 8 * 16, t2 = 32 * 32, t3 = 16 * 8;
    for (int w = gwave(); w < t0 + t1 + t2 + t3; w += nwave()) {
        if (w < t0) cvt_matrix_tile(tl, p.b_w_in, BW, DM, BW, WbinT, 0, w, 16);
        else if (w < t0 + t1) cvt_matrix_tile(tl, p.b_w_iq, 1024, QLAT, 1024, Wq2T + (size_t)4096 * QLAT, 0, w - t0, 16);
        else if (w < t0 + t1 + t2) cvt_matrix_tile(tl, p.b_w_out, DM, DM, DM, WoutTB, 0, w - t0 - t1, 32);
        else { const int v = w - t0 - t1 - t2, h = v >> 3, kt = (v >> 1) & 3, nt_ = v & 1;
            cvt_wtile((LAS unsigned char*)tl, p.b_w_uv + (size_t)h * KVLAT * 128, 128, 128, WuvBD + (size_t)(h * 128) * 4096 + h * 256, 4096, kt * 64, nt_ * 64, nt_ * 64, tidx() & 63); }
    }
    for (int i = blockIdx.x * NTHREADS + tidx(); i < 2048 * 32; i += NBLK * NTHREADS) { const int n = i >> 5, ch = i & 31, h = n >> 7;
        *(u32x4*)(WuvBD + (size_t)n * 4096 + (h ^ 1) * 256 + ch * 8) = (u32x4){0u, 0u, 0u, 0u}; }
}
__device__ __forceinline__ bf16x8 ld8_f32(const float* p) { return pack8(*(const f32x4*)p, *(const f32x4*)(p + 4)); }
__device__ __forceinline__ void phase_wprep(const Params& p) {
    const int lane = tidx() & 63, fr = lane & 15, fq = lane >> 4;
    bf16_t* Wq2T = (bf16_t*)(p.ws + OFF_WA + WA_WQ2T);
    const int nq = 16 * 16 * 32;
    for (int w = gwave(); w < nq; w += nwave()) {
        f32x4 acc = (f32x4){0.f, 0.f, 0.f, 0.f};
        {
            const int h = w >> 9, ct = (w >> 5) & 15, lt = w & 31, c0 = ct * 16, l0 = lt * 16;
#pragma unroll
            for (int ks = 0; ks < 4; ++ks) {
                const bf16x8 a = ld8_f32(p.b_w_uq + (size_t)(l0 + fr) * 2048 + h * 128 + ks * 32 + fq * 8);
 bf16x8 b = ld8_f32(p.b_w_uk + ((size_t)h * 256 + c0 + fr) * 128 + ks * 32 + fq * 8);
                asm volatile("s_nop 7" : "+v"(b));
                acc = __builtin_amdgcn_mfma_f32_16x16x32_bf16(a, b, acc, 0, 0, 0);
            }
            mfma_fence(acc);
            u32x2 o; o.x = cvt_pk_bf16(acc[0], acc[1]); o.y = cvt_pk_bf16(acc[2], acc[3]);
            *(u32x2*)(Wq2T + (size_t)(h * 256 + c0 + fr) * QLAT + l0 + 4 * fq) = o;
        }
    }
}

__device__ __forceinline__ void phase_cvt_router(const Params& p) {
    bf16_t* rwt = (bf16_t*)(p.ws + OFF_ROUTE + RWT_BYTE_OFF);
    for (int i = blockIdx.x * NTHREADS + tidx(); i < 2 * DM * 16; i += NBLK * NTHREADS) {
        const int L = i >> 15, d = (i >> 4) & 2047, e4 = (i & 15) * 4;
        const f32x4 w = *(const f32x4*)(p.router_w + ((size_t)L * DM + d) * NEXP + e4);
#pragma unroll
        for (int k = 0; k < 4; ++k) { const unsigned h = cvt_pk_bf16(w[k], 0.f) & 0xffffu; const float lo = w[k] - __uint_as_float(h << 16);
            rwt[((size_t)L * 128 + e4 + k) * DM + d] = (bf16_t)h; rwt[((size_t)L * 128 + 64 + e4 + k) * DM + d] = (bf16_t)(cvt_pk_bf16(lo, 0.f) & 0xffffu); }
    }
}
__device__ __forceinline__ void phase_cvt_fgate(const Params& p) {
    bf16_t* fwt = (bf16_t*)(p.ws + OFF_ROUTE + FWT_BYTE_OFF);
    for (int i = blockIdx.x * NTHREADS + tidx(); i < DM * 16; i += NBLK * NTHREADS) {
        const int d = i >> 4, h = i & 15;
        const float w = p.a_w_in[(size_t)d * 6160 + 6144 + h];
        const unsigned hb = cvt_pk_bf16(w, 0.f) & 0xffffu; const float lo = w - __uint_as_float(hb << 16);
        fwt[(size_t)h * DM + d] = (bf16_t)hb; fwt[(size_t)(16 + h) * DM + d] = (bf16_t)(cvt_pk_bf16(lo, 0.f) & 0xffffu);
    }
}
__device__ __forceinline__ void phase_fgate(const Params& p) {
    const int tid = tidx(), wid = tid >> 6, lane = tid & 63, fr = lane & 15, fq = lane >> 4;
    float* logf = (float*)(p.ws + OFF_BIG + BG_LOGF); const bf16_t* fwt = (const bf16_t*)(p.ws + OFF_ROUTE + FWT_BYTE_OFF);
    if (wid >= 4) return;
    for (int g = blockIdx.x; g < NTOK / 64; g += NBLK) {
        const int tok0 = g * 64 + wid * 16;
        const float* xa = p.x + (size_t)(tok0 + fr) * DM + fq * 8;
        const bf16_t* bh = fwt + (size_t)fr * DM + fq * 8;
        f32x4 acc = (f32x4){0.f, 0.f, 0.f, 0.f};
#pragma unroll 4
        for (int ks = 0; ks < 64; ++ks) {
            const f32x4 x0 = *(const f32x4*)(xa + ks * 32), x1 = *(const f32x4*)(xa + ks * 32 + 4);
            u32x4 hw = {cvt_pk_bf16(x0[0], x0[1]), cvt_pk_bf16(x0[2], x0[3]), cvt_pk_bf16(x1[0], x1[1]), cvt_pk_bf16(x1[2], x1[3])};
            f32x4 r0, r1;
#pragma unroll
            for (int i = 0; i < 4; ++i) { r0[i] = x0[i] - __uint_as_float(i & 1 ? hw[i >> 1] & 0xffff0000u : hw[i >> 1] << 16); r1[i] = x1[i] - __uint_as_float(i & 1 ? hw[2 + (i >> 1)] & 0xffff0000u : hw[2 + (i >> 1)] << 16); }
            bf16x8 ah = *reinterpret_cast<bf16x8*>(&hw), al = pack8(r0, r1);
            asm volatile("s_nop 1" : "+v"(ah), "+v"(al));
            const bf16x8 wh = *(const bf16x8*)(bh + ks * 32), wl = *(const bf16x8*)(bh + (size_t)16 * DM + ks * 32);
            acc = __builtin_amdgcn_mfma_f32_16x16x32_bf16(ah, wh, acc, 0, 0, 0);
            acc = __builtin_amdgcn_mfma_f32_16x16x32_bf16(ah, wl, acc, 0, 0, 0);
            acc = __builtin_amdgcn_mfma_f32_16x16x32_bf16(al, wh, acc, 0, 0, 0);
        }
        const float bf = p.a_b_f[fr];
#pragma unroll
        for (int i = 0; i < 4; ++i) { const float z = acc[i] + bf; logf[(size_t)(tok0 + 4 * fq + i) * 16 + fr] = fminf(z, 0.f) - log1pf(expf(-fabsf(z))); }
    }
}
__device__ __forceinline__ void phase_scan(const Params& p, LAS unsigned char* lds) {
    const int tid = tidx(), lane = tid & 63, wid = tid >> 6;
    const float* logf = (const float*)(p.ws + OFF_BIG + BG_LOGF); float* G = (float*)(p.ws + OFF_BIG + BG_G);
    LAS float* wt = (LAS float*)lds;
    for (int bh = blockIdx.x; bh < NBATCH * NHEAD; bh += NBLK) {
        const int b = bh >> 4, h = bh & 15, s0 = tid * 8;
        float v[8]; float tot = 0.f;
#pragma unroll
        for (int j = 0; j < 8; ++j) { v[j] = logf[((size_t)b * SEQ + s0 + j) * 16 + h]; tot += v[j]; }
        float inc = tot;
#pragma unroll
        for (int o = 1; o < 64; o <<= 1) { const float y = __shfl_up(inc, o); if (lane >= o) inc += y; }
        __syncthreads();
        if (lane == 63) wt[wid] = inc;
        __syncthreads();
        float run = inc - tot;
#pragma unroll
        for (int k = 0; k < 8; ++k) run += k < wid ? wt[k] : 0.f;
        f32x4 o0, o1;
#pragma unroll
        for (int j = 0; j < 4; ++j) { run += v[j]; o0[j] = -run * 11.313708498984761f; }
#pragma unroll
        for (int j = 0; j < 4; ++j) { run += v[4 + j]; o1[j] = -run * 11.313708498984761f; }
        *(f32x4*)(G + (size_t)bh * SEQ + s0) = o0; *(f32x4*)(G + (size_t)bh * SEQ + s0 + 4) = o1;
    }
}
__device__ __forceinline__ int fox_jlo(const Params& p, int item, int pass) {
    const int bh = item >> 3, x = item & 7, qb = pass ? 15 - x : x;
    const float* G = (const float*)(p.ws + OFF_BIG + BG_G) + (size_t)bh * SEQ; const float* NRM = (const float*)(p.ws + OFF_BIG + BG_NRM);
    const int J = tidx() & 63;
    const float* nq = NRM + (size_t)bh * 128, * nk = NRM + (size_t)(64 + bh) * 128;
    float q2 = 0.f, k2 = 0.f;
#pragma unroll
    for (int i = 0; i < 4; ++i) { q2 = fmaxf(q2, nq[(4 * qb + i) * 2] + nq[(4 * qb + i) * 2 + 1]); k2 = fmaxf(k2, nk[(4 * qb + i) * 2] + nk[(4 * qb + i) * 2 + 1]); }
    const float qn = sqrtf(q2), kI = sqrtf(k2), kn = sqrtf(nk[J * 2] + nk[J * 2 + 1]);
    const float Ft0 = -G[qb * 256] * fox::SCALE, Fl = -G[64 * J + 63] * fox::SCALE;
    const float ub = fox::SCALE * qn * (kn + kI) * 1.01f + (Ft0 - Fl);
    const bool skip = (ub < -50.0f) && (64 * J + 63 < qb * 256);
    const unsigned long long keep = __ballot(!skip);
    return keep ? (int)__builtin_ctzll(keep) : 0;
}
__device__ __forceinline__ fox::BlockRef fox_ref(const Params& p, int item, int pass, int jlo) {
    const int bh = item >> 3, x = item & 7, b = bh >> 4, h = bh & 15, qb = pass ? 15 - x : x;
    const bf16_t* Q = (const bf16_t*)(p.ws + OFF_BIG + BG_Q); const bf16_t* K = (const bf16_t*)(p.ws + OFF_BIG + BG_K); const bf16_t* V = (const bf16_t*)(p.ws + OFF_BIG + BG_V);
    bf16_t* O = (bf16_t*)(p.ws + OFF_BIG + BG_O); const float* G = (const float*)(p.ws + OFF_BIG + BG_G);
    fox::BlockRef r;
    const size_t hb = (size_t)b * SEQ * DM + (size_t)h * HDIM;
    r.Q = Q + hb + (size_t)qb * 256 * DM; r.O = O + hb + (size_t)qb * 256 * DM; r.K = K + hb; r.V = V + hb; r.G = G + (size_t)bh * SEQ; r.P0 = qb * 256; r.jlo = jlo;
    return r;
}
__device__ __forceinline__ void phase_fox_attn(const Params& p, LAS unsigned char* lds_) {
    char* lds = (char*)lds_;
    const int total = NBATCH * NHEAD * 8, stride = NBLK;
    int L = blockIdx.x; if (L >= total) return;
    LAS int* jl = (LAS int*)(lds_ + fox::LDS_BYTES);
    { int slot = 0;
      for (int it = L; it < total && slot < 16; it += stride, slot += 2) { const int j0 = fox_jlo(p, it, 0), j1 = fox_jlo(p, it, 1); if (tidx() == 0) { jl[slot] = j0; jl[slot + 1] = j1; } }
      __syncthreads(); }
    int pass = 0, slot = 0;
    fox::BlockRef cur = fox_ref(p, L, 0, __builtin_amdgcn_readfirstlane(jl[0]));
    fox::Seam S;
    fox::fox_prime(cur, lds, S);
    for (;;) {
        const bool more_pass = pass == 0, more_item = L + stride < total, last = !more_pass && !more_item;
        int passn = pass + 1, Ln = L;
        if (!more_pass) { passn = 0; Ln = more_item ? L + stride : L; }
        const int slotn = last ? slot : slot + 1;
        const fox::BlockRef nxt = last ? cur : fox_ref(p, Ln, passn, __builtin_amdgcn_readfirstlane(jl[slotn & 15]));
        fox::fox_block(cur, nxt, lds, S);
        if (last) break;
        cur = nxt; pass = passn; L = Ln; slot = slotn;
    }
}

__device__ __forceinline__ void ln_row_store(float (&v)[32], const float* g, const float* bt, float* yf, bf16_t* yhi, bf16_t* ylo, int lane) {
    float s = 0.f;
#pragma unroll
    for (int i = 0; i < 32; ++i) s += v[i];
    const float mean = wave_sum(s) * (1.0f / DM);
    float q = 0.f;
#pragma unroll
    for (int i = 0; i < 32; ++i) { const float d = v[i] - mean; q += d * d; }
    const float var = wave_sum(q) * (1.0f / DM);
    const float rstd = 1.0f / sqrtf(var + LN_EPS);
#pragma unroll
    for (int j = 0; j < 4; ++j) {
        const int c = j * 512 + lane * 8;
        const f32x4 g0 = *(const f32x4*)(g + c), g1 = *(const f32x4*)(g + c + 4), b0 = *(const f32x4*)(bt + c), b1 = *(const f32x4*)(bt + c + 4);
        f32x4 y0, y1;
#pragma unroll
        for (int i = 0; i < 4; ++i) { y0[i] = (v[j * 8 + i] - mean) * rstd * g0[i] + b0[i]; y1[i] = (v[j * 8 + 4 + i] - mean) * rstd * g1[i] + b1[i]; }
        if (yf) { *(f32x4*)(yf + c) = y0; *(f32x4*)(yf + c + 4) = y1; }
        else {
            const u32x4 hw = {cvt_pk_bf16(y0[0], y0[1]), cvt_pk_bf16(y0[2], y0[3]), cvt_pk_bf16(y1[0], y1[1]), cvt_pk_bf16(y1[2], y1[3])};
            f32x4 r0, r1;
#pragma unroll
            for (int i = 0; i < 4; ++i) { r0[i] = y0[i] - __uint_as_float(i & 1 ? hw[i >> 1] & 0xffff0000u : hw[i >> 1] << 16); r1[i] = y1[i] - __uint_as_float(i & 1 ? hw[2 + (i >> 1)] & 0xffff0000u : hw[2 + (i >> 1)] << 16); }
            *(u32x4*)(yhi + c) = hw; *(bf16x8*)(ylo + c) = pack8(r0, r1);
        }
    }
}
__device__ __forceinline__ void ld_hilo8(const bf16_t* hi, const bf16_t* lo, float (&o)[8]) {
    const u32x4 h = *(const u32x4*)hi, l = *(const u32x4*)lo;
#pragma unroll
    for (int i = 0; i < 4; ++i) { o[2 * i] = __uint_as_float(h[i] << 16) + __uint_as_float(l[i] << 16); o[2 * i + 1] = __uint_as_float(h[i] & 0xffff0000u) + __uint_as_float(l[i] & 0xffff0000u); }
}
__device__ __forceinline__ void phase_router(const Params& p, LAS unsigned char* lds, bf16_t* xhi, bf16_t* xlo, const bf16_t* rwt, const float* rb,
                                             const float* xin, const bf16_t* mres, const float* lng, const float* lnb) {
    LAS float* sbl = (LAS float*)lds;
    LAS float* lg = sbl + 8192;
    LAS unsigned char* flag = (LAS unsigned char*)(lg + 4096);
    LAS int* sel_l = (LAS int*)(flag + 4096);
    LAS unsigned long long* Me = (LAS unsigned long long*)(sel_l + 512);
    unsigned* ctrl = (unsigned*)(p.ws + OFF_CTRL); int* rt = (int*)(p.ws + OFF_ROUTE);
    const int tid = tidx(), lane = tid & 63, wid = __builtin_amdgcn_readfirstlane(tid >> 6);
    for (int g = blockIdx.x; g < NTOK / 64; g += NBLK) {
        const int tok0 = g * 64;
        __syncthreads();
        {
            for (int q = 0; q < 8; ++q) { const int t = tok0 + wid * 8 + q;
                float v[32];
#pragma unroll
                for (int j = 0; j < 4; ++j) {
                    const size_t o = (size_t)t * DM + j * 512 + lane * 8;
                    float a[8];
                    if (xin) { const f32x4 a0 = *(const f32x4*)(xin + o), a1 = *(const f32x4*)(xin + o + 4);
#pragma unroll
                        for (int i = 0; i < 4; ++i) { a[i] = a0[i]; a[4 + i] = a1[i]; } }
                    else ld_hilo8(xhi + o, xlo + o, a);
                    const u32x4 mw = *(const u32x4*)(mres + o);
#pragma unroll
                    for (int i = 0; i < 8; ++i) v[j * 8 + i] = ALPHA * a[i] + __uint_as_float(i & 1 ? mw[i >> 1] & 0xffff0000u : mw[i >> 1] << 16);
                }
                ln_row_store(v, lng, lnb, nullptr, xhi + (size_t)t * DM, xlo + (size_t)t * DM, lane);
            }
            asm volatile("s_waitcnt vmcnt(0)" ::: "memory");
            __syncthreads();
        }
        {
            const int fr = lane & 15, fq = lane >> 4, mt = wid & 3, nh = wid >> 2;
            f32x4 acc[2] = {(f32x4){0.f, 0.f, 0.f, 0.f}, (f32x4){0.f, 0.f, 0.f, 0.f}};
            const bf16_t* xah = xhi + (size_t)(tok0 + 16 * mt + fr) * DM + fq * 8; const bf16_t* xal = xlo + (size_t)(tok0 + 16 * mt + fr) * DM + fq * 8;
            const bf16_t* bh = rwt + (size_t)(32 * nh + fr) * DM + fq * 8;
#pragma unroll 4
            for (int ks = 0; ks < 64; ++ks) {
                const bf16x8 ah = *(const bf16x8*)(xah + ks * 32), al = *(const bf16x8*)(xal + ks * 32);
#pragma unroll
                for (int nt = 0; nt < 2; ++nt) {
                    const bf16x8 wh = *(const bf16x8*)(bh + (size_t)(16 * nt) * DM + ks * 32), wl = *(const bf16x8*)(bh + (size_t)(64 + 16 * nt) * DM + ks * 32);
                    acc[nt] = __builtin_amdgcn_mfma_f32_16x16x32_bf16(ah, wh, acc[nt], 0, 0, 0);
                    acc[nt] = __builtin_amdgcn_mfma_f32_16x16x32_bf16(ah, wl, acc[nt], 0, 0, 0);
                    acc[nt] = __builtin_amdgcn_mfma_f32_16x16x32_bf16(al, wh, acc[nt], 0, 0, 0);
                }
            }
#pragma unroll
            for (int nt = 0; nt < 2; ++nt)
#pragma unroll
                for (int i = 0; i < 4; ++i) lg[(16 * mt + 4 * fq + i) * 64 + 32 * nh + 16 * nt + fr] = acc[nt][i];
        }
        __syncthreads();
        const float bias = rb[lane];
        for (int q = 0; q < 8; ++q) {
            const int i = wid * 8 + q, t = tok0 + i;
            const float z = lg[i * 64 + lane];
            const float score = 1.0f / (1.0f + expf(-z));
            const float sb = score + bias;
            sbl[i * 64 + lane] = sb;
            int rank = 0;
#pragma unroll
            for (int m4 = 0; m4 < 16; ++m4) { const f32x4 o = *(LAS f32x4*)(sbl + i * 64 + 4 * m4);
                rank += (int)(o[0] > sb); rank += (int)(o[1] > sb); rank += (int)(o[2] > sb); rank += (int)(o[3] > sb); }
            bool taken = rank < 8;
            bool ok = __builtin_popcountll(__ballot(taken)) == 8;
#pragma unroll
            for (int r = 0; r < 8; ++r) ok = ok && (__builtin_popcountll(__ballot(rank == r)) == 1);
            float gsum = 0.f;
            if (ok) {
                const float gmine = taken ? score : 0.f;
                gsum = wave_sum(gmine);
                if (taken) { rt[RT_SEL + (size_t)t * 8 + rank] = lane; ((float*)rt)[RT_GATE + (size_t)t * 8 + rank] = score / gsum * ROUTED_SCALE; sel_l[i * 8 + rank] = lane; }
            } else {
                taken = false; int myidx = 0; float mygate = 0.f;
#pragma unroll 1
                for (int r = 0; r < 8; ++r) {
                    float v = taken ? -__builtin_inff() : sb; int idx = lane;
#pragma unroll
                    for (int o = 32; o >= 1; o >>= 1) { const float ov = __shfl_xor(v, o); const int oi = __shfl_xor(idx, o); if (ov > v || (ov == v && oi < idx)) { v = ov; idx = oi; } }
                    const float gs = __shfl(score, idx);
                    if (lane == idx) taken = true;
                    if (lane == r) { myidx = idx; mygate = gs; }
                    gsum += gs;
                }
                if (lane < 8) { rt[RT_SEL + (size_t)t * 8 + lane] = myidx; ((float*)rt)[RT_GATE + (size_t)t * 8 + lane] = mygate / gsum * ROUTED_SCALE; sel_l[i * 8 + lane] = myidx; }
            }
            flag[i * 64 + lane] = taken ? 1 : 0;
        }
        __syncthreads();
        if (tid < 64) { unsigned long long M = 0ull;
            for (int i = 0; i < 64; ++i) M |= (unsigned long long)flag[i * 64 + tid] << i;
            Me[tid] = M; ctrl[CW_HIST + g * 64 + tid] = (unsigned)__builtin_popcountll(M); }
        __syncthreads();
        { const int i = tid >> 3, r = tid & 7, e = sel_l[i * 8 + r];
          const unsigned long long M = Me[e], below = (i == 0) ? 0ull : (M & ((1ull << i) - 1ull));
          rt[RT_RANK + (size_t)(tok0 + i) * 8 + r] = __builtin_popcountll(below); }
        __syncthreads();
    }
}
__device__ __forceinline__ void phase_route_pos(const Params& p, LAS unsigned char* lds) {
    LAS int* base_l = (LAS int*)lds; LAS int* cnt_l = base_l + 64; LAS int* rs_l = cnt_l + 64; LAS int* ts_l = rs_l + 64; LAS int* ntr_l = ts_l + 64; LAS int* part_l = ntr_l + 64;
    unsigned* ctrl = (unsigned*)(p.ws + OFF_CTRL); int* rt = (int*)(p.ws + OFF_ROUTE);
    const int tid = tidx(), lane = tid & 63;
    for (int g = blockIdx.x; g < NTOK / 64; g += NBLK) {
        __syncthreads();
        { const int e = tid & 63, pt = tid >> 6; int base = 0, tot = 0;
#pragma unroll 8
          for (int k = 0; k < 32; ++k) { const int gg = pt * 32 + k; const int hv = (int)ctrl[CW_HIST + gg * 64 + e]; tot += hv; base += gg < g ? hv : 0; }
          part_l[(pt * 64 + e) * 2] = base; part_l[(pt * 64 + e) * 2 + 1] = tot; }
        __syncthreads();
        if (tid < 64) { int base = 0, tot = 0;
#pragma unroll
            for (int k = 0; k < 8; ++k) { base += part_l[(k * 64 + tid) * 2]; tot += part_l[(k * 64 + tid) * 2 + 1]; }
            base_l[tid] = base; cnt_l[tid] = tot;
            const int ntl = (tot + 255) >> 8; int inc = ntl;
#pragma unroll
            for (int o = 1; o < 64; o <<= 1) { const int y = __shfl_up(inc, o); if (lane >= o) inc += y; }
            ts_l[tid] = inc - ntl; rs_l[tid] = (inc - ntl) * 256; if (tid == 63) ntr_l[0] = inc; }
        __syncthreads();
        { const int i = tid >> 3, r = tid & 7, t = g * 64 + i;
          const int e = rt[RT_SEL + (size_t)t * 8 + r], rank = rt[RT_RANK + (size_t)t * 8 + r];
          const int pos = rs_l[e] + base_l[e] + rank;
          rt[RT_POS + (size_t)t * 8 + r] = pos; rt[RT_ROWTOK + pos] = t; }
        if (tid < 64) rt[RT_ROWTOK + SH_TILE0 * 256 + g * 64 + tid] = g * 64 + tid;
        if (g < 64) { const int e = g, c = cnt_l[e], ntl = (c + 255) >> 8, padn = ntl * 256 - c, ts = ts_l[e], ntr = ntr_l[0];
            if (tid < padn) rt[RT_ROWTOK + rs_l[e] + c + tid] = 0;
            for (int k = tid; k < ntl; k += NTHREADS) { ctrl[CW_TILE_E + ts + k] = (unsigned)e; ctrl[CW_TILE_RT + ts + k] = (unsigned)(ts + k); }
            if (tid == 0) { ctrl[CW_TILE_E + ntr + g] = 64u; ctrl[CW_TILE_RT + ntr + g] = (unsigned)(SH_TILE0 + g); if (g == 0) ctrl[CW_NTILES] = (unsigned)(ntr + 64); } }
    }
}
template <bool FP8>
__device__ __forceinline__ void phase_combine_ln2(const Params& p, bf16_t* xhi, bf16_t* xlo, const float* g, const float* bt, float* yf) {
    const int lane = tidx() & 63;
    const bf16_t* Ys = (const bf16_t*)(p.ws + OFF_BIG + BG_YS); const int* rt = (const int*)(p.ws + OFF_ROUTE);
    for (int t = gwave(); t < NTOK; t += nwave()) {
        float v[32];
#pragma unroll
        for (int i = 0; i < 32; ++i) v[i] = 0.f;
        constexpr int RG = FP8 ? 5 : 3;
#pragma unroll 1
        for (int r3 = 0; r3 < (9 + RG - 1) / RG; ++r3) {
            u32x4 w[FP8 ? 1 : RG][4]; u32x2 w8[FP8 ? RG : 1][4]; float gt[RG];
#pragma unroll
            for (int q = 0; q < RG; ++q) {
                const int r = r3 * RG + q, rr = r < 8 ? r : 0;
                int pos = rt[RT_POS + (size_t)t * 8 + rr]; gt[q] = ((const float*)rt)[RT_GATE + (size_t)t * 8 + rr];
                if (r == 8) { pos = SH_TILE0 * 256 + t; gt[q] = 1.0f; }
                if (r > 8) gt[q] = 0.f;
                if constexpr (FP8) { const unsigned char* row = (const unsigned char*)Ys + (size_t)pos * DM; gt[q] *= (1.0f / 64.0f);
#pragma unroll
                    for (int j = 0; j < 4; ++j) w8[q][j] = *(const u32x2*)(row + j * 512 + lane * 8); }
                else { const bf16_t* row = Ys + (size_t)pos * DM;
#pragma unroll
                    for (int j = 0; j < 4; ++j) w[q][j] = *(const u32x4*)(row + j * 512 + lane * 8); }
            }
#pragma unroll
            for (int q = 0; q < RG; ++q)
#pragma unroll
                for (int j = 0; j < 4; ++j) {
                    if constexpr (FP8) {
                        const auto f0 = __builtin_amdgcn_cvt_pk_f32_fp8((int)w8[q][j].x, false), f1 = __builtin_amdgcn_cvt_pk_f32_fp8((int)w8[q][j].x, true), f2 = __builtin_amdgcn_cvt_pk_f32_fp8((int)w8[q][j].y, false), f3 = __builtin_amdgcn_cvt_pk_f32_fp8((int)w8[q][j].y, true);
                        v[j * 8 + 0] += gt[q] * f0[0]; v[j * 8 + 1] += gt[q] * f0[1]; v[j * 8 + 2] += gt[q] * f1[0]; v[j * 8 + 3] += gt[q] * f1[1];
                        v[j * 8 + 4] += gt[q] * f2[0]; v[j * 8 + 5] += gt[q] * f2[1]; v[j * 8 + 6] += gt[q] * f3[0]; v[j * 8 + 7] += gt[q] * f3[1];
                    } else {
#pragma unroll
                        for (int i = 0; i < 4; ++i) { v[j * 8 + 2 * i] += gt[q] * __uint_as_float(w[q][j][i] << 16); v[j * 8 + 2 * i + 1] += gt[q] * __uint_as_float(w[q][j][i] & 0xffff0000u); } } }
        }
#pragma unroll
        for (int j = 0; j < 4; ++j) { const size_t o = (size_t)t * DM + j * 512 + lane * 8;
            float a[8]; ld_hilo8(xhi + o, xlo + o, a);
#pragma unroll
            for (int i = 0; i < 8; ++i) v[j * 8 + i] += ALPHA * a[i]; }
        ln_row_store(v, g, bt, yf ? yf + (size_t)t * DM : nullptr, xhi + (size_t)t * DM, xlo + (size_t)t * DM, lane);
    }
}
__device__ __forceinline__ void phase_dsa_prep(const Params& p) {
    const int lane = tidx() & 63;
    const float* proj = (const float*)(p.ws + OFF_BIG + BG_PROJ);
    bf16_t* cq = (bf16_t*)(p.ws + OFF_BIG + BG_CQ); bf16_t* ckv = (bf16_t*)(p.ws + OFF_BIG + BG_CKV); bf16_t* kidx = (bf16_t*)(p.ws + OFF_BIG + BG_KIDX); float* widx = (float*)(p.ws + OFF_BIG + BG_WIDX);
    for (int t = gwave(); t < NTOK; t += nwave()) {
        const float* row = proj + (size_t)t * 1024;
        const f32x4 a0 = *(const f32x4*)(row + lane * 8), a1 = *(const f32x4*)(row + lane * 8 + 4);
        float s = 0.f;
#pragma unroll
        for (int i = 0; i < 4; ++i) s += a0[i] * a0[i] + a1[i] * a1[i];
        const float rq = 1.0f / sqrtf(wave_sum(s) * (1.0f / QLAT) + RMS_EPS);
        const f32x4 g0 = *(const f32x4*)(p.b_q_norm + lane * 8), g1 = *(const f32x4*)(p.b_q_norm + lane * 8 + 4);
        *(bf16x8*)(cq + (size_t)t * QLAT + lane * 8) = pack8(a0 * rq * g0, a1 * rq * g1);
        const f32x4 c0 = *(const f32x4*)(row + 512 + lane * 4);
        float s2 = 0.f;
#pragma unroll
        for (int i = 0; i < 4; ++i) s2 += c0[i] * c0[i];
        const float rk = 1.0f / sqrtf(wave_sum(s2) * (1.0f / KVLAT) + RMS_EPS);
        const f32x4 gk = *(const f32x4*)(p.b_kv_norm + lane * 4);
        const f32x4 ck = c0 * rk * gk;
        u32x2 o; o.x = cvt_pk_bf16(ck[0], ck[1]); o.y = cvt_pk_bf16(ck[2], ck[3]);
        *(u32x2*)(ckv + (size_t)t * KVLAT + lane * 4) = o;
        const float kv = row[768 + lane], kn = __shfl_down(kv, 1);
        if ((lane & 1) == 0) *(unsigned*)(kidx + (size_t)t * IDXD + lane) = cvt_pk_bf16(kv, kn);
        if (lane < 16) widx[(size_t)t * 16 + lane] = row[832 + lane] * 0.25f;
    }
}

__device__ __forceinline__ unsigned f2sortable(float v) { const unsigned b = __float_as_uint(v); return b ^ ((b >> 31) ? 0xffffffffu : 0x80000000u); }
__device__ __forceinline__ void phase_indexer(const Params& p, LAS unsigned char* lds) {
    const int tid = tidx(), wid = __builtin_amdgcn_readfirstlane(tid >> 6), lane = tid & 63, fr = lane & 15, fq = lane >> 4;
    const bf16_t* qidx = (const bf16_t*)(p.ws + OFF_BIG + BG_QIDX); const bf16_t* kidx = (const bf16_t*)(p.ws + OFF_BIG + BG_KIDX); const float* widx = (const float*)(p.ws + OFF_BIG + BG_WIDX);
    int* sel = (int*)(p.ws + OFF_BIG + BG_SEL); int* nsel = (int*)(p.ws + OFF_BIG + BG_NSEL);
    const int skey = tid >> 3, sc = tid & 7;
    const int swr = skey * 128 + ((sc ^ ((skey >> 1) & 7)) << 4);
    const int k32 = lane & 31, hi = lane >> 5;
    LAS unsigned char* rdb[4];
#pragma unroll
    for (int ks = 0; ks < 4; ++ks) rdb[ks] = lds + k32 * 128 + ((((2 * ks + hi)) ^ ((k32 >> 1) & 7)) << 4);
    for (int pr = blockIdx.x; pr < 256; pr += NBLK)
    for (int tk = 0; tk < 8; ++tk) {
        const int b = tk >> 1, pg = (tk & 1) ? 511 - pr : pr;
        const int pos = pg * 8 + wid, t = b * SEQ + pos, nchunks = (pg >> 3) + 1, kmax = nchunks * 64;
        int* selp = sel + (size_t)t * IDXTOPK;
        if (kmax <= IDXTOPK) {
#pragma unroll
            for (int k = 0; k < 4; ++k) if (lane + 64 * k < kmax) selp[lane + 64 * k] = lane + 64 * k;
            if (lane == 0) nsel[t] = kmax;
            continue;
        }
        bf16x8 qa[4];
#pragma unroll
        for (int ks = 0; ks < 4; ++ks) { qa[ks] = (bf16x8){0, 0, 0, 0, 0, 0, 0, 0}; if (k32 < 16) qa[ks] = *(const bf16x8*)(qidx + (size_t)t * 1024 + k32 * 64 + ks * 16 + hi * 8); }
        const f32x4 wA = *(const f32x4*)(widx + (size_t)t * 16 + 4 * hi), wB = *(const f32x4*)(widx + (size_t)t * 16 + 8 + 4 * hi);
        unsigned u[64];
        const bf16_t* kg = kidx + ((size_t)b * SEQ + skey) * IDXD + sc * 8;
        const int nsc = (nchunks + 3) >> 2;
        bf16x8 stg[4];
#pragma unroll
        for (int q = 0; q < 4; ++q) stg[q] = *(const bf16x8*)(kg + (size_t)q * 64 * IDXD);
        __syncthreads();
#pragma unroll
        for (int q = 0; q < 4; ++q) *(LAS bf16x8*)(lds + q * 8192 + swr) = stg[q];
        __syncthreads();
#pragma unroll
        for (int sc4 = 0; sc4 < 16; ++sc4) {
            if (sc4 < nsc) {
                if (sc4 + 1 < nsc) {
#pragma unroll
                    for (int q = 0; q < 4; ++q) stg[q] = *(const bf16x8*)(kg + (size_t)(4 * (sc4 + 1) + q) * 64 * IDXD);
                }
#pragma unroll
                for (int q = 0; q < 4; ++q) {
                    const int j = 4 * sc4 + q;
                    if (j < nchunks) {
                        float part[2];
#pragma unroll
                        for (int T2 = 0; T2 < 2; ++T2) {
                            f32x16 acc = {};
#pragma unroll
                            for (int ks = 0; ks < 4; ++ks) {
                                const bf16x8 kf = *(const LAS bf16x8*)(rdb[ks] + (sc4 & 1) * 32768 + q * 8192 + T2 * 4096);
                                acc = __builtin_amdgcn_mfma_f32_32x32x16_bf16(qa[ks], kf, acc, 0, 0, 0);
                            }
                            float pt = 0.f;
#pragma unroll
                            for (int r = 0; r < 4; ++r) { pt = fmaf(wA[r], __int_as_float(max(__float_as_int(acc[r]), 0)), pt); pt = fmaf(wB[r], __int_as_float(max(__float_as_int(acc[4 + r]), 0)), pt); }
                            part[T2] = pt;
                        }
                        const auto xs = __builtin_amdgcn_permlane32_swap(__float_as_uint(part[0]), __float_as_uint(part[1]), false, false);
                        const float val = hi ? part[1] + __uint_as_float(xs[0]) : part[0] + __uint_as_float(xs[1]);
                        u[j] = f2sortable(val);
                    } else u[j] = 0u;
                }
                if (sc4 + 1 < nsc) {
#pragma unroll
                    for (int q = 0; q < 4; ++q) *(LAS bf16x8*)(lds + ((sc4 + 1) & 1) * 32768 + q * 8192 + swr) = stg[q];
                    __syncthreads();
                }
            } else {
#pragma unroll
                for (int q = 0; q < 4; ++q) u[4 * sc4 + q] = 0u;
            }
        }
        unsigned thr = 0u; int c_gt = 0; bool exact = false;
        for (int bit = 31; bit >= 0; --bit) {
            const unsigned cand = thr | (1u << bit);
            int cnt = 0;
#pragma unroll
            for (int j = 0; j < 64; j += 8) {
                if (j < nchunks) {
                const unsigned long long m0 = __ballot(u[j] >= cand), m1 = __ballot(u[j + 1] >= cand), m2 = __ballot(u[j + 2] >= cand), m3 = __ballot(u[j + 3] >= cand),
                                         m4 = __ballot(u[j + 4] >= cand), m5 = __ballot(u[j + 5] >= cand), m6 = __ballot(u[j + 6] >= cand), m7 = __ballot(u[j + 7] >= cand);
                cnt += ((__builtin_popcountll(m0) + __builtin_popcountll(m1)) + (__builtin_popcountll(m2) + __builtin_popcountll(m3))) +
                       ((__builtin_popcountll(m4) + __builtin_popcountll(m5)) + (__builtin_popcountll(m6) + __builtin_popcountll(m7)));
                }
            }
            if (cnt >= IDXTOPK) thr = cand; else c_gt = cnt;
            if (cnt == IDXTOPK) { exact = true; break; }
        }
        const unsigned t_gt = exact ? thr - 1u : thr;
        const int eq_base = exact ? IDXTOPK : c_gt, quota = IDXTOPK - eq_base;
        LAS int* ssel = (LAS int*)(lds + 65536 + wid * 1024);
        int rg = 0, re = 0;
#pragma unroll
        for (int j = 0; j < 64; ++j) {
            if (j < nchunks) {
            const bool sg = u[j] > t_gt, se = u[j] == thr && !exact;
            const unsigned long long mg = __ballot(sg), me = __ballot(se);
            const int pg_ = rg + __builtin_amdgcn_mbcnt_hi((unsigned)(mg >> 32), __builtin_amdgcn_mbcnt_lo((unsigned)mg, 0u));
            const int pe_ = re + __builtin_amdgcn_mbcnt_hi((unsigned)(me >> 32), __builtin_amdgcn_mbcnt_lo((unsigned)me, 0u));
            const int key = 64 * j + 32 * hi + k32;
            if (sg) ssel[pg_] = key;
            if (se && pe_ < quota) ssel[eq_base + pe_] = key;
            rg += __builtin_popcountll(mg); re += __builtin_popcountll(me);
            }
        }
        *(u32x4*)(selp + 4 * lane) = *(LAS u32x4*)(ssel + 4 * lane);
        if (lane == 0) nsel[t] = IDXTOPK;
    }
}

__device__ __forceinline__ int t5_bucket_dev(int rel) {
    const int n = rel < 0 ? -rel : rel;
    int large = 2 + (31 - __builtin_clz((unsigned)(n * n) | 1u)); large = large > 15 ? 15 : large;
    return (rel > 0 ? 16 : 0) + (n < 8 ? n : large);
}
__device__ __forceinline__ int cg_off(int r, int c) { return r * 512 + ((c ^ ((r & 7) << 1)) << 4); }
__device__ __forceinline__ void phase_sparse_attn(const Params& p, LAS unsigned char* lds) {
    const int tid = tidx(), wid = __builtin_amdgcn_readfirstlane(tid >> 6), lane = tid & 63, fr = lane & 15, fq = lane >> 4;
    LAS unsigned char* cgl = lds + wid * 16384;
    LAS float* rbl = (LAS float*)(lds + 131072);
    LAS int* qctr = (LAS int*)(lds + 133120 + 8 * 1280);
    if (tid == 0) *qctr = 0;
    if (tid < 512) rbl[tid] = p.rel_bias[tid] * 1.4426950408889634f;
    __syncthreads();
    if (wid >= NWAVES - SPA_CW) { cvt_moe_run4(p, cgl, 1, CVT1_SPLIT + blockIdx.x * SPA_CW + (wid - (NWAVES - SPA_CW)), NBLK * SPA_CW, 65 * 768 - CVT0_GU, lane); }
    else {
    const bf16_t* qlat = (const bf16_t*)(p.ws + OFF_BIG + BG_QLAT); const bf16_t* ckv = (const bf16_t*)(p.ws + OFF_BIG + BG_CKV);
    const int* sel = (const int*)(p.ws + OFF_BIG + BG_SEL); const int* nsel = (const int*)(p.ws + OFF_BIG + BG_NSEL);
    bf16_t* olat = (bf16_t*)(p.ws + OFF_BIG + BG_OLAT);
    const int hr = lane >> 5, hc = lane & 31;
    const int q4 = fr >> 2, p4 = fr & 3;
    const int trbase = (int)(uintptr_t)cgl;
    LAS unsigned char* qkb[4]; int trb[8];
#pragma unroll
    for (int jj = 0; jj < 4; ++jj) qkb[jj] = cgl + cg_off(fr, 4 * jj + fq);
#pragma unroll
    for (int m = 0; m < 8; ++m) trb[m] = trbase + cg_off(4 * fq + q4, 2 * m + (p4 >> 1)) + (p4 & 1) * 8;
    LAS int* ssel = (LAS int*)(lds + 133120 + wid * 1280);
    LAS int* bkt = ssel + 256;
    for (;;) {
        int qk = 0; if (lane == 0) qk = __atomic_fetch_add(qctr, 1, __ATOMIC_RELAXED);
        qk = __builtin_amdgcn_readfirstlane(qk); if (qk >= 64) break;
        const int t = blockIdx.x * 8 + (qk & 7) + NBLK * 8 * (qk >> 3);
        const int b = t >> 12, pos = t & 4095, ns = __builtin_amdgcn_readfirstlane(nsel[t]), nch = ns >> 5;
        const int* selp = sel + (size_t)t * IDXTOPK;
        *(LAS u32x4*)(ssel + 4 * lane) = *(const u32x4*)(selp + 4 * lane);
        bf16x8 qb[8];
#pragma unroll
        for (int j = 0; j < 8; ++j) qb[j] = *(const bf16x8*)(qlat + (size_t)t * 4096 + fr * 256 + j * 32 + fq * 8);
        f32x4 acc[16];
#pragma unroll
        for (int n = 0; n < 16; ++n) acc[n] = (f32x4){0.f, 0.f, 0.f, 0.f};
        float mrun = -1e30f, lsum = 0.f;
        const bf16_t* ckb = ckv + (size_t)b * SEQ * KVLAT + hc * 8;
        bf16x8 st[16];
#pragma unroll
        for (int it = 0; it < 16; ++it) { const int key = ssel[2 * it + hr]; st[it] = *(const bf16x8*)(ckb + (size_t)key * KVLAT); }
        for (int ch = 0; ch < nch; ++ch) {
#pragma unroll
            for (int it = 0; it < 16; ++it) *(LAS bf16x8*)(cgl + cg_off(2 * it + hr, hc)) = st[it];
            if (ch + 1 < nch) {
#pragma unroll
                for (int it = 0; it < 16; ++it) { const int key = ssel[(ch + 1) * 32 + 2 * it + hr]; st[it] = *(const bf16x8*)(ckb + (size_t)key * KVLAT); }
            }
            if (lane < 32) bkt[lane] = t5_bucket_dev(ssel[ch * 32 + lane] - pos) * 16;
            f32x4 s0 = (f32x4){0.f, 0.f, 0.f, 0.f}, s1 = (f32x4){0.f, 0.f, 0.f, 0.f};
#pragma unroll
            for (int j = 0; j < 8; ++j) {
                const bf16x8 a0 = *(const LAS bf16x8*)(qkb[j & 3] + (j >> 2) * 256);
                const bf16x8 a1 = *(const LAS bf16x8*)(qkb[j & 3] + (j >> 2) * 256 + 8192);
                s0 = __builtin_amdgcn_mfma_f32_16x16x32_bf16(a0, qb[j], s0, 0, 0, 0);
                s1 = __builtin_amdgcn_mfma_f32_16x16x32_bf16(a1, qb[j], s1, 0, 0, 0);
            }
            const u32x4 bo0 = *(LAS u32x4*)(bkt + 4 * fq), bo1 = *(LAS u32x4*)(bkt + 16 + 4 * fq);
            float cmax = -1e30f;
#pragma unroll
            for (int i = 0; i < 4; ++i) {
                s0[i] = fmaf(s0[i], 0.12751743082459868f, rbl[bo0[i] + fr]);
                s1[i] = fmaf(s1[i], 0.12751743082459868f, rbl[bo1[i] + fr]);
                cmax = fmaxf(cmax, fmaxf(s0[i], s1[i]));
            }
            { const auto x16 = __builtin_amdgcn_permlane16_swap(__float_as_uint(cmax), __float_as_uint(cmax), false, false); cmax = fmaxf(__uint_as_float(x16[0]), __uint_as_float(x16[1]));
              const auto x32 = __builtin_amdgcn_permlane32_swap(__float_as_uint(cmax), __float_as_uint(cmax), false, false); cmax = fmaxf(__uint_as_float(x32[0]), __uint_as_float(x32[1])); }
            if (!__all(cmax - mrun <= 11.5f)) {
                const float mnew = fmaxf(mrun, cmax), alpha = __builtin_amdgcn_exp2f(mrun - mnew);
                mrun = mnew; lsum *= alpha;
#pragma unroll
                for (int n = 0; n < 16; ++n) acc[n] *= alpha;
            }
            float ps = 0.f;
#pragma unroll
            for (int i = 0; i < 4; ++i) { s0[i] = __builtin_amdgcn_exp2f(s0[i] - mrun); s1[i] = __builtin_amdgcn_exp2f(s1[i] - mrun); ps += s0[i] + s1[i]; }
            lsum += ps;
            u32x4 pw; pw.x = cvt_pk_bf16(s0[0], s0[1]); pw.y = cvt_pk_bf16(s0[2], s0[3]); pw.z = cvt_pk_bf16(s1[0], s1[1]); pw.w = cvt_pk_bf16(s1[2], s1[3]);
            const bf16x8 pb = *reinterpret_cast<bf16x8*>(&pw);
#define TRRD2(dst, base, off) asm volatile("ds_read_b64_tr_b16 %0, %1 offset:%2" : "=&v"(dst) : "v"(base), "i"(off) : "memory")
#define PV_4(n0) do { s16x4 l0, h0, l1, h1, l2, h2, l3, h3; \
                TRRD2(l0, trb[((n0) + 0) & 7], (((n0) + 0) >> 3) * 256); TRRD2(h0, trb[((n0) + 0) & 7], (((n0) + 0) >> 3) * 256 + 8192); \
                TRRD2(l1, trb[((n0) + 1) & 7], (((n0) + 1) >> 3) * 256); TRRD2(h1, trb[((n0) + 1) & 7], (((n0) + 1) >> 3) * 256 + 8192); \
                TRRD2(l2, trb[((n0) + 2) & 7], (((n0) + 2) >> 3) * 256); TRRD2(h2, trb[((n0) + 2) & 7], (((n0) + 2) >> 3) * 256 + 8192); \
                TRRD2(l3, trb[((n0) + 3) & 7], (((n0) + 3) >> 3) * 256); TRRD2(h3, trb[((n0) + 3) & 7], (((n0) + 3) >> 3) * 256 + 8192); \
                asm volatile("s_waitcnt lgkmcnt(0)" ::: "memory"); __builtin_amdgcn_sched_barrier(0); \
                acc[(n0) + 0] = __builtin_amdgcn_mfma_f32_16x16x32_bf16((bf16x8){l0[0], l0[1], l0[2], l0[3], h0[0], h0[1], h0[2], h0[3]}, pb, acc[(n0) + 0], 0, 0, 0); \
                acc[(n0) + 1] = __builtin_amdgcn_mfma_f32_16x16x32_bf16((bf16x8){l1[0], l1[1], l1[2], l1[3], h1[0], h1[1], h1[2], h1[3]}, pb, acc[(n0) + 1], 0, 0, 0); \
                acc[(n0) + 2] = __builtin_amdgcn_mfma_f32_16x16x32_bf16((bf16x8){l2[0], l2[1], l2[2], l2[3], h2[0], h2[1], h2[2], h2[3]}, pb, acc[(n0) + 2], 0, 0, 0); \
                acc[(n0) + 3] = __builtin_amdgcn_mfma_f32_16x16x32_bf16((bf16x8){l3[0], l3[1], l3[2], l3[3], h3[0], h3[1], h3[2], h3[3]}, pb, acc[(n0) + 3], 0, 0, 0); \
                __builtin_amdgcn_sched_barrier(0); } while (0)
            PV_4(0); PV_4(4); PV_4(8); PV_4(12);
#undef PV_4
#undef TRRD2
            asm volatile("s_waitcnt lgkmcnt(0)" ::: "memory");
        }
        float lt = lsum; lt += __shfl_xor(lt, 16); lt += __shfl_xor(lt, 32);
        const float inv = 1.0f / lt;
        bf16_t* op = olat + (size_t)t * 4096 + fr * 256 + 4 * fq;
#pragma unroll
        for (int n = 0; n < 16; ++n) { u32x2 o; o.x = cvt_pk_bf16(acc[n][0] * inv, acc[n][1] * inv); o.y = cvt_pk_bf16(acc[n][2] * inv, acc[n][3] * inv); *(u32x2*)(op + 16 * n) = o; }
    }
    }
}

#define XB_TMO      128
#define XB_XCNT(j)  (256  + 64 * (j))
#define XB_XSUB(j)  (1280 + 64 * (j))
#define XB_XGEN(j)  (2304 + 64 * (j))
#define XB_TOP      3328
#define XB_TOPGEN   3392
#define XCD_BAR_WORDS 3456
#define XB_SPIN_CAP (1u << 21)

__device__ __forceinline__ unsigned xb_ld(unsigned* p)              { return __hip_atomic_load(p, __ATOMIC_RELAXED, __HIP_MEMORY_SCOPE_AGENT); }
__device__ __forceinline__ unsigned xb_add(unsigned* p, unsigned v) { return __hip_atomic_fetch_add(p, v, __ATOMIC_RELAXED, __HIP_MEMORY_SCOPE_AGENT); }
__device__ __forceinline__ unsigned xb_xcc_id() { return (unsigned)__builtin_amdgcn_s_getreg((3 << 11) | 20) & 0xFu; }
#define XB_SPIN(cond, bar) do { unsigned _sp = 0; while (cond) { __builtin_amdgcn_s_sleep(1); \
    if ((++_sp & 255u) == 0u) { if (xb_ld(&(bar)[XB_TMO])) break; if (_sp > XB_SPIN_CAP) { atomicAdd(&(bar)[XB_TMO], 1u); break; } } } } while (0)

struct XcdBarrier {
    unsigned* bar; unsigned x;
    volatile LAS unsigned* st;
};

__device__ __forceinline__ XcdBarrier xcd_barrier_post(unsigned* bar, volatile LAS unsigned* st) {
    XcdBarrier b; b.bar = bar; b.x = xb_xcc_id(); b.st = st;
    if (threadIdx.x == 0) (void)xb_add(&bar[XB_XCNT(b.x)], 1u);
    return b;
}
__device__ __forceinline__ void xcd_barrier_complete(unsigned* bar, unsigned x, unsigned& nloc, unsigned& nx) {
    const unsigned G = gridDim.x * gridDim.y * gridDim.z;
    unsigned sum, cnt, mine, sp = 0u;
    for (;;) {
        sum = 0u; cnt = 0u; mine = 0u;
#pragma unroll
        for (unsigned j = 0; j < 16; ++j) { const unsigned c = xb_ld(&bar[XB_XCNT(j)]); sum += c; cnt += (c > 0u) ? 1u : 0u; mine = (j == x) ? c : mine; }
        if (sum == G) break;
        __builtin_amdgcn_s_sleep(1);
        if ((++sp & 255u) == 0u) { if (xb_ld(&bar[XB_TMO])) break; if (sp > XB_SPIN_CAP) { atomicAdd(&bar[XB_TMO], 1u); break; } }
    }
    nloc = mine > 0u ? mine : 1u; nx = cnt > 0u ? cnt : 1u;
}

__device__ __forceinline__ void xcd_barrier(const XcdBarrier& b) {
    asm volatile("s_waitcnt vmcnt(0)" ::: "memory");
    __syncthreads();
    if (threadIdx.x == 0) {
        unsigned* bar = b.bar;
        __builtin_amdgcn_s_waitcnt(0);
        unsigned nloc = b.st[0], nx = b.st[1];
        if (nloc == 0u) { xcd_barrier_complete(bar, b.x, nloc, nx); b.st[0] = nloc; b.st[1] = nx; }
        const unsigned old = xb_add(&bar[XB_XSUB(b.x)], 1u);
        const unsigned gen = old / nloc;
        if (old + 1u == (gen + 1u) * nloc) {
            __builtin_amdgcn_fence(__ATOMIC_RELEASE, "agent");
            asm volatile("s_waitcnt vmcnt(0)" ::: "memory");
            const unsigned og = xb_add(&bar[XB_TOP], 1u);
            const unsigned tg = og / nx;
            if (og + 1u == (tg + 1u) * nx) xb_add(&bar[XB_TOPGEN], 1u);
            else XB_SPIN(xb_ld(&bar[XB_TOPGEN]) == tg, bar);
            __builtin_amdgcn_fence(__ATOMIC_ACQUIRE, "agent");
            xb_add(&bar[XB_XGEN(b.x)], 1u);
            asm volatile("s_waitcnt vmcnt(0)" ::: "memory");
        } else {
            XB_SPIN(xb_ld(&bar[XB_XGEN(b.x)]) == gen, bar);
            __builtin_amdgcn_fence(__ATOMIC_ACQUIRE, "agent");
            asm volatile("s_waitcnt vmcnt(0)" ::: "memory");
        }
    }
    __syncthreads();
}


enum { PH_PROLOGUE = 0, PH_INPROJ_A, PH_NORMS, PH_ATTN_A, PH_OUTPROJ_A, PH_LNR_0, PH_RPOS_0, PH_GU_0, PH_DOWN_0, PH_COMB_0,
       PH_INPROJ_B, PH_DSA_PREP, PH_QPROJ_B, PH_INDEXER, PH_SPATTN, PH_UV_B, PH_OUTPROJ_B, PH_LNR_1, PH_RPOS_1, PH_GU_1, PH_DOWN_1, PH_COMB_1, PH_COUNT };

template <int PH>
__device__ __forceinline__ void run_phase(const Params& p, LAS unsigned char* lds) {
    unsigned char* ws = p.ws;
    unsigned* ctrl = (unsigned*)(ws + OFF_CTRL);
    bf16_t* xb = (bf16_t*)(ws + OFF_XB); bf16_t* xlo = (bf16_t*)(ws + OFF_X2F);
    unsigned char* big = ws + OFF_BIG;
    constexpr int LAYER = (PH >= PH_INPROJ_B) ? 1 : 0;
    if constexpr (PH == PH_PROLOGUE) {
        { float* NRM = (float*)(big + BG_NRM); for (int i = blockIdx.x * NTHREADS + tidx(); i < 2 * 64 * 64 * 2; i += NBLK * NTHREADS) NRM[i] = 0.f; }
        phase_cvt_fox(p, lds); phase_cvt_router(p); phase_cvt_fgate(p); phase_cvt_moe(p, lds, 0, CVT0_SPLIT); phase_cvt_dsa(p, lds); phase_wprep(p); phase_cvt_moe(p, lds, 1, CVT1_SPLIT);
    }
    else if constexpr (PH == PH_INPROJ_A) {
        phase_fgate(p);
        if (blockIdx.x >= NBLK - CVB) {
            const int tid = tidx();
            cvt_moe_run4(p, lds + (tid >> 6) * 9216, 0, CVT0_SPLIT + (blockIdx.x - (NBLK - CVB)) * NWAVES + (tid >> 6), CVB * NWAVES, 65 * 768 - CVT0_GU, tid & 63);
        } else {
            pg8::DenseSched S; S.init(xb, (const bf16_t*)(ws + OFF_WA + WA_WINT), NTOK, 6144, DM, NBLK - CVB);
            pg8::EpiBf16T<true> E; E.O0 = (bf16_t*)(big + BG_Q); E.ld0 = DM; E.O1 = nullptr; E.ld1 = 0; E.split0 = 0; E.split_cols = DM; E.split_stride = (size_t)NTOK * DM; E.nrm = (float*)(big + BG_NRM);
            pg8::gemm_phase(lds, S, E);
        }
    }
    else if constexpr (PH == PH_NORMS) phase_scan(p, lds);
    else if constexpr (PH == PH_ATTN_A) phase_fox_attn(p, lds);
    else if constexpr (PH == PH_OUTPROJ_A) {
        pg8::DenseSched S; S.init((const bf16_t*)(big + BG_O), (const bf16_t*)(ws + OFF_WA + WA_WOUTT), NTOK, DM, DM);
        pg8::EpiBf16 E; E.O0 = (bf16_t*)(big + BG_M); E.ld0 = DM; E.O1 = nullptr; E.ld1 = 0; E.split0 = 1 << 30; E.split_cols = 0; E.split_stride = 0;
        pg8::gemm_phase(lds, S, E);
    }
    else if constexpr (PH == PH_LNR_0) phase_router(p, lds, xb, xlo, (const bf16_t*)(ws + OFF_ROUTE + RWT_BYTE_OFF), p.router_b, p.x, (const bf16_t*)(big + BG_M), p.ln1_g, p.ln1_b);
    else if constexpr (PH == PH_LNR_1) phase_router(p, lds, xb, xlo, (const bf16_t*)(ws + OFF_ROUTE + RWT_BYTE_OFF) + (size_t)128 * DM, p.router_b + NEXP, nullptr, (const bf16_t*)(big + BG_M2), p.ln1_g + DM, p.ln1_b + DM);
    else if constexpr (PH == PH_RPOS_0 || PH == PH_RPOS_1) phase_route_pos(p, lds);
    else if constexpr (PH == PH_GU_0 || PH == PH_GU_1) {
        constexpr int NCV = GU0_CV;
        if (NCV > 0 && (int)(blockIdx.x >> 3) >= (NBLK >> 3) - NCV) {
            const int tid = tidx();
            cvt_moe_run4(p, lds + (tid >> 6) * 9216, LAYER, 65 * 768 - CVT0_GU + ((int)(blockIdx.x >> 3) - ((NBLK >> 3) - NCV)) * 64 + (int)(blockIdx.x & 7) * NWAVES + (tid >> 6), NCV * 64, 65 * 768, tid & 63);
        } else {
            pg8::MoeGuSched S; S.init(ctrl, xb, (const bf16_t*)(ws + OFF_WGU + (size_t)LAYER * MOE_LSTRIDE), (const int*)(ws + OFF_ROUTE) + RT_ROWTOK, -1, (LAS int*)(lds + pg8::STAGE_BYTES), NCV);
            pg8::EpiSwiGLU E; E.H = (bf16_t*)(big + BG_H);
            pg8::gemm_phase(lds, S, E);
        }
    }
    else if constexpr (PH == PH_DOWN_0 || PH == PH_DOWN_1) {
        pg8::MoeDownSched S; S.init(ctrl, (const bf16_t*)(big + BG_H), (const bf16_t*)(ws + OFF_WD + (size_t)LAYER * MOE_LSTRIDE), -1);
        if constexpr (PH == PH_DOWN_1 || YS0_FP8) {
            pg8::EpiFp8 E; E.O = big + BG_YS; E.ldc = DM;
            pg8::gemm_phase(lds, S, E);
        } else {
            pg8::EpiBf16 E; E.O0 = (bf16_t*)(big + BG_YS); E.ld0 = DM; E.O1 = nullptr; E.ld1 = 0; E.split0 = 1 << 30; E.split_cols = 0; E.split_stride = 0;
            pg8::gemm_phase(lds, S, E);
        }
    }
    else if constexpr (PH == PH_COMB_0) phase_combine_ln2<(YS0_FP8 != 0)>(p, xb, xlo, p.ln2_g, p.ln2_b, nullptr);
    else if constexpr (PH == PH_COMB_1) phase_combine_ln2<true>(p, xb, xlo, p.ln2_g + DM, p.ln2_b + DM, p.out);
    else if constexpr (PH == PH_INPROJ_B) {
        pg8::DenseSched S; S.init(xb, (const bf16_t*)(ws + OFF_WA + WA_WBINT), NTOK, 1024, DM);
        pg8::EpiF32 E; E.C = (float*)(big + BG_PROJ); E.ldc = 1024;
        pg8::gemm_phase(lds, S, E);
    }
    else if constexpr (PH == PH_DSA_PREP) phase_dsa_prep(p);
    else if constexpr (PH == PH_QPROJ_B) {
        pg8::DenseSched S; S.init((const bf16_t*)(big + BG_CQ), (const bf16_t*)(ws + OFF_WA + WA_WQ2T), NTOK, 5120, QLAT);
        pg8::EpiBf16 E; E.O0 = (bf16_t*)(big + BG_QLAT); E.ld0 = 4096; E.O1 = (bf16_t*)(big + BG_QIDX); E.ld1 = 1024; E.split0 = 4096; E.split_cols = 0; E.split_stride = 0;
        pg8::gemm_phase(lds, S, E);
    }
    else if constexpr (PH == PH_INDEXER) phase_indexer(p, lds);
    else if constexpr (PH == PH_SPATTN) phase_sparse_attn(p, lds);
    else if constexpr (PH == PH_UV_B) {
        pg8::BlockDiagSched S; S.init((const bf16_t*)(big + BG_OLAT), (const bf16_t*)(ws + OFF_WA + WA_WUVOT), NTOK, DM, 512, 4096);
        pg8::EpiBf16 E; E.O0 = (bf16_t*)(big + BG_O2); E.ld0 = DM; E.O1 = nullptr; E.ld1 = 0; E.split0 = 1 << 30; E.split_cols = 0; E.split_stride = 0;
        pg8::gemm_phase(lds, S, E);
    }
    else if constexpr (PH == PH_OUTPROJ_B) {
        pg8::DenseSched S; S.init((const bf16_t*)(big + BG_O2), (const bf16_t*)(ws + OFF_WA + WA_WOUTTB), NTOK, DM, DM);
        pg8::EpiBf16 E; E.O0 = (bf16_t*)(big + BG_M2); E.ld0 = DM; E.O1 = nullptr; E.ld1 = 0; E.split0 = 1 << 30; E.split_cols = 0; E.split_stride = 0;
        pg8::gemm_phase(lds, S, E);
    }
}

#ifndef MK_LAUNCHES
#define MK_LAUNCHES 1
#endif
constexpr int LDS_BAR_OFF = LDS_BYTES - 16;

template <int PH>
__device__ __forceinline__ void run_from(const Params& p, LAS unsigned char* lds, const XcdBarrier& bar) {
    run_phase<PH>(p, lds);
    if constexpr (PH + 1 < PH_COUNT) { xcd_barrier(bar); run_from<PH + 1>(p, lds, bar); }
}
__global__ void __launch_bounds__(NTHREADS, 2) k_mega(Params p) {
    extern __shared__ __attribute__((aligned(16))) unsigned char smem[];
    LAS unsigned char* lds = (LAS unsigned char*)smem;
    if (threadIdx.x == 0) *(LAS u32x4*)(lds + LDS_BAR_OFF) = (u32x4){0u, 0u, 0u, 0u};
    __syncthreads();
    const XcdBarrier bar = xcd_barrier_post((unsigned*)(p.ws + OFF_CTRL) + CW_BAR, (volatile LAS unsigned*)(lds + LDS_BAR_OFF));
    run_from<0>(p, lds, bar);
}
template <int PH>
__global__ void __launch_bounds__(NTHREADS, 2) k_phase(Params p) {
    extern __shared__ __attribute__((aligned(16))) unsigned char smem[];
    run_phase<PH>(p, (LAS unsigned char*)smem);
}
template <int PH>
static void launch_phases(const Params& p, int grid, hipStream_t stream) {
    static bool done = false;
    if (!done) { done = true; (void)hipFuncSetAttribute((const void*)k_phase<PH>, hipFuncAttributeMaxDynamicSharedMemorySize, LDS_BYTES); }
    hipLaunchKernelGGL(k_phase<PH>, dim3(grid), dim3(NTHREADS), LDS_BYTES, stream, p);
    if constexpr (PH + 1 < PH_COUNT) launch_phases<PH + 1>(p, grid, stream);
}

extern "C" void kernel_launch(void* const* d_in, const int* in_sizes, int n_in, void* d_out, int out_size, void* d_ws, size_t ws_size, hipStream_t stream) {
    if (n_in != 25 || out_size != NTOK * DM || ws_size < WS_END) { fprintf(stderr, "kernel_launch: unexpected shapes (n_in %d out %d ws %zu)\n", n_in, out_size, ws_size); return; }
    Params p{};
    const float** pp = (const float**)&p;
    for (int i = 0; i < 25; ++i) pp[i] = (const float*)d_in[i];
    p.out = (float*)d_out; p.ws = (unsigned char*)d_ws;
    static int grid = 0;
    if (!grid) {
        int dev = 0, cus = 0, per_cu = 0; (void)hipGetDevice(&dev);
        if (hipDeviceGetAttribute(&cus, hipDeviceAttributeMultiprocessorCount, dev) != hipSuccess || cus <= 0) cus = 256;
        (void)hipFuncSetAttribute((const void*)k_mega, hipFuncAttributeMaxDynamicSharedMemorySize, LDS_BYTES);
        if (hipOccupancyMaxActiveBlocksPerMultiprocessor(&per_cu, (const void*)k_mega, NTHREADS, LDS_BYTES) != hipSuccess || per_cu < 1) fprintf(stderr, "kernel_launch: occupancy query reports %d workgroups per CU\n", per_cu);
        if (cus < NBLK) fprintf(stderr, "kernel_launch: built for a %d-CU device, found %d CUs\n", NBLK, cus);
        grid = NBLK;
    }
    (void)hipMemsetAsync((char*)d_ws + OFF_CTRL, 0, CTRL_ZERO_BYTES, stream);
#if MK_LAUNCHES
    hipLaunchKernelGGL(k_mega, dim3(grid), dim3(NTHREADS), LDS_BYTES, stream, p);
#else
    launch_phases<0>(p, grid, stream);
#endif
}
```

```cpp
#include <hip/hip_runtime.h>
#include <stdint.h>
#include <stdio.h>

#define LAS __attribute__((address_space(3)))
typedef unsigned short bf16_t;
typedef short bf16x8 __attribute__((ext_vector_type(8)));
typedef short s16x4 __attribute__((ext_vector_type(4)));
typedef float f32x16 __attribute__((ext_vector_type(16)));
typedef float f32x4 __attribute__((ext_vector_type(4)));
typedef float f32x2 __attribute__((ext_vector_type(2)));
typedef unsigned u32x4 __attribute__((ext_vector_type(4)));
typedef unsigned u32x2 __attribute__((ext_vector_type(2)));

constexpr int NTOK = 16384, DM = 2048, SEQ = 4096, NBATCH = 4, NHEAD = 16, HDIM = 128;
constexpr int NEXP = 64, TOPK = 8, DEXP = 512;
constexpr int QLAT = 512, KVLAT = 256, IDXD = 64, IDXH = 16, IDXTOPK = 256, BW = 848;
constexpr float ALPHA = 1.4142135623730951f, LN_EPS = 1e-5f, RMS_EPS = 1e-6f, ROUTED_SCALE = 2.5f;
constexpr int NTHREADS = 512, NWAVES = 8;
#ifndef YS0_FP8
#define YS0_FP8 1
#endif
#ifndef CVT1_SPLIT
#define CVT1_SPLIT 0
#endif
#ifndef CVB
#define CVB 64
#endif
#ifndef GU0_CV
#define GU0_CV 1
#endif
#ifndef CVT0_GU
#define CVT0_GU 8320
#endif
#ifndef CVT0_SPLIT
#define CVT0_SPLIT 0
#endif
#ifndef SPA_CW
#define SPA_CW 2
#endif
constexpr int NBLK = 256;
constexpr int LDS_BYTES = 147456;
constexpr int MAXRT = 576;
constexpr int SH_TILE0 = MAXRT;
constexpr int NSROWS = (MAXRT + 64) * 256;

constexpr size_t MiB = 1048576;
constexpr size_t OFF_CTRL = 0, OFF_ROUTE = 1 * MiB, OFF_WGU = 5 * MiB, OFF_WD = 265 * MiB, MOE_LSTRIDE = 390 * MiB  , OFF_WA = 785 * MiB, OFF_XB = 857 * MiB, OFF_X2F = 921 * MiB, OFF_BIG = 1049 * MiB, WS_END = 1849 * MiB;
constexpr int CW_BAR = 0;
constexpr int CW_NTILES = 4096;
constexpr int CW_TILE_E = 4352;
constexpr int CW_TILE_RT = 5120;
constexpr int CW_HIST = 8192;
constexpr int CTRL_ZERO_BYTES = 16384;
constexpr size_t RT_SEL = 0, RT_GATE = 131072, RT_RANK = 262144, RT_POS = 393216, RT_ROWTOK = 524288;
constexpr size_t FWT_BYTE_OFF = 3 * MiB - 131072;
constexpr size_t RWT_BYTE_OFF = 3 * MiB;
constexpr size_t BG_Q = 0, BG_K = 64 * MiB, BG_V = 128 * MiB, BG_O = 192 * MiB, BG_M = 256 * MiB, BG_LOGF = 384 * MiB, BG_G = 385 * MiB, BG_NRM = 386 * MiB;
constexpr size_t BG_H = 0, BG_YS = 160 * MiB;
constexpr size_t BG_PROJ = 0, BG_CQ = 64 * MiB, BG_CKV = 80 * MiB, BG_KIDX = 88 * MiB, BG_WIDX = 90 * MiB, BG_NSEL = 91 * MiB, BG_QLAT = 96 * MiB, BG_QIDX = 224 * MiB, BG_SEL = 256 * MiB, BG_OLAT = 272 * MiB, BG_M2 = 400 * MiB, BG_O2 = 464 * MiB;
constexpr size_t WA_WINT = 0, WA_WOUTT = 24 * MiB;
constexpr size_t WA_WBINT = 32 * MiB, WA_WQ2T = 36 * MiB, WA_WUVOT = 44 * MiB  , WA_WOUTTB = 60 * MiB;

struct Params {
    const float *x, *a_w_in, *a_b_f, *a_w_out, *b_w_in, *b_q_norm, *b_kv_norm, *b_w_uq, *b_w_iq, *b_w_uk, *b_w_uv, *b_w_out, *rel_bias,
        *ln1_g, *ln1_b, *ln2_g, *ln2_b, *router_w, *router_b, *w_gate, *w_up, *w_down, *sh_gate, *sh_up, *sh_down;
    float* out;
    unsigned char* ws;
};

__device__ __forceinline__ unsigned cvt_pk_bf16(float lo, float hi) { unsigned r; asm volatile("v_cvt_pk_bf16_f32 %0, %1, %2" : "=v"(r) : "v"(lo), "v"(hi)); return r; }
__device__ __forceinline__ bf16x8 pack8(f32x4 a, f32x4 b) {
    u32x4 w = {cvt_pk_bf16(a[0], a[1]), cvt_pk_bf16(a[2], a[3]), cvt_pk_bf16(b[0], b[1]), cvt_pk_bf16(b[2], b[3])};
    return *reinterpret_cast<bf16x8*>(&w);
}
__device__ __forceinline__ void mfma_fence(f32x4& a) { asm volatile("s_nop 15\n\ts_nop 15" : "+v"(a)); }
__device__ __forceinline__ int tidx() { int t = (int)threadIdx.x; asm volatile("" : "+v"(t)); return t; }
__device__ __forceinline__ float bf2f(bf16_t b) { return __uint_as_float(((unsigned)b) << 16); }
__device__ __forceinline__ float wave_sum(float v) {
#pragma unroll
    for (int o = 32; o >= 1; o >>= 1) v += __shfl_xor(v, o);
    return v;
}
__device__ __forceinline__ float wave_max(float v) {
#pragma unroll
    for (int o = 32; o >= 1; o >>= 1) v = fmaxf(v, __shfl_xor(v, o));
    return v;
}

namespace pg8 {
constexpr int BM = 256, BK = 64, HALF = 128, HTB = HALF * BK * 2  , STAGE_BYTES = 8 * HTB, NXCD = 8, WGM = 8;

__host__ __device__ __forceinline__ int lds_byte(int r, int c) { const int st = (r >> 4) * 2 + (c >> 5), rr = r & 15, cc = c & 31, ob = rr * 64 + cc * 2; return st * 1024 + (ob ^ (((ob >> 9) & 1) << 5)); }
__host__ __device__ __forceinline__ void stage_rc(int b, int& R, int& C) { const int st = b / 1024, sb = b % 1024, swz = sb ^ (((sb >> 9) & 1) << 5); R = (st >> 1) * 16 + swz / 64; C = (st & 1) * 32 + (swz % 64) / 2; }
__host__ __device__ __forceinline__ int perm32(int rho) { const int n = rho >> 4, i = rho & 15; return 8 * (i >> 2) + 4 * n + (i & 3); }

struct Unit { int pm, pn, e, idx; };

struct StaticOrder {
    int nM, nN, nwg, G, c;
    __device__ void init(int M, int N, int G_, int c_) { nM = M / BM; nN = N / BM; nwg = nM * nN; G = G_; c = c_; }
    __device__ bool next(int i, Unit& u) const {
        const long L = (long)i * G + c; if (L >= nwg) return false;
        int wgid = (int)L; { const int q = nwg / NXCD, r = nwg % NXCD, xcd = wgid % NXCD, off = wgid / NXCD; wgid = (xcd < r ? xcd * (q + 1) : r * (q + 1) + (xcd - r) * q) + off; }
        const int nig = WGM * nN, gid = wgid / nig, fm = gid * WGM, gsz = (nM - fm) < WGM ? (nM - fm) : WGM;
        u.pm = fm + ((wgid % nig) % gsz); u.pn = (wgid % nig) / gsz; u.e = 0; u.idx = i; return true;
    }
};
struct DenseSched {
    const bf16_t* A; const bf16_t* Bt; int K; StaticOrder so;
    __device__ void init(const bf16_t* A_, const bf16_t* Bt_, int M, int N, int K_, int G_ = NBLK) { A = A_; Bt = Bt_; K = K_; so.init(M, N, G_, blockIdx.x); }
    __device__ __forceinline__ bool next(int i, Unit& u) const { return so.next(i, u); }
    __device__ __forceinline__ int rot() const { return 0; }
    __device__ __forceinline__ int ldk() const { return K; }
    __device__ __forceinline__ size_t kstep_a() const { return BK * 2; }
    __device__ __forceinline__ size_t kstep_b() const { return BK * 2; }
    __device__ __forceinline__ const char* a_base(const Unit& u) const { return (const char*)A + (size_t)u.pm * BM * K * 2; }
    __device__ __forceinline__ const char* b_base(const Unit& u) const { return (const char*)Bt + (size_t)u.pn * BM * K * 2; }
    __device__ __forceinline__ void a_offs(const Unit&, const int (&R)[2], const int (&C)[2], unsigned (&off)[2][2]) const {
#pragma unroll
        for (int h = 0; h < 2; ++h)
#pragma unroll
            for (int i = 0; i < 2; ++i) off[h][i] = (unsigned)((h * HALF + R[i]) * K + C[i]) * 2u;
    }
};
struct BlockDiagSched {
    const bf16_t* A; const bf16_t* Bt; int K, LD; StaticOrder so;
    __device__ void init(const bf16_t* A_, const bf16_t* Bt_, int M, int N, int K_, int LD_) { A = A_; Bt = Bt_; K = K_; LD = LD_; so.init(M, N, NBLK, blockIdx.x); }
    __device__ __forceinline__ bool next(int i, Unit& u) const { return so.next(i, u); }
    __device__ __forceinline__ int rot() const { return 0; }
    __device__ __forceinline__ int ldk() const { return LD; }
    __device__ __forceinline__ size_t kstep_a() const { return BK * 2; }
    __device__ __forceinline__ size_t kstep_b() const { return BK * 2; }
    __device__ __forceinline__ const char* a_base(const Unit& u) const { return (const char*)A + ((size_t)u.pm * BM * LD + (size_t)u.pn * K) * 2; }
    __device__ __forceinline__ const char* b_base(const Unit& u) const { return (const char*)Bt + ((size_t)u.pn * BM * LD + (size_t)u.pn * K) * 2; }
    __device__ __forceinline__ void a_offs(const Unit&, const int (&R)[2], const int (&C)[2], unsigned (&off)[2][2]) const {
#pragma unroll
        for (int h = 0; h < 2; ++h)
#pragma unroll
            for (int i = 0; i < 2; ++i) off[h][i] = (unsigned)((h * HALF + R[i]) * LD + C[i]) * 2u;
    }
};
struct MoeSchedBase {
    const unsigned* ctrl; int npn, ntiles, G, c, tpx, t0, t1, nx, lc;
    __device__ void init_base(const unsigned* ctrl_, int npn_, int part, int nconv = 0) { ctrl = ctrl_; npn = npn_; ntiles = (int)ctrl_[CW_NTILES]; G = NBLK; c = blockIdx.x;
        if ((G & 7) == 0) { const int x = c & 7; nx = (G >> 3) - nconv; lc = c >> 3; tpx = (ntiles + 7) >> 3; t0 = x * tpx; t1 = t0 + tpx < ntiles ? t0 + tpx : ntiles; if (t0 > t1) t0 = t1; }
        else { nx = G; lc = c; tpx = ntiles; t0 = 0; t1 = ntiles; }
        if (part >= 0) { const int ts = t0 + (2 * (t1 - t0) + 2) / 3; if (part == 0) t1 = ts; else t0 = ts; } }
    __device__ __forceinline__ bool next(int i, Unit& u) const {
        const int li = i * nx + lc, T = t0 + li / npn; if (T >= t1) return false;
        u.pn = li % npn; u.e = (int)ctrl[CW_TILE_E + T]; u.pm = (int)ctrl[CW_TILE_RT + T]; u.idx = i; return true;
    }
    __device__ __forceinline__ int rot() const { return 0; }
    __device__ __forceinline__ size_t kstep_a() const { return BK * 2; }
    __device__ __forceinline__ size_t kstep_b() const { return BK * 2; }
};
struct MoeGuSched : MoeSchedBase {
    const bf16_t* A; const bf16_t* Bt; const int* row_tok; int K; LAS int* rowsL;
    __device__ void init(const unsigned* ctrl_, const bf16_t* A_, const bf16_t* Bt_, const int* row_tok_, int part, LAS int* rowsL_, int nconv = 0) { init_base(ctrl_, 4, part, nconv); A = A_; Bt = Bt_; row_tok = row_tok_; K = DM; rowsL = rowsL_;
        const int tid = tidx();
        for (int i = 0; i < 15; ++i) { Unit u; if (!next(i, u)) break; if (tid < 256) rowsL[i * 256 + tid] = row_tok[(size_t)u.pm * BM + tid]; }
        asm volatile("s_waitcnt vmcnt(0) lgkmcnt(0)" ::: "memory"); __syncthreads(); }
    __device__ __forceinline__ int ldk() const { return DM; }
    __device__ __forceinline__ const char* a_base(const Unit&) const { return (const char*)A; }
    __device__ __forceinline__ const char* b_base(const Unit& u) const { return (const char*)Bt + ((size_t)u.e * 1024 + (size_t)u.pn * BM) * DM * 2; }
    __device__ __forceinline__ void a_offs(const Unit& u, const int (&R)[2], const int (&C)[2], unsigned (&off)[2][2]) const {
        const LAS int* rt = rowsL + (u.idx < 15 ? u.idx : 14) * 256;
#pragma unroll
        for (int h = 0; h < 2; ++h)
#pragma unroll
            for (int i = 0; i < 2; ++i) { const int tok = rt[h * HALF + R[i]]; off[h][i] = (unsigned)(tok * DM + C[i]) * 2u; }
    }
};
struct MoeDownSched : MoeSchedBase {
    const bf16_t* A; const bf16_t* Bt; int K;
    __device__ void init(const unsigned* ctrl_, const bf16_t* A_, const bf16_t* Bt_, int part) { init_base(ctrl_, 8, part); A = A_; Bt = Bt_; K = DEXP; }
    __device__ __forceinline__ int ldk() const { return DEXP; }
    __device__ __forceinline__ const char* a_base(const Unit& u) const { return (const char*)A + (size_t)u.pm * BM * DEXP * 2; }
    __device__ __forceinline__ const char* b_base(const Unit& u) const { return (const char*)Bt + ((size_t)u.e * DM + (size_t)u.pn * BM) * DEXP * 2; }
    __device__ __forceinline__ void a_offs(const Unit&, const int (&R)[2], const int (&C)[2], unsigned (&off)[2][2]) const {
#pragma unroll
        for (int h = 0; h < 2; ++h)
#pragma unroll
            for (int i = 0; i < 2; ++i) off[h][i] = (unsigned)((h * HALF + R[i]) * DEXP + C[i]) * 2u;
    }
};

__device__ __forceinline__ unsigned xchg1(unsigned v) { return (unsigned)__builtin_amdgcn_update_dpp(0, (int)v, 0xB1, 0xf, 0xf, false); }
__device__ __forceinline__ float xchg1f(float v) { return __uint_as_float(xchg1(__float_as_uint(v))); }
struct EpiF32 {
    static constexpr int PERM = 0;
    float* C; int ldc;
    __device__ __forceinline__ void operator()(const f32x4 (&acc)[2][2][4][2], const Unit& u, int wr, int wc, int fr, int fq) const {
        const bool odd = (fr & 1) != 0;
        const int rowe = u.pm * BM + wr * 64 + (fr & ~1), col0 = u.pn * BM + wc * 32 + (odd ? 16 : 0) + 4 * fq;
#pragma unroll
        for (int ai = 0; ai < 2; ++ai)
#pragma unroll
            for (int m = 0; m < 4; ++m) { float* rowp = C + (size_t)(rowe + ai * HALF + m * 16) * ldc + col0;
#pragma unroll
                for (int bj = 0; bj < 2; ++bj) {
                    const f32x4 v0 = acc[ai][bj][m][0], v1 = acc[ai][bj][m][1];
                    f32x4 s0, s1;
#pragma unroll
                    for (int k = 0; k < 4; ++k) { const float snd = odd ? v0[k] : v1[k]; const float rcv = xchg1f(snd); s0[k] = odd ? rcv : v0[k]; s1[k] = odd ? v1[k] : rcv; }
                    *(f32x4*)(rowp + bj * HALF) = s0; *(f32x4*)(rowp + ldc + bj * HALF) = s1; } }
    }
};
template <bool NORMS>
struct EpiBf16T {
    static constexpr int PERM = 2;
    bf16_t* O0; int ld0; bf16_t* O1; int ld1; int split0; int split_cols; size_t split_stride;
    float* nrm;
    __device__ __forceinline__ void operator()(const f32x4 (&acc)[2][2][4][2], const Unit& u, int wr, int wc, int fr, int fq) const {
        int colt = u.pn * BM; bf16_t* base = O0; int ldc = ld0;
        int qk = 2;
        if (split_cols) { const int t = colt / split_cols; base += (size_t)t * split_stride; colt -= t * split_cols; qk = t; }
        else if (colt >= split0) { base = O1; ldc = ld1; colt -= split0; }
        const bool odd = (fr & 1) != 0;
        const int col0 = colt + wc * 64 + (odd ? 32 : 0) + 8 * fq;
        const int rowe = u.pm * BM + wr * 64 + (fr & ~1);
#pragma unroll
        for (int ai = 0; ai < 2; ++ai) {
            float mx = 0.f;
#pragma unroll
            for (int m = 0; m < 4; ++m) {
                float lo[8], hi[8], e0[8], e1[8];
#pragma unroll
                for (int k = 0; k < 4; ++k) { lo[k] = acc[ai][0][m][0][k]; lo[4 + k] = acc[ai][0][m][1][k]; hi[k] = acc[ai][1][m][0][k]; hi[4 + k] = acc[ai][1][m][1][k]; }
                if constexpr (NORMS) { float sq = 0.f;
#pragma unroll
                    for (int k = 0; k < 8; ++k) { sq = fmaf(lo[k], lo[k], sq); sq = fmaf(hi[k], hi[k], sq); }
                    sq += __shfl_xor(sq, 16); sq += __shfl_xor(sq, 32); mx = fmaxf(mx, sq); }
#pragma unroll
                for (int k = 0; k < 8; ++k) { const float snd = odd ? lo[k] : hi[k]; const float rcv = xchg1f(snd); e0[k] = odd ? rcv : lo[k]; e1[k] = odd ? hi[k] : rcv; }
                u32x4 s0, s1;
                s0.x = cvt_pk_bf16(e0[0], e0[1]); s0.y = cvt_pk_bf16(e0[2], e0[3]); s0.z = cvt_pk_bf16(e0[4], e0[5]); s0.w = cvt_pk_bf16(e0[6], e0[7]);
                s1.x = cvt_pk_bf16(e1[0], e1[1]); s1.y = cvt_pk_bf16(e1[2], e1[3]); s1.z = cvt_pk_bf16(e1[4], e1[5]); s1.w = cvt_pk_bf16(e1[6], e1[7]);
                bf16_t* rp = base + (size_t)(rowe + ai * HALF + m * 16) * ldc + col0;
                *(u32x4*)rp = s0; *(u32x4*)(rp + ldc) = s1;
            }
            if constexpr (NORMS) {
                mx = fmaxf(mx, __shfl_xor(mx, 1)); mx = fmaxf(mx, __shfl_xor(mx, 2)); mx = fmaxf(mx, __shfl_xor(mx, 4)); mx = fmaxf(mx, __shfl_xor(mx, 8));
                const int Jg = u.pm * 4 + ai * 2 + wr, c = colt + wc * 64;
                if (qk < 2 && fr == 0 && fq == 0) atomicMax((unsigned*)(nrm + ((((size_t)qk * 64 + (Jg >> 6) * 16 + (c >> 7)) * 64 + (Jg & 63)) * 2 + ((c >> 6) & 1))), __float_as_uint(mx));
            }
        }
    }
};
using EpiBf16 = EpiBf16T<false>;
struct EpiFp8 {
    static constexpr int PERM = 2;
    unsigned char* O; int ldc;
    __device__ __forceinline__ void operator()(const f32x4 (&acc)[2][2][4][2], const Unit& u, int wr, int wc, int fr, int fq) const {
        const bool odd = (fr & 1) != 0;
        const int col0 = u.pn * BM + wc * 64 + (odd ? 32 : 0) + 8 * fq;
        const int rowe = u.pm * BM + wr * 64 + (fr & ~1);
#pragma unroll
        for (int ai = 0; ai < 2; ++ai)
#pragma unroll
            for (int m = 0; m < 4; ++m) {
                float lo[8], hi[8];
#pragma unroll
                for (int k = 0; k < 4; ++k) { lo[k] = __builtin_amdgcn_fmed3f(acc[ai][0][m][0][k] * 64.f, -448.f, 448.f); lo[4 + k] = __builtin_amdgcn_fmed3f(acc[ai][0][m][1][k] * 64.f, -448.f, 448.f);
                    hi[k] = __builtin_amdgcn_fmed3f(acc[ai][1][m][0][k] * 64.f, -448.f, 448.f); hi[4 + k] = __builtin_amdgcn_fmed3f(acc[ai][1][m][1][k] * 64.f, -448.f, 448.f); }
                int l0 = __builtin_amdgcn_cvt_pk_fp8_f32(lo[0], lo[1], 0, false); l0 = __builtin_amdgcn_cvt_pk_fp8_f32(lo[2], lo[3], l0, true);
                int l1 = __builtin_amdgcn_cvt_pk_fp8_f32(lo[4], lo[5], 0, false); l1 = __builtin_amdgcn_cvt_pk_fp8_f32(lo[6], lo[7], l1, true);
                int h0 = __builtin_amdgcn_cvt_pk_fp8_f32(hi[0], hi[1], 0, false); h0 = __builtin_amdgcn_cvt_pk_fp8_f32(hi[2], hi[3], h0, true);
                int h1 = __builtin_amdgcn_cvt_pk_fp8_f32(hi[4], hi[5], 0, false); h1 = __builtin_amdgcn_cvt_pk_fp8_f32(hi[6], hi[7], h1, true);
                const unsigned s0 = odd ? (unsigned)l0 : (unsigned)h0, s1 = odd ? (unsigned)l1 : (unsigned)h1;
                const unsigned r0 = xchg1(s0), r1 = xchg1(s1);
                u32x2 e0, e1;
                e0.x = odd ? r0 : (unsigned)l0; e0.y = odd ? r1 : (unsigned)l1; e1.x = odd ? (unsigned)h0 : r0; e1.y = odd ? (unsigned)h1 : r1;
                unsigned char* rp = O + (size_t)(rowe + ai * HALF + m * 16) * ldc + col0;
                *(u32x2*)rp = e0; *(u32x2*)(rp + ldc) = e1;
            }
    }
};
__device__ __forceinline__ float silu_f(float g) { return g * __builtin_amdgcn_rcpf(1.0f + __builtin_amdgcn_exp2f(-1.4426950408889634f * g)); }
struct EpiSwiGLU {
    static constexpr int PERM = 1;
    bf16_t* H;
    __device__ __forceinline__ void operator()(const f32x4 (&acc)[2][2][4][2], const Unit& u, int wr, int wc, int fr, int fq) const {
        const int row0 = u.pm * BM + wr * 64 + fr, col0 = u.pn * HALF + wc * 32 + 8 * fq;
#pragma unroll
        for (int ai = 0; ai < 2; ++ai)
#pragma unroll
            for (int m = 0; m < 4; ++m) { bf16_t* rowp = H + (size_t)(row0 + ai * HALF + m * 16) * DEXP + col0;
                const f32x4 g0 = acc[ai][0][m][0], g1 = acc[ai][0][m][1], u0 = acc[ai][1][m][0], u1 = acc[ai][1][m][1];
                u32x4 w; w.x = cvt_pk_bf16(silu_f(g0[0]) * u0[0], silu_f(g0[1]) * u0[1]); w.y = cvt_pk_bf16(silu_f(g0[2]) * u0[2], silu_f(g0[3]) * u0[3]);
                w.z = cvt_pk_bf16(silu_f(g1[0]) * u1[0], silu_f(g1[1]) * u1[1]); w.w = cvt_pk_bf16(silu_f(g1[2]) * u1[2], silu_f(g1[3]) * u1[3]);
                *(u32x4*)rowp = w; }
    }
};

template <class Epi, class Sched>
__device__ __forceinline__ void gemm_phase(LAS unsigned char* lds, const Sched& S, const Epi& E) {
    const int tid = tidx(), wid = __builtin_amdgcn_readfirstlane(tid >> 6), lane = tid & 63, wr = wid >> 2, wc = wid & 3, fr = lane & 15, fq = lane >> 4;
    const int K = S.K, nt = K / BK;
    int Rr[2], Cc[2]; unsigned voffB[2];
#pragma unroll
    for (int i = 0; i < 2; ++i) { int R, C; stage_rc(tid * 16 + i * 8192, R, C); Rr[i] = R; Cc[i] = C; const int Rb = Epi::PERM == 2 ? (64 * (R >> 5) + perm32(R & 31)) : Epi::PERM ? ((R & ~31) + perm32(R & 31)) : R; voffB[i] = (unsigned)(Rb * S.ldk() + C) * 2u; }
    const size_t kstep = (size_t)(BK * 2);
    const size_t hstep = (size_t)(Epi::PERM == 2 ? 32 : HALF) * S.ldk() * 2;
    const unsigned ldsw = (unsigned)wid * 1024u;
    const int aoff = lds_byte(wr * 64 + fr, fq * 8), boff = lds_byte(wc * 32 + fr, fq * 8);
#define PG8_SA(b, h) (((b) * 2 + (h)) * HTB)
#define PG8_SB(b, h) ((4 + (b) * 2 + (h)) * HTB)
#define PG8_STAGE(bufoff, gbase, voff) do { _Pragma("unroll") for (int _i = 0; _i < 2; ++_i) \
        __builtin_amdgcn_global_load_lds((const unsigned*)((const char*)(gbase) + (voff)[_i]), (LAS unsigned*)(lds + (bufoff) + ldsw + _i * 8192), 16, 0, 0); } while (0)
#define PG8_LDA(dst, b, h) do { _Pragma("unroll") for (int m = 0; m < 4; ++m) _Pragma("unroll") for (int k = 0; k < 2; ++k) dst[m][k] = *(const LAS bf16x8*)(lds + PG8_SA(b, h) + aoff + m * 2048 + k * 1024); } while (0)
#define PG8_LDB(dst, b, h) do { _Pragma("unroll") for (int n = 0; n < 2; ++n) _Pragma("unroll") for (int k = 0; k < 2; ++k) dst[n][k] = *(const LAS bf16x8*)(lds + PG8_SB(b, h) + boff + n * 2048 + k * 1024); } while (0)
#define PG8_MMA(ai, bj, At, Bt) do { __builtin_amdgcn_s_setprio(1); _Pragma("unroll") for (int m = 0; m < 4; ++m) _Pragma("unroll") for (int n = 0; n < 2; ++n) _Pragma("unroll") for (int k = 0; k < 2; ++k) \
        acc[ai][bj][m][n] = __builtin_amdgcn_mfma_f32_16x16x32_bf16(Bt[n][k], At[m][k], acc[ai][bj][m][n], 0, 0, 0); __builtin_amdgcn_s_setprio(0); } while (0)
#define PG8_WAIT_V(n) asm volatile("s_waitcnt vmcnt(" #n ")" ::: "memory")
#define PG8_WAIT_L(n) asm volatile("s_waitcnt lgkmcnt(" #n ")" ::: "memory")
#define PG8_BAR __builtin_amdgcn_s_barrier()
#define PG8_SCHED __builtin_amdgcn_sched_barrier(0)
    Unit cur, nxt; int ui = 0;
    if (!S.next(0, cur)) return;
    f32x4 acc[2][2][4][2];
#pragma unroll
    for (int a = 0; a < 2; ++a)
#pragma unroll
        for (int b = 0; b < 2; ++b)
#pragma unroll
            for (int m = 0; m < 4; ++m)
#pragma unroll
                for (int n = 0; n < 2; ++n) acc[a][b][m][n] = (f32x4){0.f, 0.f, 0.f, 0.f};
    bf16x8 At[4][2], B0[2][2], B1[2][2];
    unsigned offC[2][2], offN[2][2];
    S.a_offs(cur, Rr, Cc, offC);
    const char* cA = S.a_base(cur); const char* cB = S.b_base(cur);
    const int rot = S.rot() & (nt - 1), ntm = nt - 1;
    const size_t kstepA = S.kstep_a(), kstepB = S.kstep_b();
#define PG8_KOFF(t_) ((size_t)(((t_) + rot) & ntm) * kstepB)
#define PG8_KOFFA(t_) ((size_t)(((t_) + rot) & ntm) * kstepA)
    PG8_STAGE(PG8_SB(0, 0), cB + PG8_KOFF(0), voffB); PG8_STAGE(PG8_SA(0, 0), cA + PG8_KOFFA(0), offC[0]); PG8_STAGE(PG8_SB(0, 1), cB + hstep + PG8_KOFF(0), voffB); PG8_STAGE(PG8_SA(0, 1), cA + PG8_KOFFA(0), offC[1]);
    if (wr == 1) PG8_BAR;
    PG8_WAIT_V(4); PG8_BAR;
    PG8_STAGE(PG8_SB(1, 0), cB + PG8_KOFF(1), voffB); PG8_STAGE(PG8_SA(1, 0), cA + PG8_KOFFA(1), offC[0]); PG8_STAGE(PG8_SB(1, 1), cB + hstep + PG8_KOFF(1), voffB);
    PG8_WAIT_V(6); PG8_BAR;
    for (;;) {
        const bool has_next = S.next(ui + 1, nxt);
        const char* nA = has_next ? S.a_base(nxt) : cA; const char* nB = has_next ? S.b_base(nxt) : cB;
        if (has_next) S.a_offs(nxt, Rr, Cc, offN);
        else {
#pragma unroll
            for (int h = 0; h < 2; ++h)
#pragma unroll
                for (int i = 0; i < 2; ++i) offN[h][i] = offC[h][i]; }
        for (int t = 0; t < nt; t += 2) {
            const bool last = (t == nt - 2);
            const char* a1 = cA + PG8_KOFFA(t + 1);
            const char* a2 = (last ? nA : cA) + PG8_KOFFA(t + 2); const char* b2 = (last ? nB : cB) + PG8_KOFF(t + 2);
            const char* a3 = (last ? nA : cA) + PG8_KOFFA(t + 3); const char* b3 = (last ? nB : cB) + PG8_KOFF(t + 3);
            unsigned o2[2][2];
#pragma unroll
            for (int h = 0; h < 2; ++h)
#pragma unroll
                for (int i = 0; i < 2; ++i) o2[h][i] = last ? offN[h][i] : offC[h][i];
            PG8_LDB(B0, 0, 0); PG8_SCHED; PG8_LDA(At, 0, 0); PG8_STAGE(PG8_SA(1, 1), a1, offC[1]);
            PG8_WAIT_L(8); PG8_BAR; PG8_WAIT_L(0); PG8_MMA(0, 0, At, B0); PG8_BAR; PG8_SCHED;
            PG8_LDB(B1, 0, 1); PG8_STAGE(PG8_SB(0, 0), b2, voffB);
            PG8_BAR; PG8_WAIT_L(0); PG8_MMA(0, 1, At, B1); PG8_BAR;
            PG8_LDA(At, 0, 1); PG8_STAGE(PG8_SA(0, 0), a2, o2[0]);
            PG8_BAR; PG8_WAIT_L(0); PG8_MMA(1, 0, At, B0); PG8_BAR; PG8_SCHED;
            PG8_STAGE(PG8_SB(0, 1), b2 + hstep, voffB);
            PG8_WAIT_V(6); PG8_BAR; PG8_MMA(1, 1, At, B1); PG8_BAR;
            PG8_LDB(B0, 1, 0); PG8_SCHED; PG8_LDA(At, 1, 0); PG8_STAGE(PG8_SA(0, 1), a2, o2[1]);
            PG8_WAIT_L(8); PG8_BAR; PG8_WAIT_L(0); PG8_MMA(0, 0, At, B0); PG8_BAR; PG8_SCHED;
            PG8_LDB(B1, 1, 1); PG8_STAGE(PG8_SB(1, 0), b3, voffB);
            PG8_BAR; PG8_WAIT_L(0); PG8_MMA(0, 1, At, B1); PG8_BAR;
            PG8_LDA(At, 1, 1); PG8_STAGE(PG8_SA(1, 0), a3, o2[0]);
            PG8_BAR; PG8_WAIT_L(0); PG8_MMA(1, 0, At, B0); PG8_BAR; PG8_SCHED;
            PG8_STAGE(PG8_SB(1, 1), b3 + hstep, voffB);
            PG8_WAIT_V(6); PG8_BAR; PG8_MMA(1, 1, At, B1); PG8_BAR;
        }
        E(acc, cur, wr, wc, fr, fq);
        if (!has_next) break;
#pragma unroll
        for (int a = 0; a < 2; ++a)
#pragma unroll
            for (int b = 0; b < 2; ++b)
#pragma unroll
                for (int m = 0; m < 4; ++m)
#pragma unroll
                    for (int n = 0; n < 2; ++n) acc[a][b][m][n] = (f32x4){0.f, 0.f, 0.f, 0.f};
        cur = nxt; cA = nA; cB = nB; ++ui;
#pragma unroll
        for (int h = 0; h < 2; ++h)
#pragma unroll
            for (int i = 0; i < 2; ++i) offC[h][i] = offN[h][i];
    }
    PG8_WAIT_V(0);
    if (wr == 0) PG8_BAR;
    PG8_BAR;
#undef PG8_KOFF
#undef PG8_KOFFA
#undef PG8_SA
#undef PG8_SB
#undef PG8_STAGE
#undef PG8_LDA
#undef PG8_LDB
#undef PG8_MMA
#undef PG8_WAIT_V
#undef PG8_WAIT_L
#undef PG8_BAR
#undef PG8_SCHED
}
}

namespace fox {
constexpr int D = 128, LD = DM, NW = 8, QBLK = 32, KVBLK = 64, QB = NW * QBLK;
constexpr int SHM_V = KVBLK * D * 2, SHM_K = KVBLK * D * 2;
constexpr int OFF_WS = 2 * SHM_V + 2 * SHM_K, OFF_G = OFF_WS + NW * 64 * 4, GBUF = SEQ * 4, LDS_BYTES = OFF_G + 2 * GBUF;
constexpr float SCALE = 0.08838834764831845f, THR = 8.f;

#define KSWZ(row, colB) ((row) * 256 + ((colB) ^ (((row) & 7) << 4)))
#define SBAR() __builtin_amdgcn_sched_barrier(0)
__device__ __forceinline__ int v_st(int k, int c) { const int kk = (k & ~0xC) | ((k & 4) << 1) | ((k & 8) >> 1); return ((kk >> 3) * 4 + (c >> 5)) * 512 + ((kk & 7) * 32 + (c & 31)) * 2; }
__device__ __forceinline__ int v_rd_base(int lane) { return ((lane & 3) << 3) | (((lane >> 2) & 3) << 6) | (((lane >> 4) & 1) << 5) | (((lane >> 5) & 1) << 8); }
constexpr int v_rd_off(int d0, int ks, int half) { return d0 * 512 + ks * 4096 + half * 2048; }
__device__ __forceinline__ int crow(int r, int hi) { return (r & 3) + 8 * (r >> 2) + 4 * hi; }
__device__ __forceinline__ bf16x8 load8(const bf16_t* p) { return *reinterpret_cast<const bf16x8*>(p); }

__device__ __forceinline__ void mask_tile(f32x16& p0, f32x16& p1, int dq) {
    const float NEG = -__builtin_inff();
#pragma unroll
    for (int r = 0; r < 16; ++r) {
        const int c = (r & 3) + 8 * (r >> 2);
        if (dq - c < 0) p0[r] = NEG;
        if (dq - c - 32 < 0) p1[r] = NEG;
    }
}
__device__ __forceinline__ void bias_tile(f32x16& p0, f32x16& p1, const float* gl, int hi) {
#pragma unroll
    for (int j = 0; j < 4; ++j) {
        const f32x4 a = *(const f32x4*)(gl + 8 * j + 4 * hi), b = *(const f32x4*)(gl + 32 + 8 * j + 4 * hi);
#pragma unroll
        for (int i = 0; i < 4; ++i) { p0[4 * j + i] += a[i]; p1[4 * j + i] += b[i]; }
    }
}
__device__ __forceinline__ void partialSM(f32x16& p0, f32x16& p1, float& m_reg, float& mn, float& alpha) {
    float pmax = p0[0];
#pragma unroll
    for (int r = 1; r < 16; ++r) pmax = fmaxf(pmax, p0[r]);
#pragma unroll
    for (int r = 0; r < 16; ++r) pmax = fmaxf(pmax, p1[r]);
    { auto rr = __builtin_amdgcn_permlane32_swap(__float_as_uint(pmax), __float_as_uint(pmax), false, false);
      pmax = fmaxf(__uint_as_float(rr[0]), __uint_as_float(rr[1])); }
    constexpr float C2 = 1.4426950408889634f * SCALE;
    if (__builtin_expect(__all((pmax - m_reg) * SCALE <= THR), 1)) { mn = m_reg; alpha = 1.f; }
    else { mn = fmaxf(m_reg, pmax); alpha = __builtin_amdgcn_exp2f((m_reg - mn) * C2); m_reg = mn; }
    const float mnL = -mn * C2;
#pragma unroll
    for (int r = 0; r < 16; ++r) p0[r] = fmaf(p0[r], C2, mnL);
#pragma unroll
    for (int r = 0; r < 16; ++r) p1[r] = fmaf(p1[r], C2, mnL);
#pragma unroll
    for (int r = 0; r < 16; ++r) p0[r] = __builtin_amdgcn_exp2f(p0[r]);
}
__device__ __forceinline__ void finishSM(f32x16& p0, f32x16& p1, float alpha, float& l_reg, bf16x8& pa0, bf16x8& pa1, bf16x8& pa2, bf16x8& pa3) {
#pragma unroll
    for (int r = 0; r < 16; ++r) p1[r] = __builtin_amdgcn_exp2f(p1[r]);
    float ps = 0;
#pragma unroll
    for (int r = 0; r < 16; ++r) ps += p0[r];
#pragma unroll
    for (int r = 0; r < 16; ++r) ps += p1[r];
    { auto rr = __builtin_amdgcn_permlane32_swap(__float_as_uint(ps), __float_as_uint(ps), false, false);
      ps = __uint_as_float(rr[0]) + __uint_as_float(rr[1]); }
    l_reg = l_reg * alpha + ps;
#define PK4(P, B_, OUT) do { unsigned a0 = cvt_pk_bf16(P[B_+0], P[B_+1]), a1 = cvt_pk_bf16(P[B_+2], P[B_+3]);                          \
        unsigned b0 = cvt_pk_bf16(P[B_+4], P[B_+5]), b1 = cvt_pk_bf16(P[B_+6], P[B_+7]);                                             \
        auto r0 = __builtin_amdgcn_permlane32_swap(a0, b0, false, false); auto r1 = __builtin_amdgcn_permlane32_swap(a1, b1, false, false); \
        u32x4 w = {r0[0], r1[0], r0[1], r1[1]}; OUT = *reinterpret_cast<bf16x8*>(&w); } while (0)
    PK4(p0, 0, pa0); PK4(p0, 8, pa1); PK4(p1, 0, pa2); PK4(p1, 8, pa3);
#undef PK4
}
template <int KB>
__device__ __forceinline__ void qkt(f32x16& p0, f32x16& p1, const char* K_lds, int r32, int hi, const bf16x8* qr) {
    p0 = f32x16{}; p1 = f32x16{};
    const char* kb[4];
#pragma unroll
    for (int dd = 0; dd < 4; ++dd) kb[dd] = K_lds + KB * SHM_K + KSWZ(r32, (dd * 16 + hi * 8) * 2);
#pragma unroll
    for (int d0 = 0; d0 < 8; ++d0) { const char* a = kb[d0 & 3] + (d0 >> 2) * 128;
        bf16x8 b0 = *reinterpret_cast<const bf16x8*>(a);
        bf16x8 b1 = *reinterpret_cast<const bf16x8*>(a + 32 * 256);
        p0 = __builtin_amdgcn_mfma_f32_32x32x16_bf16(b0, qr[d0], p0, 0, 0, 0);
        p1 = __builtin_amdgcn_mfma_f32_32x32x16_bf16(b1, qr[d0], p1, 0, 0, 0); }
}
template <int VB>
__device__ __forceinline__ void pv_tile(f32x16* o, int vb0, bf16x8 pa0, bf16x8 pa1, bf16x8 pa2, bf16x8 pa3) {
#define TRRD(dst, off) asm volatile("ds_read_b64_tr_b16 %0, %1 offset:%2" : "=&v"(dst) : "v"(vb0), "i"(off) : "memory")
#define PV_D0(d0) do { s16x4 l0, l1, l2, l3, h0, h1, h2, h3; constexpr int b_ = VB * SHM_V + v_rd_off(d0, 0, 0);     \
        TRRD(l0, b_); TRRD(h0, b_ + 2048); TRRD(l1, b_ + 4096); TRRD(h1, b_ + 6144); TRRD(l2, b_ + 8192); TRRD(h2, b_ + 10240); TRRD(l3, b_ + 12288); TRRD(h3, b_ + 14336); \
        asm volatile("s_waitcnt lgkmcnt(0)" ::: "memory"); SBAR();                                                    \
        o[d0] = __builtin_amdgcn_mfma_f32_32x32x16_bf16(pa0, (bf16x8){l0[0], l0[1], l0[2], l0[3], h0[0], h0[1], h0[2], h0[3]}, o[d0], 0, 0, 0);   \
        o[d0] = __builtin_amdgcn_mfma_f32_32x32x16_bf16(pa1, (bf16x8){l1[0], l1[1], l1[2], l1[3], h1[0], h1[1], h1[2], h1[3]}, o[d0], 0, 0, 0);   \
        o[d0] = __builtin_amdgcn_mfma_f32_32x32x16_bf16(pa2, (bf16x8){l2[0], l2[1], l2[2], l2[3], h2[0], h2[1], h2[2], h2[3]}, o[d0], 0, 0, 0);   \
        o[d0] = __builtin_amdgcn_mfma_f32_32x32x16_bf16(pa3, (bf16x8){l3[0], l3[1], l3[2], l3[3], h3[0], h3[1], h3[2], h3[3]}, o[d0], 0, 0, 0); } while (0)
    PV_D0(0); PV_D0(1); PV_D0(2); PV_D0(3);
#undef PV_D0
#undef TRRD
}

struct BlockRef { const bf16_t* Q; const bf16_t* K; const bf16_t* V; const float* G; bf16_t* O; int P0; int jlo; };
struct Seam { bf16x8 qr[8]; bf16x8 st_v0, st_v1, st_k0, st_k1; int gsel; };
#define ROW(p, k0, rr) ((p) + (size_t)((k0) + (rr)) * LD + sc)
#define VMW() asm volatile("s_waitcnt vmcnt(0)" ::: "memory")
#define VMWN(n) asm volatile("s_waitcnt vmcnt(%0)" :: "i"(n) : "memory")
#define SLOAD_H(Kp, Vp, k0) do { S.st_v0 = load8(ROW(Vp, k0, sr)); S.st_v1 = load8(ROW(Vp, k0, 32 + sr));              \
                         S.st_k0 = load8(ROW(Kp, k0, sr)); S.st_k1 = load8(ROW(Kp, k0, 32 + sr)); } while (0)
#define SWRITE_HK(bf) do { *(bf16x8*)(K_lds + (bf) * SHM_K + kws) = S.st_k0; *(bf16x8*)(K_lds + (bf) * SHM_K + kws + 32 * 256) = S.st_k1; } while (0)
#define GDMA(Gp, gb) do { _Pragma("unroll") for (int k_ = 0; k_ < 2; ++k_) __builtin_amdgcn_global_load_lds((const unsigned*)((const char*)(Gp) + k_ * 8192 + tid * 16), \
                           (LAS unsigned*)((LAS char*)(lds_las) + OFF_G + (gb) * GBUF + k_ * 8192 + wid * 1024), 16, 0, 0); } while (0)
#define SWRITE_HV(bf) do { *(bf16x8*)(V_lds + (bf) * SHM_V + vst0) = S.st_v0; *(bf16x8*)(V_lds + (bf) * SHM_V + vst1) = S.st_v1; } while (0)
#define SWRITE_H(bf) do { SWRITE_HV(bf); SWRITE_HK(bf); } while (0)
__device__ __forceinline__ void fox_prime(const BlockRef& cur, char* lds, Seam& S) {
    const int tid = tidx(), wid = __builtin_amdgcn_readfirstlane(tid >> 6), lane = tid & 63, r32 = lane & 31, hi = lane >> 5;
    const int sr = tid >> 4, sc = (tid & 15) * 8, kws = KSWZ(sr, sc * 2); char* K_lds = lds + 2 * SHM_V; LAS char* lds_las = (LAS char*)lds;
    const int kb0 = cur.jlo * KVBLK;
    S.gsel = 0; GDMA(cur.G, 0);
#pragma unroll
    for (int d0 = 0; d0 < 8; ++d0) S.qr[d0] = load8(cur.Q + (size_t)(wid * QBLK + r32) * LD + d0 * 16 + hi * 8);
    SLOAD_H(cur.K, cur.V, kb0); VMW(); SWRITE_HK(0);
    __syncthreads();
}
__device__ __forceinline__ void fox_block(const BlockRef& cur, const BlockRef& nxt, char* lds, Seam& S) {
    const int tid = tidx(), wid = __builtin_amdgcn_readfirstlane(tid >> 6), lane = tid & 63, r32 = lane & 31, hi = lane >> 5;
    const int j_lo = cur.jlo;
    const int j_hi = (cur.P0 + QB - 1) / KVBLK + 1;
    const int NT = j_hi - j_lo;
    const int kbn = nxt.jlo * KVBLK;
    const int qlo = cur.P0 + wid * QBLK, qm = qlo + r32 - 4 * hi;
    char* V_lds = lds; char* K_lds = lds + 2 * SHM_V; LAS char* lds_las = (LAS char*)lds; const float* G_cur = (const float*)(lds + OFF_G + S.gsel * GBUF);
    float* ws = (float*)(lds + OFF_WS) + wid * 64; float* li_l = ws, * al_l = ws + 32;
    float m_reg = -1e30f, l_reg = 0; f32x16 o[4] = {};
    const int sr = tid >> 4, sc = (tid & 15) * 8, vst0 = v_st(sr, sc), vst1 = v_st(32 + sr, sc), kws = KSWZ(sr, sc * 2);
    const int vb0 = (int)(uintptr_t)V_lds + v_rd_base(lane);
    const bf16_t* Kh = cur.K; const bf16_t* Vh = cur.V;
#define RESC(a) do { if (__any((a) < 1.f)) { if (hi == 0) al_l[r32] = (a); asm volatile("s_waitcnt lgkmcnt(0)" ::: "memory");              \
                     for (int d_ = 0; d_ < 4; ++d_) for (int r = 0; r < 16; ++r) o[d_][r] *= al_l[crow(r, hi)]; } } while (0)
#define KBASE(t) ((j_lo + (t)) * KVBLK)
#define BIASMASK(P0_, P1_, t, KB) do { const int kb_ = KBASE(t); bias_tile(P0_, P1_, G_cur + kb_, hi); if (kb_ + KVBLK - 1 > qlo) mask_tile(P0_, P1_, qm - kb_); } while (0)
    constexpr int NQL = 8;
#define SEAM_K0() do { VMWN(NQL); SWRITE_HK(0); SBAR(); } while (0)
    f32x16 pA0, pA1, pB0, pB1; float mnA, mnB, alA, alB; bf16x8 pa0, pa1, pa2, pa3;
    SWRITE_HV(0); SBAR();
    if (NT > 1) { SLOAD_H(Kh, Vh, KBASE(1)); }
    SBAR(); qkt<0>(pA0, pA1, K_lds, r32, hi, S.qr);
    BIASMASK(pA0, pA1, 0, 0); partialSM(pA0, pA1, m_reg, mnA, alA);
    if (NT > 1) { VMW(); SWRITE_H(1); }
    __syncthreads();
#define HALF_STEP(PX0, PX1, mnX, alX, PY0, PY1, alY, t, KB, VB, SB) do {                                                      \
        SBAR(); qkt<KB>(PX0, PX1, K_lds, r32, hi, S.qr);                                                         \
        finishSM(PY0, PY1, alY, l_reg, pa0, pa1, pa2, pa3); SBAR();                                                           \
        if ((t) + 1 < NT) { SLOAD_H(Kh, Vh, KBASE((t) + 1)); SBAR(); }                                                    \
        pv_tile<VB>(o, vb0, pa0, pa1, pa2, pa3); BIASMASK(PX0, PX1, (t), KB); partialSM(PX0, PX1, m_reg, mnX, alX);          \
        __syncthreads();                                                                                                      \
        if ((t) + 1 < NT) { VMW(); SWRITE_H(SB); }                                                                            \
        RESC(alX); __syncthreads(); } while (0)
    for (int t = 1; t + 1 < NT; t += 2) {
        HALF_STEP(pB0, pB1, mnB, alB, pA0, pA1, alA, t, 1, 0, 0);
        HALF_STEP(pA0, pA1, mnA, alA, pB0, pB1, alB, t + 1, 0, 1, 1);
    }
    const bool even = (NT & 1) == 0;
    if (even) { SBAR(); qkt<1>(pB0, pB1, K_lds, r32, hi, S.qr); SBAR(); }
    GDMA(nxt.G, S.gsel ^ 1); SLOAD_H(nxt.K, nxt.V, kbn); SBAR();
#pragma unroll
    for (int d0 = 0; d0 < 8; ++d0) S.qr[d0] = load8(nxt.Q + (size_t)(wid * QBLK + r32) * LD + d0 * 16 + hi * 8);
    SBAR();
    finishSM(pA0, pA1, alA, l_reg, pa0, pa1, pa2, pa3); SBAR();
    pv_tile<0>(o, vb0, pa0, pa1, pa2, pa3);
    if (even) { BIASMASK(pB0, pB1, NT - 1, 1); partialSM(pB0, pB1, m_reg, mnB, alB); __syncthreads(); RESC(alB);
        finishSM(pB0, pB1, alB, l_reg, pa0, pa1, pa2, pa3); SBAR(); pv_tile<1>(o, vb0, pa0, pa1, pa2, pa3); }
    SBAR(); SEAM_K0();
    if (hi == 0) li_l[r32] = l_reg; asm volatile("s_waitcnt lgkmcnt(0)" ::: "memory");
    float rli[16];
#pragma unroll
    for (int r = 0; r < 16; ++r) rli[r] = __builtin_amdgcn_rcpf(li_l[crow(r, hi)]);
    int lane2 = lane; asm volatile("" : "+v"(lane2));
    const int r32b = lane2 & 31, hib = lane2 >> 5;
    bf16_t* Ow = cur.O + (size_t)(wid * QBLK) * LD + r32b;
#pragma unroll
    for (int r = 0; r < 16; ++r) { const int orow = crow(r, hib);
#pragma unroll
        for (int d0 = 0; d0 < 4; ++d0) { const float v = o[d0][r] * rli[r];
            const float vn = __shfl_xor(v, 1);
            if ((r32b & 1) == 0) *(unsigned*)(Ow + (size_t)orow * LD + d0 * 32) = cvt_pk_bf16(v, vn); } }
    S.gsel ^= 1;
    __syncthreads();
#undef RESC
#undef KBASE
#undef BIASMASK
#undef SEAM_K0
#undef HALF_STEP
}
#undef ROW
#undef VMW
#undef VMWN
#undef SLOAD_H
#undef SWRITE_HK
#undef GDMA
#undef SWRITE_HV
#undef SWRITE_H
#undef KSWZ
#undef SBAR
}

__device__ __forceinline__ int gwave() { return blockIdx.x * NWAVES + (tidx() >> 6); }
__device__ __forceinline__ int nwave() { return NBLK * NWAVES; }

__device__ __forceinline__ void cvt_wtile(LAS unsigned char* tl, const float* src, int ld, int Nvalid, bf16_t* dst, int Kdst, int k0, int n0, int drow0, int lane) {
    const int n = n0 + lane;
    float v[64];
    if (n < Nvalid) {
        const float* sp = src + (size_t)k0 * ld + n;
#pragma unroll
        for (int k = 0; k < 64; ++k) v[k] = __builtin_nontemporal_load(sp + (size_t)k * ld);
    } else {
#pragma unroll
        for (int k = 0; k < 64; ++k) v[k] = 0.f;
    }
    LAS unsigned char* wl = tl + (tidx() >> 6) * 9216;
#pragma unroll
    for (int q = 0; q < 8; ++q) {
        u32x4 w; w.x = cvt_pk_bf16(v[8 * q], v[8 * q + 1]); w.y = cvt_pk_bf16(v[8 * q + 2], v[8 * q + 3]); w.z = cvt_pk_bf16(v[8 * q + 4], v[8 * q + 5]); w.w = cvt_pk_bf16(v[8 * q + 6], v[8 * q + 7]);
        *(LAS u32x4*)(wl + lane * 144 + q * 16) = w;
    }
    const int rr = lane >> 3, ch = lane & 7;
#pragma unroll
    for (int it = 0; it < 8; ++it) {
        const u32x4 w = *(LAS u32x4*)(wl + (it * 8 + rr) * 144 + ch * 16);
        *(u32x4*)(dst + (size_t)(drow0 + it * 8 + rr) * Kdst + k0 + ch * 8) = w;
    }
}
__device__ __forceinline__ void cvt_matrix_tile(LAS float* tl, const float* src, int ld, int K, int Nvalid, bf16_t* dst, int mode, int tile, int ntn) {
    const int kt = tile / ntn, nt_ = tile - kt * ntn, n0 = nt_ * 64;
    int drow0 = n0;
    if (mode == 1) drow0 = (n0 >> 7) * 256 + (n0 & 127);
    else if (mode == 2) drow0 = (n0 >> 7) * 256 + 128 + (n0 & 127);
    cvt_wtile((LAS unsigned char*)tl, src, ld, Nvalid, dst, K, kt * 64, n0, drow0, tidx() & 63);
}
struct CvtRef { const float* sp; size_t ld; bf16_t* dp; int Kdst; };
__device__ __forceinline__ CvtRef cvt_moe_ref(const Params& p, int L, int w, int lane) {
    bf16_t* Wgu = (bf16_t*)(p.ws + OFF_WGU + (size_t)L * MOE_LSTRIDE); bf16_t* Wd = (bf16_t*)(p.ws + OFF_WD + (size_t)L * MOE_LSTRIDE);
    int e, which, tile;
    if (w < 65 * 512) { e = w >> 9; which = (w >> 8) & 1; tile = w & 255; } else { const int v = w - 65 * 512; e = v >> 8; which = 2; tile = v & 255; }
    CvtRef c;
    if (which < 2) {
        const float* src = which == 0 ? (e < 64 ? p.w_gate + ((size_t)L * 64 + e) * DM * DEXP : p.sh_gate + (size_t)L * DM * DEXP) : (e < 64 ? p.w_up + ((size_t)L * 64 + e) * DM * DEXP : p.sh_up + (size_t)L * DM * DEXP);
        const int kt = tile >> 3, n0 = (tile & 7) * 64, drow0 = (n0 >> 7) * 256 + which * 128 + (n0 & 127);
        c.sp = src + (size_t)kt * 64 * DEXP + n0 + lane; c.ld = DEXP; c.Kdst = DM; c.dp = Wgu + (size_t)e * 1024 * DM + (size_t)drow0 * DM + kt * 64;
    } else {
        const float* src = e < 64 ? p.w_down + ((size_t)L * 64 + e) * DEXP * DM : p.sh_down + (size_t)L * DEXP * DM;
        const int kt = tile >> 5, n0 = (tile & 31) * 64;
        c.sp = src + (size_t)kt * 64 * DM + n0 + lane; c.ld = DM; c.Kdst = DEXP; c.dp = Wd + (size_t)e * DM * DEXP + (size_t)n0 * DEXP + kt * 64;
    }
    return c;
}
__device__ __forceinline__ void cvt_ld(const CvtRef& c, float (&v)[64]) {
#pragma unroll
    for (int k = 0; k < 64; ++k) v[k] = __builtin_nontemporal_load(c.sp + (size_t)k * c.ld);
}
__device__ __forceinline__ void cvt_st(const CvtRef& c, const float (&v)[64], LAS unsigned char* wl, int lane) {
#pragma unroll
    for (int q = 0; q < 8; ++q) {
        u32x4 w; w.x = cvt_pk_bf16(v[8 * q], v[8 * q + 1]); w.y = cvt_pk_bf16(v[8 * q + 2], v[8 * q + 3]); w.z = cvt_pk_bf16(v[8 * q + 4], v[8 * q + 5]); w.w = cvt_pk_bf16(v[8 * q + 6], v[8 * q + 7]);
        *(LAS u32x4*)(wl + lane * 144 + q * 16) = w;
    }
    const int rr = lane >> 3, ch = lane & 7;
#pragma unroll
    for (int it = 0; it < 8; ++it) {
        const u32x4 w = *(LAS u32x4*)(wl + (it * 8 + rr) * 144 + ch * 16);
        *(u32x4*)(c.dp + (size_t)(it * 8 + rr) * c.Kdst + ch * 8) = w;
    }
}
__device__ __forceinline__ void cvt_moe_run(const Params& p, LAS unsigned char* wl, int L, int w, const int nw, const int total, const int lane) {
    if (w >= total) return;
    float va[64], vb[64];
    CvtRef ca = cvt_moe_ref(p, L, w, lane), cb = ca;
    cvt_ld(ca, va);
    for (;;) {
        const bool hb = w + nw < total;
        cb = cvt_moe_ref(p, L, hb ? w + nw : w, lane); cvt_ld(cb, vb);
        cvt_st(ca, va, wl, lane);
        if (!hb) break;
        w += nw;
        const bool ha = w + nw < total;
        ca = cvt_moe_ref(p, L, ha ? w + nw : w, lane); cvt_ld(ca, va);
        cvt_st(cb, vb, wl, lane);
        if (!ha) break;
        w += nw;
    }
}
__device__ __forceinline__ void cvt_ld4(const CvtRef& c, int lane, f32x4 (&v)[16]) {
    const float* sp = c.sp + (size_t)(lane >> 4) * c.ld + 4 * (lane & 15);
#pragma unroll
    for (int i = 0; i < 16; ++i) v[i] = __builtin_nontemporal_load((const f32x4*)(sp + (size_t)(4 * i) * c.ld));
}
__device__ __forceinline__ void cvt_st4(const CvtRef& c, const f32x4 (&v)[16], LAS unsigned char* wl, int lane) {
    const int cq = lane & 15, r = lane >> 4;
    LAS unsigned char* wp = wl + (4 * cq + (r & 1)) * 136 + (r >> 1) * 4;
#pragma unroll
    for (int i = 0; i < 16; ++i)
#pragma unroll
        for (int jp = 0; jp < 2; ++jp) {
            const auto sw = __builtin_amdgcn_permlane16_swap(__float_as_uint(v[i][2 * jp]), __float_as_uint(v[i][2 * jp + 1]), false, false);
            *(LAS unsigned*)(wp + jp * 272 + i * 8) = cvt_pk_bf16(__uint_as_float(sw[0]), __uint_as_float(sw[1]));
        }
    const int rr = lane >> 3, ch = lane & 7;
#pragma unroll
    for (int it = 0; it < 8; ++it) {
        const u32x2 w0 = *(LAS u32x2*)(wl + (it * 8 + rr) * 136 + ch * 16), w1 = *(LAS u32x2*)(wl + (it * 8 + rr) * 136 + ch * 16 + 8);
        *(u32x4*)(c.dp + (size_t)(it * 8 + rr) * c.Kdst + ch * 8) = (u32x4){w0.x, w0.y, w1.x, w1.y};
    }
}
__device__ __forceinline__ void cvt_moe_run4(const Params& p, LAS unsigned char* wl, int L, int w, const int nw, const int total, const int lane) {
    if (w >= total) return;
    f32x4 va[16], vb[16];
    CvtRef ca = cvt_moe_ref(p, L, w, 0), cb = ca;
    cvt_ld4(ca, lane, va);
    for (;;) {
        const bool hb = w + nw < total;
        cb = cvt_moe_ref(p, L, hb ? w + nw : w, 0); cvt_ld4(cb, lane, vb);
        cvt_st4(ca, va, wl, lane);
        if (!hb) break;
        w += nw;
        const bool ha = w + nw < total;
        ca = cvt_moe_ref(p, L, ha ? w + nw : w, 0); cvt_ld4(ca, lane, va);
        cvt_st4(cb, vb, wl, lane);
        if (!ha) break;
        w += nw;
    }
}
__device__ __forceinline__ void phase_cvt_moe(const Params& p, LAS unsigned char* lds, int L, int total) {
    const int tid = tidx();
    cvt_moe_run(p, lds + (tid >> 6) * 9216, L, gwave(), nwave(), total, tid & 63);
}
__device__ __forceinline__ void phase_cvt_fox(const Params& p, LAS unsigned char* lds) {
    LAS float* tl = (LAS float*)lds;
    bf16_t* WinT = (bf16_t*)(p.ws + OFF_WA + WA_WINT); bf16_t* WoutT = (bf16_t*)(p.ws + OFF_WA + WA_WOUTT);
    const int t_in = 32 * 96, t_out = 32 * 32;
    for (int w = gwave(); w < t_in + t_out; w += nwave()) {
        if (w < t_in) cvt_matrix_tile(tl, p.a_w_in, 6160, DM, 6144, WinT, 0, w, 96);
        else cvt_matrix_tile(tl, p.a_w_out, DM, DM, DM, WoutT, 0, w - t_in, 32);
    }
    bf16_t* xb = (bf16_t*)(p.ws + OFF_XB);
    const size_t n8 = (size_t)NTOK * DM / 8, stride = (size_t)NBLK * NTHREADS;
    for (size_t i = (size_t)blockIdx.x * NTHREADS + tidx(); i < n8; i += 4 * stride) {
        f32x4 a[4], b[4];
#pragma unroll
        for (int u = 0; u < 4; ++u) { const size_t j = i + u * stride; if (j < n8) { a[u] = __builtin_nontemporal_load((const f32x4*)(p.x + j * 8)); b[u] = __builtin_nontemporal_load((const f32x4*)(p.x + j * 8 + 4)); } }
#pragma unroll
        for (int u = 0; u < 4; ++u) { const size_t j = i + u * stride; if (j < n8) *(bf16x8*)(xb + j * 8) = pack8(a[u], b[u]); }
    }
}
__device__ __forceinline__ void phase_cvt_dsa(const Params& p, LAS unsigned char* lds) {
    LAS float* tl = (LAS float*)lds;
    bf16_t* WbinT = (bf16_t*)(p.ws + OFF_WA + WA_WBINT); bf16_t* Wq2T = (bf16_t*)(p.ws + OFF_WA + WA_WQ2T); bf16_t* WoutTB = (bf16_t*)(p.ws + OFF_WA + WA_WOUTTB); bf16_t* WuvBD = (bf16_t*)(p.ws + OFF_WA + WA_WUVOT);
    const int t0 = 32 * 16, t1 = 8 * 16, t2 = 32 * 32, t3 = 16 * 8;
    for (int w = gwave(); w < t0 + t1 + t2 + t3; w += nwave()) {
        if (w < t0) cvt_matrix_tile(tl, p.b_w_in, BW, DM, BW, WbinT, 0, w, 16);
        else if (w < t0 + t1) cvt_matrix_tile(tl, p.b_w_iq, 1024, QLAT, 1024, Wq2T + (size_t)4096 * QLAT, 0, w - t0, 16);
        else if (w < t0 + t1 + t2) cvt_matrix_tile(tl, p.b_w_out, DM, DM, DM, WoutTB, 0, w - t0 - t1, 32);
        else { const int v = w - t0 - t1 - t2, h = v >> 3, kt = (v >> 1) & 3, nt_ = v & 1;
            cvt_wtile((LAS unsigned char*)tl, p.b_w_uv + (size_t)h * KVLAT * 128, 128, 128, WuvBD + (size_t)(h * 128) * 4096 + h * 256, 4096, kt * 64, nt_ * 64, nt_ * 64, tidx() & 63); }
    }
    for (int i = blockIdx.x * NTHREADS + tidx(); i < 2048 * 32; i += NBLK * NTHREADS) { const int n = i >> 5, ch = i & 31, h = n >> 7;
        *(u32x4*)(WuvBD + (size_t)n * 4096 + (h ^ 1) * 256 + ch * 8) = (u32x4){0u, 0u, 0u, 0u}; }
}
__device__ __forceinline__ bf16x8 ld8_f32(const float* p) { return pack8(*(const f32x4*)p, *(const f32x4*)(p + 4)); }
__device__ __forceinline__ void phase_wprep(const Params& p) {
    const int lane = tidx() & 63, fr = lane & 15, fq = lane >> 4;
    bf16_t* Wq2T = (bf16_t*)(p.ws + OFF_WA + WA_WQ2T);
    const int nq = 16 * 16 * 32;
    for (int w = gwave(); w < nq; w += nwave()) {
        f32x4 acc = (f32x4){0.f, 0.f, 0.f, 0.f};
        {
            const int h = w >> 9, ct = (w >> 5) & 15, lt = w & 31, c0 = ct * 16, l0 = lt * 16;
#pragma unroll
            for (int ks = 0; ks < 4; ++ks) {
                const bf16x8 a = ld8_f32(p.b_w_uq + (size_t)(l0 + fr) * 2048 + h * 128 + ks * 32 + fq * 8);
 bf16x8 b = ld8_f32(p.b_w_uk + ((size_t)h * 256 + c0 + fr) * 128 + ks * 32 + fq * 8);
                asm volatile("s_nop 7" : "+v"(b));
                acc = __builtin_amdgcn_mfma_f32_16x16x32_bf16(a, b, acc, 0, 0, 0);
            }
            mfma_fence(acc);
            u32x2 o; o.x = cvt_pk_bf16(acc[0], acc[1]); o.y = cvt_pk_bf16(acc[2], acc[3]);
            *(u32x2*)(Wq2T + (size_t)(h * 256 + c0 + fr) * QLAT + l0 + 4 * fq) = o;
        }
    }
}

__device__ __forceinline__ void phase_cvt_router(const Params& p) {
    bf16_t* rwt = (bf16_t*)(p.ws + OFF_ROUTE + RWT_BYTE_OFF);
    for (int i = blockIdx.x * NTHREADS + tidx(); i < 2 * DM * 16; i += NBLK * NTHREADS) {
        const int L = i >> 15, d = (i >> 4) & 2047, e4 = (i & 15) * 4;
        const f32x4 w = *(const f32x4*)(p.router_w + ((size_t)L * DM + d) * NEXP + e4);
#pragma unroll
        for (int k = 0; k < 4; ++k) { const unsigned h = cvt_pk_bf16(w[k], 0.f) & 0xffffu; const float lo = w[k] - __uint_as_float(h << 16);
            rwt[((size_t)L * 128 + e4 + k) * DM + d] = (bf16_t)h; rwt[((size_t)L * 128 + 64 + e4 + k) * DM + d] = (bf16_t)(cvt_pk_bf16(lo, 0.f) & 0xffffu); }
    }
}
__device__ __forceinline__ void phase_cvt_fgate(const Params& p) {
    bf16_t* fwt = (bf16_t*)(p.ws + OFF_ROUTE + FWT_BYTE_OFF);
    for (int i = blockIdx.x * NTHREADS + tidx(); i < DM * 16; i += NBLK * NTHREADS) {
        const int d = i >> 4, h = i & 15;
        const float w = p.a_w_in[(size_t)d * 6160 + 6144 + h];
        const unsigned hb = cvt_pk_bf16(w, 0.f) & 0xffffu; const float lo = w - __uint_as_float(hb << 16);
        fwt[(size_t)h * DM + d] = (bf16_t)hb; fwt[(size_t)(16 + h) * DM + d] = (bf16_t)(cvt_pk_bf16(lo, 0.f) & 0xffffu);
    }
}
__device__ __forceinline__ void phase_fgate(const Params& p) {
    const int tid = tidx(), wid = tid >> 6, lane = tid & 63, fr = lane & 15, fq = lane >> 4;
    float* logf = (float*)(p.ws + OFF_BIG + BG_LOGF); const bf16_t* fwt = (const bf16_t*)(p.ws + OFF_ROUTE + FWT_BYTE_OFF);
    if (wid >= 4) return;
    for (int g = blockIdx.x; g < NTOK / 64; g += NBLK) {
        const int tok0 = g * 64 + wid * 16;
        const float* xa = p.x + (size_t)(tok0 + fr) * DM + fq * 8;
        const bf16_t* bh = fwt + (size_t)fr * DM + fq * 8;
        f32x4 acc = (f32x4){0.f, 0.f, 0.f, 0.f};
#pragma unroll 4
        for (int ks = 0; ks < 64; ++ks) {
            const f32x4 x0 = *(const f32x4*)(xa + ks * 32), x1 = *(const f32x4*)(xa + ks * 32 + 4);
            u32x4 hw = {cvt_pk_bf16(x0[0], x0[1]), cvt_pk_bf16(x0[2], x0[3]), cvt_pk_bf16(x1[0], x1[1]), cvt_pk_bf16(x1[2], x1[3])};
            f32x4 r0, r1;
#pragma unroll
            for (int i = 0; i < 4; ++i) { r0[i] = x0[i] - __uint_as_float(i & 1 ? hw[i >> 1] & 0xffff0000u : hw[i >> 1] << 16); r1[i] = x1[i] - __uint_as_float(i & 1 ? hw[2 + (i >> 1)] & 0xffff0000u : hw[2 + (i >> 1)] << 16); }
            bf16x8 ah = *reinterpret_cast<bf16x8*>(&hw), al = pack8(r0, r1);
            asm volatile("s_nop 1" : "+v"(ah), "+v"(al));
            const bf16x8 wh = *(const bf16x8*)(bh + ks * 32), wl = *(const bf16x8*)(bh + (size_t)16 * DM + ks * 32);
            acc = __builtin_amdgcn_mfma_f32_16x16x32_bf16(ah, wh, acc, 0, 0, 0);
            acc = __builtin_amdgcn_mfma_f32_16x16x32_bf16(ah, wl, acc, 0, 0, 0);
            acc = __builtin_amdgcn_mfma_f32_16x16x32_bf16(al, wh, acc, 0, 0, 0);
        }
        const float bf = p.a_b_f[fr];
#pragma unroll
        for (int i = 0; i < 4; ++i) { const float z = acc[i] + bf; logf[(size_t)(tok0 + 4 * fq + i) * 16 + fr] = fminf(z, 0.f) - log1pf(expf(-fabsf(z))); }
    }
}
__device__ __forceinline__ void phase_scan(const Params& p, LAS unsigned char* lds) {
    const int tid = tidx(), lane = tid & 63, wid = tid >> 6;
    const float* logf = (const float*)(p.ws + OFF_BIG + BG_LOGF); float* G = (float*)(p.ws + OFF_BIG + BG_G);
    LAS float* wt = (LAS float*)lds;
    for (int bh = blockIdx.x; bh < NBATCH * NHEAD; bh += NBLK) {
        const int b = bh >> 4, h = bh & 15, s0 = tid * 8;
        float v[8]; float tot = 0.f;
#pragma unroll
        for (int j = 0; j < 8; ++j) { v[j] = logf[((size_t)b * SEQ + s0 + j) * 16 + h]; tot += v[j]; }
        float inc = tot;
#pragma unroll
        for (int o = 1; o < 64; o <<= 1) { const float y = __shfl_up(inc, o); if (lane >= o) inc += y; }
        __syncthreads();
        if (lane == 63) wt[wid] = inc;
        __syncthreads();
        float run = inc - tot;
#pragma unroll
        for (int k = 0; k < 8; ++k) run += k < wid ? wt[k] : 0.f;
        f32x4 o0, o1;
#pragma unroll
        for (int j = 0; j < 4; ++j) { run += v[j]; o0[j] = -run * 11.313708498984761f; }
#pragma unroll
        for (int j = 0; j < 4; ++j) { run += v[4 + j]; o1[j] = -run * 11.313708498984761f; }
        *(f32x4*)(G + (size_t)bh * SEQ + s0) = o0; *(f32x4*)(G + (size_t)bh * SEQ + s0 + 4) = o1;
    }
}
__device__ __forceinline__ int fox_jlo(const Params& p, int item, int pass) {
    const int bh = item >> 3, x = item & 7, qb = pass ? 15 - x : x;
    const float* G = (const float*)(p.ws + OFF_BIG + BG_G) + (size_t)bh * SEQ; const float* NRM = (const float*)(p.ws + OFF_BIG + BG_NRM);
    const int J = tidx() & 63;
    const float* nq = NRM + (size_t)bh * 128, * nk = NRM + (size_t)(64 + bh) * 128;
    float q2 = 0.f, k2 = 0.f;
#pragma unroll
    for (int i = 0; i < 4; ++i) { q2 = fmaxf(q2, nq[(4 * qb + i) * 2] + nq[(4 * qb + i) * 2 + 1]); k2 = fmaxf(k2, nk[(4 * qb + i) * 2] + nk[(4 * qb + i) * 2 + 1]); }
    const float qn = sqrtf(q2), kI = sqrtf(k2), kn = sqrtf(nk[J * 2] + nk[J * 2 + 1]);
    const float Ft0 = -G[qb * 256] * fox::SCALE, Fl = -G[64 * J + 63] * fox::SCALE;
    const float ub = fox::SCALE * qn * (kn + kI) * 1.01f + (Ft0 - Fl);
    const bool skip = (ub < -50.0f) && (64 * J + 63 < qb * 256);
    const unsigned long long keep = __ballot(!skip);
    return keep ? (int)__builtin_ctzll(keep) : 0;
}
__device__ __forceinline__ fox::BlockRef fox_ref(const Params& p, int item, int pass, int jlo) {
    const int bh = item >> 3, x = item & 7, b = bh >> 4, h = bh & 15, qb = pass ? 15 - x : x;
    const bf16_t* Q = (const bf16_t*)(p.ws + OFF_BIG + BG_Q); const bf16_t* K = (const bf16_t*)(p.ws + OFF_BIG + BG_K); const bf16_t* V = (const bf16_t*)(p.ws + OFF_BIG + BG_V);
    bf16_t* O = (bf16_t*)(p.ws + OFF_BIG + BG_O); const float* G = (const float*)(p.ws + OFF_BIG + BG_G);
    fox::BlockRef r;
    const size_t hb = (size_t)b * SEQ * DM + (size_t)h * HDIM;
    r.Q = Q + hb + (size_t)qb * 256 * DM; r.O = O + hb + (size_t)qb * 256 * DM; r.K = K + hb; r.V = V + hb; r.G = G + (size_t)bh * SEQ; r.P0 = qb * 256; r.jlo = jlo;
    return r;
}
__device__ __forceinline__ void phase_fox_attn(const Params& p, LAS unsigned char* lds_) {
    char* lds = (char*)lds_;
    const int total = NBATCH * NHEAD * 8, stride = NBLK;
    int L = blockIdx.x; if (L >= total) return;
    LAS int* jl = (LAS int*)(lds_ + fox::LDS_BYTES);
    { int slot = 0;
      for (int it = L; it < total && slot < 16; it += stride, slot += 2) { const int j0 = fox_jlo(p, it, 0), j1 = fox_jlo(p, it, 1); if (tidx() == 0) { jl[slot] = j0; jl[slot + 1] = j1; } }
      __syncthreads(); }
    int pass = 0, slot = 0;
    fox::BlockRef cur = fox_ref(p, L, 0, __builtin_amdgcn_readfirstlane(jl[0]));
    fox::Seam S;
    fox::fox_prime(cur, lds, S);
    for (;;) {
        const bool more_pass = pass == 0, more_item = L + stride < total, last = !more_pass && !more_item;
        int passn = pass + 1, Ln = L;
        if (!more_pass) { passn = 0; Ln = more_item ? L + stride : L; }
        const int slotn = last ? slot : slot + 1;
        const fox::BlockRef nxt = last ? cur : fox_ref(p, Ln, passn, __builtin_amdgcn_readfirstlane(jl[slotn & 15]));
        fox::fox_block(cur, nxt, lds, S);
        if (last) break;
        cur = nxt; pass = passn; L = Ln; slot = slotn;
    }
}

__device__ __forceinline__ void ln_row_store(float (&v)[32], const float* g, const float* bt, float* yf, bf16_t* yhi, bf16_t* ylo, int lane) {
    float s = 0.f;
#pragma unroll
    for (int i = 0; i < 32; ++i) s += v[i];
    const float mean = wave_sum(s) * (1.0f / DM);
    float q = 0.f;
#pragma unroll
    for (int i = 0; i < 32; ++i) { const float d = v[i] - mean; q += d * d; }
    const float var = wave_sum(q) * (1.0f / DM);
    const float rstd = 1.0f / sqrtf(var + LN_EPS);
#pragma unroll
    for (int j = 0; j < 4; ++j) {
        const int c = j * 512 + lane * 8;
        const f32x4 g0 = *(const f32x4*)(g + c), g1 = *(const f32x4*)(g + c + 4), b0 = *(const f32x4*)(bt + c), b1 = *(const f32x4*)(bt + c + 4);
        f32x4 y0, y1;
#pragma unroll
        for (int i = 0; i < 4; ++i) { y0[i] = (v[j * 8 + i] - mean) * rstd * g0[i] + b0[i]; y1[i] = (v[j * 8 + 4 + i] - mean) * rstd * g1[i] + b1[i]; }
        if (yf) { *(f32x4*)(yf + c) = y0; *(f32x4*)(yf + c + 4) = y1; }
        else {
            const u32x4 hw = {cvt_pk_bf16(y0[0], y0[1]), cvt_pk_bf16(y0[2], y0[3]), cvt_pk_bf16(y1[0], y1[1]), cvt_pk_bf16(y1[2], y1[3])};
            f32x4 r0, r1;
#pragma unroll
            for (int i = 0; i < 4; ++i) { r0[i] = y0[i] - __uint_as_float(i & 1 ? hw[i >> 1] & 0xffff0000u : hw[i >> 1] << 16); r1[i] = y1[i] - __uint_as_float(i & 1 ? hw[2 + (i >> 1)] & 0xffff0000u : hw[2 + (i >> 1)] << 16); }
            *(u32x4*)(yhi + c) = hw; *(bf16x8*)(ylo + c) = pack8(r0, r1);
        }
    }
}
__device__ __forceinline__ void ld_hilo8(const bf16_t* hi, const bf16_t* lo, float (&o)[8]) {
    const u32x4 h = *(const u32x4*)hi, l = *(const u32x4*)lo;
#pragma unroll
    for (int i = 0; i < 4; ++i) { o[2 * i] = __uint_as_float(h[i] << 16) + __uint_as_float(l[i] << 16); o[2 * i + 1] = __uint_as_float(h[i] & 0xffff0000u) + __uint_as_float(l[i] & 0xffff0000u); }
}
struct RawRow { u32x4 a[8]; u32x4 m[4]; };
__device__ __forceinline__ void router_ln_load(RawRow& r, int t, const bf16_t* xhi, const bf16_t* xlo, const float* xin, const bf16_t* mres, int lane) {
#pragma unroll
    for (int j = 0; j < 4; ++j) {
        const size_t o = (size_t)t * DM + j * 512 + lane * 8;
        if (xin) { r.a[2 * j] = *(const u32x4*)(xin + o); r.a[2 * j + 1] = *(const u32x4*)(xin + o + 4); }
        else { r.a[2 * j] = *(const u32x4*)(xhi + o); r.a[2 * j + 1] = *(const u32x4*)(xlo + o); }
        r.m[j] = *(const u32x4*)(mres + o);
    }
}
__device__ __forceinline__ void router_ln_finish(const RawRow& r, int t, bf16_t* xhi, bf16_t* xlo, bool f32in, const float* lng, const float* lnb, int lane) {
    float v[32];
#pragma unroll
    for (int j = 0; j < 4; ++j) {
        float a[8];
        if (f32in) {
#pragma unroll
            for (int i = 0; i < 4; ++i) { a[i] = __uint_as_float(r.a[2 * j][i]); a[4 + i] = __uint_as_float(r.a[2 * j + 1][i]); }
        } else {
            const u32x4 h = r.a[2 * j], l = r.a[2 * j + 1];
#pragma unroll
            for (int i = 0; i < 4; ++i) { a[2 * i] = __uint_as_float(h[i] << 16) + __uint_as_float(l[i] << 16); a[2 * i + 1] = __uint_as_float(h[i] & 0xffff0000u) + __uint_as_float(l[i] & 0xffff0000u); }
        }
        const u32x4 mw = r.m[j];
#pragma unroll
        for (int i = 0; i < 8; ++i) v[j * 8 + i] = ALPHA * a[i] + __uint_as_float(i & 1 ? mw[i >> 1] & 0xffff0000u : mw[i >> 1] << 16);
    }
    ln_row_store(v, lng, lnb, nullptr, xhi + (size_t)t * DM, xlo + (size_t)t * DM, lane);
}
#ifndef ROUTER_SGT
#define ROUTER_SGT 32
#endif
__device__ __forceinline__ void phase_router(const Params& p, LAS unsigned char* lds, bf16_t* xhi, bf16_t* xlo, const bf16_t* rwt, const float* rb,
                                             const float* xin, const bf16_t* mres, const float* lng, const float* lnb) {
    constexpr int SGT = ROUTER_SGT, MT = SGT / 16, RPW = SGT / 4, NLN = 64 / SGT, SPW = SGT / 4;
    LAS float* lgp = (LAS float*)lds;
    LAS float* sbl = lgp + 4 * SGT * 64;
    LAS unsigned char* flag = (LAS unsigned char*)(sbl + 4096);
    LAS int* sel_l = (LAS int*)(flag + 4096);
    LAS unsigned long long* Me = (LAS unsigned long long*)(sel_l + 512);
    unsigned* ctrl = (unsigned*)(p.ws + OFF_CTRL); int* rt = (int*)(p.ws + OFF_ROUTE);
    const int tid = tidx(), lane = tid & 63, wid = __builtin_amdgcn_readfirstlane(tid >> 6);
    const bool f32in = xin != nullptr;
    for (int g = blockIdx.x; g < NTOK / 64; g += NBLK) {
        const int tok0 = g * 64;
        __syncthreads();
        RawRow ra, rb_;
        if (wid < 4) router_ln_load(ra, tok0 + RPW * wid, xhi, xlo, xin, mres, lane);
#pragma unroll 1
        for (int st = 0; st <= NLN; ++st) {
            const int sg = st - 1;
            const int t0 = tok0 + SGT * st + RPW * wid;
            if (wid < 4) {
                if (st < NLN) {
#pragma unroll
                    for (int i = 0; i < RPW / 2; ++i) {
                        if (i & 1) { router_ln_load(ra, t0 + i + 1, xhi, xlo, xin, mres, lane); router_ln_finish(rb_, t0 + i, xhi, xlo, f32in, lng, lnb, lane); }
                        else { router_ln_load(rb_, t0 + i + 1, xhi, xlo, xin, mres, lane); router_ln_finish(ra, t0 + i, xhi, xlo, f32in, lng, lnb, lane); }
                    }
                }
            } else if (st >= 1) {
                const int fr = lane & 15, fq = lane >> 4, kq = wid - 4;
                f32x4 acc[MT][4];
#pragma unroll
                for (int mt = 0; mt < MT; ++mt)
#pragma unroll
                    for (int nt = 0; nt < 4; ++nt) acc[mt][nt] = (f32x4){0.f, 0.f, 0.f, 0.f};
                const bf16_t* xah = xhi + (size_t)(tok0 + SGT * sg + fr) * DM + kq * 512 + fq * 8; const bf16_t* xal = xlo + (size_t)(tok0 + SGT * sg + fr) * DM + kq * 512 + fq * 8;
                const bf16_t* bh = rwt + (size_t)fr * DM + kq * 512 + fq * 8;
#pragma unroll 2
                for (int ks = 0; ks < 16; ++ks) {
                    bf16x8 ah[MT], al[MT];
#pragma unroll
                    for (int mt = 0; mt < MT; ++mt) { ah[mt] = *(const bf16x8*)(xah + (size_t)(16 * mt) * DM + ks * 32); al[mt] = *(const bf16x8*)(xal + (size_t)(16 * mt) * DM + ks * 32); }
#pragma unroll
                    for (int nt = 0; nt < 4; ++nt) {
                        const bf16x8 wh = *(const bf16x8*)(bh + (size_t)(16 * nt) * DM + ks * 32), wl = *(const bf16x8*)(bh + (size_t)(64 + 16 * nt) * DM + ks * 32);
#pragma unroll
                        for (int mt = 0; mt < MT; ++mt) {
                            acc[mt][nt] = __builtin_amdgcn_mfma_f32_16x16x32_bf16(ah[mt], wh, acc[mt][nt], 0, 0, 0);
                            acc[mt][nt] = __builtin_amdgcn_mfma_f32_16x16x32_bf16(ah[mt], wl, acc[mt][nt], 0, 0, 0);
                            acc[mt][nt] = __builtin_amdgcn_mfma_f32_16x16x32_bf16(al[mt], wh, acc[mt][nt], 0, 0, 0);
                        }
                    }
                }
#pragma unroll
                for (int mt = 0; mt < MT; ++mt)
#pragma unroll
                    for (int nt = 0; nt < 4; ++nt)
#pragma unroll
                        for (int i = 0; i < 4; ++i) lgp[(kq * SGT + 16 * mt + 4 * fq + i) * 64 + 16 * nt + fr] = acc[mt][nt][i];
            }
            __syncthreads();
            if (wid < 4) {
                if (st < NLN) {
#pragma unroll
                    for (int i = RPW / 2; i < RPW; ++i) {
                        const int tn = i + 1 < RPW ? t0 + i + 1 : (st + 1 < NLN ? t0 + SGT : t0 + i);
                        if (i & 1) { router_ln_load(ra, tn, xhi, xlo, xin, mres, lane); router_ln_finish(rb_, t0 + i, xhi, xlo, f32in, lng, lnb, lane); }
                        else { router_ln_load(rb_, tn, xhi, xlo, xin, mres, lane); router_ln_finish(ra, t0 + i, xhi, xlo, f32in, lng, lnb, lane); }
                    }
                }
                asm volatile("s_waitcnt vmcnt(0)" ::: "memory");
            } else if (st >= 1) {
                const float bias = rb[lane];
                for (int q = 0; q < SPW; ++q) {
                    const int il = SPW * (wid - 4) + q, i = SGT * sg + il, t = tok0 + i;
                    const float z = (lgp[il * 64 + lane] + lgp[(SGT + il) * 64 + lane]) + (lgp[(2 * SGT + il) * 64 + lane] + lgp[(3 * SGT + il) * 64 + lane]);
                    const float score = 1.0f / (1.0f + expf(-z));
                    const float sb = score + bias;
                    sbl[i * 64 + lane] = sb;
                    int rank = 0;
#pragma unroll
                    for (int m4 = 0; m4 < 16; ++m4) { const f32x4 o = *(LAS f32x4*)(sbl + i * 64 + 4 * m4);
                        rank += (int)(o[0] > sb); rank += (int)(o[1] > sb); rank += (int)(o[2] > sb); rank += (int)(o[3] > sb); }
                    bool taken = rank < 8;
                    bool ok = __builtin_popcountll(__ballot(taken)) == 8;
#pragma unroll
                    for (int r = 0; r < 8; ++r) ok = ok && (__builtin_popcountll(__ballot(rank == r)) == 1);
                    float gsum = 0.f;
                    if (ok) {
                        const float gmine = taken ? score : 0.f;
                        gsum = wave_sum(gmine);
                        if (taken) { rt[RT_SEL + (size_t)t * 8 + rank] = lane; ((float*)rt)[RT_GATE + (size_t)t * 8 + rank] = score / gsum * ROUTED_SCALE; sel_l[i * 8 + rank] = lane; }
                    } else {
                        taken = false; int myidx = 0; float mygate = 0.f;
#pragma unroll 1
                        for (int r = 0; r < 8; ++r) {
                            float v = taken ? -__builtin_inff() : sb; int idx = lane;
#pragma unroll
                            for (int o = 32; o >= 1; o >>= 1) { const float ov = __shfl_xor(v, o); const int oi = __shfl_xor(idx, o); if (ov > v || (ov == v && oi < idx)) { v = ov; idx = oi; } }
                            const float gs = __shfl(score, idx);
                            if (lane == idx) taken = true;
                            if (lane == r) { myidx = idx; mygate = gs; }
                            gsum += gs;
                        }
                        if (lane < 8) { rt[RT_SEL + (size_t)t * 8 + lane] = myidx; ((float*)rt)[RT_GATE + (size_t)t * 8 + lane] = mygate / gsum * ROUTED_SCALE; sel_l[i * 8 + lane] = myidx; }
                    }
                    flag[i * 64 + lane] = taken ? 1 : 0;
                }
            }
            __syncthreads();
        }
        if (tid < 64) { unsigned long long M = 0ull;
            for (int i = 0; i < 64; ++i) M |= (unsigned long long)flag[i * 64 + tid] << i;
            Me[tid] = M; ctrl[CW_HIST + g * 64 + tid] = (unsigned)__builtin_popcountll(M); }
        __syncthreads();
        { const int i = tid >> 3, r = tid & 7, e = sel_l[i * 8 + r];
          const unsigned long long M = Me[e], below = (i == 0) ? 0ull : (M & ((1ull << i) - 1ull));
          rt[RT_RANK + (size_t)(tok0 + i) * 8 + r] = __builtin_popcountll(below); }
        __syncthreads();
    }
}
__device__ __forceinline__ void phase_route_pos(const Params& p, LAS unsigned char* lds) {
    LAS int* base_l = (LAS int*)lds; LAS int* cnt_l = base_l + 64; LAS int* rs_l = cnt_l + 64; LAS int* ts_l = rs_l + 64; LAS int* ntr_l = ts_l + 64; LAS int* part_l = ntr_l + 64;
    unsigned* ctrl = (unsigned*)(p.ws + OFF_CTRL); int* rt = (int*)(p.ws + OFF_ROUTE);
    const int tid = tidx(), lane = tid & 63;
    for (int g = blockIdx.x; g < NTOK / 64; g += NBLK) {
        __syncthreads();
        { const int e = tid & 63, pt = tid >> 6; int base = 0, tot = 0;
#pragma unroll 8
          for (int k = 0; k < 32; ++k) { const int gg = pt * 32 + k; const int hv = (int)ctrl[CW_HIST + gg * 64 + e]; tot += hv; base += gg < g ? hv : 0; }
          part_l[(pt * 64 + e) * 2] = base; part_l[(pt * 64 + e) * 2 + 1] = tot; }
        __syncthreads();
        if (tid < 64) { int base = 0, tot = 0;
#pragma unroll
            for (int k = 0; k < 8; ++k) { base += part_l[(k * 64 + tid) * 2]; tot += part_l[(k * 64 + tid) * 2 + 1]; }
            base_l[tid] = base; cnt_l[tid] = tot;
            const int ntl = (tot + 255) >> 8; int inc = ntl;
#pragma unroll
            for (int o = 1; o < 64; o <<= 1) { const int y = __shfl_up(inc, o); if (lane >= o) inc += y; }
            ts_l[tid] = inc - ntl; rs_l[tid] = (inc - ntl) * 256; if (tid == 63) ntr_l[0] = inc; }
        __syncthreads();
        { const int i = tid >> 3, r = tid & 7, t = g * 64 + i;
          const int e = rt[RT_SEL + (size_t)t * 8 + r], rank = rt[RT_RANK + (size_t)t * 8 + r];
          const int pos = rs_l[e] + base_l[e] + rank;
          rt[RT_POS + (size_t)t * 8 + r] = pos; rt[RT_ROWTOK + pos] = t; }
        if (tid < 64) rt[RT_ROWTOK + SH_TILE0 * 256 + g * 64 + tid] = g * 64 + tid;
        if (g < 64) { const int e = g, c = cnt_l[e], ntl = (c + 255) >> 8, padn = ntl * 256 - c, ts = ts_l[e], ntr = ntr_l[0];
            if (tid < padn) rt[RT_ROWTOK + rs_l[e] + c + tid] = 0;
            for (int k = tid; k < ntl; k += NTHREADS) { ctrl[CW_TILE_E + ts + k] = (unsigned)e; ctrl[CW_TILE_RT + ts + k] = (unsigned)(ts + k); }
            if (tid == 0) { ctrl[CW_TILE_E + ntr + g] = 64u; ctrl[CW_TILE_RT + ntr + g] = (unsigned)(SH_TILE0 + g); if (g == 0) ctrl[CW_NTILES] = (unsigned)(ntr + 64); } }
    }
}
template <bool FP8>
__device__ __forceinline__ void phase_combine_ln2(const Params& p, bf16_t* xhi, bf16_t* xlo, const float* g, const float* bt, float* yf) {
    const int lane = tidx() & 63;
    const bf16_t* Ys = (const bf16_t*)(p.ws + OFF_BIG + BG_YS); const int* rt = (const int*)(p.ws + OFF_ROUTE);
    for (int t = gwave(); t < NTOK; t += nwave()) {
        float v[32];
#pragma unroll
        for (int i = 0; i < 32; ++i) v[i] = 0.f;
        constexpr int RG = FP8 ? 5 : 3;
#pragma unroll 1
        for (int r3 = 0; r3 < (9 + RG - 1) / RG; ++r3) {
            u32x4 w[FP8 ? 1 : RG][4]; u32x2 w8[FP8 ? RG : 1][4]; float gt[RG];
#pragma unroll
            for (int q = 0; q < RG; ++q) {
                const int r = r3 * RG + q, rr = r < 8 ? r : 0;
                int pos = rt[RT_POS + (size_t)t * 8 + rr]; gt[q] = ((const float*)rt)[RT_GATE + (size_t)t * 8 + rr];
                if (r == 8) { pos = SH_TILE0 * 256 + t; gt[q] = 1.0f; }
                if (r > 8) gt[q] = 0.f;
                if constexpr (FP8) { const unsigned char* row = (const unsigned char*)Ys + (size_t)pos * DM; gt[q] *= (1.0f / 64.0f);
#pragma unroll
                    for (int j = 0; j < 4; ++j) w8[q][j] = *(const u32x2*)(row + j * 512 + lane * 8); }
                else { const bf16_t* row = Ys + (size_t)pos * DM;
#pragma unroll
                    for (int j = 0; j < 4; ++j) w[q][j] = *(const u32x4*)(row + j * 512 + lane * 8); }
            }
#pragma unroll
            for (int q = 0; q < RG; ++q)
#pragma unroll
                for (int j = 0; j < 4; ++j) {
                    if constexpr (FP8) {
                        const auto f0 = __builtin_amdgcn_cvt_pk_f32_fp8((int)w8[q][j].x, false), f1 = __builtin_amdgcn_cvt_pk_f32_fp8((int)w8[q][j].x, true), f2 = __builtin_amdgcn_cvt_pk_f32_fp8((int)w8[q][j].y, false), f3 = __builtin_amdgcn_cvt_pk_f32_fp8((int)w8[q][j].y, true);
                        v[j * 8 + 0] += gt[q] * f0[0]; v[j * 8 + 1] += gt[q] * f0[1]; v[j * 8 + 2] += gt[q] * f1[0]; v[j * 8 + 3] += gt[q] * f1[1];
                        v[j * 8 + 4] += gt[q] * f2[0]; v[j * 8 + 5] += gt[q] * f2[1]; v[j * 8 + 6] += gt[q] * f3[0]; v[j * 8 + 7] += gt[q] * f3[1];
                    } else {
#pragma unroll
                        for (int i = 0; i < 4; ++i) { v[j * 8 + 2 * i] += gt[q] * __uint_as_float(w[q][j][i] << 16); v[j * 8 + 2 * i + 1] += gt[q] * __uint_as_float(w[q][j][i] & 0xffff0000u); } } }
        }
#pragma unroll
        for (int j = 0; j < 4; ++j) { const size_t o = (size_t)t * DM + j * 512 + lane * 8;
            float a[8]; ld_hilo8(xhi + o, xlo + o, a);
#pragma unroll
            for (int i = 0; i < 8; ++i) v[j * 8 + i] += ALPHA * a[i]; }
        ln_row_store(v, g, bt, yf ? yf + (size_t)t * DM : nullptr, xhi + (size_t)t * DM, xlo + (size_t)t * DM, lane);
    }
}
__device__ __forceinline__ void phase_dsa_prep(const Params& p) {
    const int lane = tidx() & 63;
    const float* proj = (const float*)(p.ws + OFF_BIG + BG_PROJ);
    bf16_t* cq = (bf16_t*)(p.ws + OFF_BIG + BG_CQ); bf16_t* ckv = (bf16_t*)(p.ws + OFF_BIG + BG_CKV); bf16_t* kidx = (bf16_t*)(p.ws + OFF_BIG + BG_KIDX); float* widx = (float*)(p.ws + OFF_BIG + BG_WIDX);
    for (int t = gwave(); t < NTOK; t += nwave()) {
        const float* row = proj + (size_t)t * 1024;
        const f32x4 a0 = *(const f32x4*)(row + lane * 8), a1 = *(const f32x4*)(row + lane * 8 + 4);
        float s = 0.f;
#pragma unroll
        for (int i = 0; i < 4; ++i) s += a0[i] * a0[i] + a1[i] * a1[i];
        const float rq = 1.0f / sqrtf(wave_sum(s) * (1.0f / QLAT) + RMS_EPS);
        const f32x4 g0 = *(const f32x4*)(p.b_q_norm + lane * 8), g1 = *(const f32x4*)(p.b_q_norm + lane * 8 + 4);
        *(bf16x8*)(cq + (size_t)t * QLAT + lane * 8) = pack8(a0 * rq * g0, a1 * rq * g1);
        const f32x4 c0 = *(const f32x4*)(row + 512 + lane * 4);
        float s2 = 0.f;
#pragma unroll
        for (int i = 0; i < 4; ++i) s2 += c0[i] * c0[i];
        const float rk = 1.0f / sqrtf(wave_sum(s2) * (1.0f / KVLAT) + RMS_EPS);
        const f32x4 gk = *(const f32x4*)(p.b_kv_norm + lane * 4);
        const f32x4 ck = c0 * rk * gk;
        u32x2 o; o.x = cvt_pk_bf16(ck[0], ck[1]); o.y = cvt_pk_bf16(ck[2], ck[3]);
        *(u32x2*)(ckv + (size_t)t * KVLAT + lane * 4) = o;
        const float kv = row[768 + lane], kn = __shfl_down(kv, 1);
        if ((lane & 1) == 0) *(unsigned*)(kidx + (size_t)t * IDXD + lane) = cvt_pk_bf16(kv, kn);
        if (lane < 16) widx[(size_t)t * 16 + lane] = row[832 + lane] * 0.25f;
    }
}

__device__ __forceinline__ unsigned f2sortable(float v) { const unsigned b = __float_as_uint(v); return b ^ ((b >> 31) ? 0xffffffffu : 0x80000000u); }
__device__ __forceinline__ void phase_indexer(const Params& p, LAS unsigned char* lds) {
    const int tid = tidx(), wid = __builtin_amdgcn_readfirstlane(tid >> 6), lane = tid & 63, fr = lane & 15, fq = lane >> 4;
    const bf16_t* qidx = (const bf16_t*)(p.ws + OFF_BIG + BG_QIDX); const bf16_t* kidx = (const bf16_t*)(p.ws + OFF_BIG + BG_KIDX); const float* widx = (const float*)(p.ws + OFF_BIG + BG_WIDX);
    int* sel = (int*)(p.ws + OFF_BIG + BG_SEL); int* nsel = (int*)(p.ws + OFF_BIG + BG_NSEL);
    const int skey = tid >> 3, sc = tid & 7;
    const int swr = skey * 128 + ((sc ^ ((skey >> 1) & 7)) << 4);
    const int k32 = lane & 31, hi = lane >> 5;
    LAS unsigned char* rdb[4];
#pragma unroll
    for (int ks = 0; ks < 4; ++ks) rdb[ks] = lds + k32 * 128 + ((((2 * ks + hi)) ^ ((k32 >> 1) & 7)) << 4);
    for (int pr = blockIdx.x; pr < 256; pr += NBLK)
    for (int tk = 0; tk < 8; ++tk) {
        const int b = tk >> 1, pg = (tk & 1) ? 511 - pr : pr;
        const int pos = pg * 8 + wid, t = b * SEQ + pos, nchunks = (pg >> 3) + 1, kmax = nchunks * 64;
        int* selp = sel + (size_t)t * IDXTOPK;
        if (kmax <= IDXTOPK) {
#pragma unroll
            for (int k = 0; k < 4; ++k) if (lane + 64 * k < kmax) selp[lane + 64 * k] = lane + 64 * k;
            if (lane == 0) nsel[t] = kmax;
            continue;
        }
        bf16x8 qa[4];
#pragma unroll
        for (int ks = 0; ks < 4; ++ks) { qa[ks] = (bf16x8){0, 0, 0, 0, 0, 0, 0, 0}; if (k32 < 16) qa[ks] = *(const bf16x8*)(qidx + (size_t)t * 1024 + k32 * 64 + ks * 16 + hi * 8); }
        const f32x4 wA = *(const f32x4*)(widx + (size_t)t * 16 + 4 * hi), wB = *(const f32x4*)(widx + (size_t)t * 16 + 8 + 4 * hi);
        unsigned u[64];
        const bf16_t* kg = kidx + ((size_t)b * SEQ + skey) * IDXD + sc * 8;
        const int nsc = (nchunks + 3) >> 2;
        bf16x8 stg[4];
#pragma unroll
        for (int q = 0; q < 4; ++q) stg[q] = *(const bf16x8*)(kg + (size_t)q * 64 * IDXD);
        __syncthreads();
#pragma unroll
        for (int q = 0; q < 4; ++q) *(LAS bf16x8*)(lds + q * 8192 + swr) = stg[q];
        __syncthreads();
#pragma unroll
        for (int sc4 = 0; sc4 < 16; ++sc4) {
            if (sc4 < nsc) {
                if (sc4 + 1 < nsc) {
#pragma unroll
                    for (int q = 0; q < 4; ++q) stg[q] = *(const bf16x8*)(kg + (size_t)(4 * (sc4 + 1) + q) * 64 * IDXD);
                }
#pragma unroll
                for (int q = 0; q < 4; ++q) {
                    const int j = 4 * sc4 + q;
                    if (j < nchunks) {
                        float part[2];
#pragma unroll
                        for (int T2 = 0; T2 < 2; ++T2) {
                            f32x16 acc = {};
#pragma unroll
                            for (int ks = 0; ks < 4; ++ks) {
                                const bf16x8 kf = *(const LAS bf16x8*)(rdb[ks] + (sc4 & 1) * 32768 + q * 8192 + T2 * 4096);
                                acc = __builtin_amdgcn_mfma_f32_32x32x16_bf16(qa[ks], kf, acc, 0, 0, 0);
                            }
                            float pt = 0.f;
#pragma unroll
                            for (int r = 0; r < 4; ++r) { pt = fmaf(wA[r], __int_as_float(max(__float_as_int(acc[r]), 0)), pt); pt = fmaf(wB[r], __int_as_float(max(__float_as_int(acc[4 + r]), 0)), pt); }
                            part[T2] = pt;
                        }
                        const auto xs = __builtin_amdgcn_permlane32_swap(__float_as_uint(part[0]), __float_as_uint(part[1]), false, false);
                        const float val = hi ? part[1] + __uint_as_float(xs[0]) : part[0] + __uint_as_float(xs[1]);
                        u[j] = f2sortable(val);
                    } else u[j] = 0u;
                }
                if (sc4 + 1 < nsc) {
#pragma unroll
                    for (int q = 0; q < 4; ++q) *(LAS bf16x8*)(lds + ((sc4 + 1) & 1) * 32768 + q * 8192 + swr) = stg[q];
                    __syncthreads();
                }
            } else {
#pragma unroll
                for (int q = 0; q < 4; ++q) u[4 * sc4 + q] = 0u;
            }
        }
        unsigned thr = 0u; int c_gt = 0; bool exact = false;
        for (int bit = 31; bit >= 0; --bit) {
            const unsigned cand = thr | (1u << bit);
            int cnt = 0;
#pragma unroll
            for (int j = 0; j < 64; j += 8) {
                if (j < nchunks) {
                const unsigned long long m0 = __ballot(u[j] >= cand), m1 = __ballot(u[j + 1] >= cand), m2 = __ballot(u[j + 2] >= cand), m3 = __ballot(u[j + 3] >= cand),
                                         m4 = __ballot(u[j + 4] >= cand), m5 = __ballot(u[j + 5] >= cand), m6 = __ballot(u[j + 6] >= cand), m7 = __ballot(u[j + 7] >= cand);
                cnt += ((__builtin_popcountll(m0) + __builtin_popcountll(m1)) + (__builtin_popcountll(m2) + __builtin_popcountll(m3))) +
                       ((__builtin_popcountll(m4) + __builtin_popcountll(m5)) + (__builtin_popcountll(m6) + __builtin_popcountll(m7)));
                }
            }
            if (cnt >= IDXTOPK) thr = cand; else c_gt = cnt;
            if (cnt == IDXTOPK) { exact = true; break; }
        }
        const unsigned t_gt = exact ? thr - 1u : thr;
        const int eq_base = exact ? IDXTOPK : c_gt, quota = IDXTOPK - eq_base;
        LAS int* ssel = (LAS int*)(lds + 65536 + wid * 1024);
        int rg = 0, re = 0;
#pragma unroll
        for (int j = 0; j < 64; ++j) {
            if (j < nchunks) {
            const bool sg = u[j] > t_gt, se = u[j] == thr && !exact;
            const unsigned long long mg = __ballot(sg), me = __ballot(se);
            const int pg_ = rg + __builtin_amdgcn_mbcnt_hi((unsigned)(mg >> 32), __builtin_amdgcn_mbcnt_lo((unsigned)mg, 0u));
            const int pe_ = re + __builtin_amdgcn_mbcnt_hi((unsigned)(me >> 32), __builtin_amdgcn_mbcnt_lo((unsigned)me, 0u));
            const int key = 64 * j + 32 * hi + k32;
            if (sg) ssel[pg_] = key;
            if (se && pe_ < quota) ssel[eq_base + pe_] = key;
            rg += __builtin_popcountll(mg); re += __builtin_popcountll(me);
            }
        }
        *(u32x4*)(selp + 4 * lane) = *(LAS u32x4*)(ssel + 4 * lane);
        if (lane == 0) nsel[t] = IDXTOPK;
    }
}

__device__ __forceinline__ int t5_bucket_dev(int rel) {
    const int n = rel < 0 ? -rel : rel;
    int large = 2 + (31 - __builtin_clz((unsigned)(n * n) | 1u)); large = large > 15 ? 15 : large;
    return (rel > 0 ? 16 : 0) + (n < 8 ? n : large);
}
__device__ __forceinline__ int cg_off(int r, int c) { return r * 512 + ((c ^ ((r & 7) << 1)) << 4); }
__device__ __forceinline__ void phase_sparse_attn(const Params& p, LAS unsigned char* lds) {
    const int tid = tidx(), wid = __builtin_amdgcn_readfirstlane(tid >> 6), lane = tid & 63, fr = lane & 15, fq = lane >> 4;
    LAS unsigned char* cgl = lds + wid * 16384;
    LAS float* rbl = (LAS float*)(lds + 131072);
    LAS int* qctr = (LAS int*)(lds + 133120 + 8 * 1280);
    if (tid == 0) *qctr = 0;
    if (tid < 512) rbl[tid] = p.rel_bias[tid] * 1.4426950408889634f;
    __syncthreads();
    if (wid >= NWAVES - SPA_CW) { cvt_moe_run4(p, cgl, 1, CVT1_SPLIT + blockIdx.x * SPA_CW + (wid - (NWAVES - SPA_CW)), NBLK * SPA_CW, 65 * 768 - CVT0_GU, lane); }
    else {
    const bf16_t* qlat = (const bf16_t*)(p.ws + OFF_BIG + BG_QLAT); const bf16_t* ckv = (const bf16_t*)(p.ws + OFF_BIG + BG_CKV);
    const int* sel = (const int*)(p.ws + OFF_BIG + BG_SEL); const int* nsel = (const int*)(p.ws + OFF_BIG + BG_NSEL);
    bf16_t* olat = (bf16_t*)(p.ws + OFF_BIG + BG_OLAT);
    const int hr = lane >> 5, hc = lane & 31;
    const int q4 = fr >> 2, p4 = fr & 3;
    const int trbase = (int)(uintptr_t)cgl;
    LAS unsigned char* qkb[4]; int trb[8];
#pragma unroll
    for (int jj = 0; jj < 4; ++jj) qkb[jj] = cgl + cg_off(fr, 4 * jj + fq);
#pragma unroll
    for (int m = 0; m < 8; ++m) trb[m] = trbase + cg_off(4 * fq + q4, 2 * m + (p4 >> 1)) + (p4 & 1) * 8;
    LAS int* ssel = (LAS int*)(lds + 133120 + wid * 1280);
    LAS int* bkt = ssel + 256;
    for (;;) {
        int qk = 0; if (lane == 0) qk = __atomic_fetch_add(qctr, 1, __ATOMIC_RELAXED);
        qk = __builtin_amdgcn_readfirstlane(qk); if (qk >= 64) break;
        const int t = blockIdx.x * 8 + (qk & 7) + NBLK * 8 * (qk >> 3);
        const int b = t >> 12, pos = t & 4095, ns = __builtin_amdgcn_readfirstlane(nsel[t]), nch = ns >> 5;
        const int* selp = sel + (size_t)t * IDXTOPK;
        *(LAS u32x4*)(ssel + 4 * lane) = *(const u32x4*)(selp + 4 * lane);
        bf16x8 qb[8];
#pragma unroll
        for (int j = 0; j < 8; ++j) qb[j] = *(const bf16x8*)(qlat + (size_t)t * 4096 + fr * 256 + j * 32 + fq * 8);
        f32x4 acc[16];
#pragma unroll
        for (int n = 0; n < 16; ++n) acc[n] = (f32x4){0.f, 0.f, 0.f, 0.f};
        float mrun = -1e30f, lsum = 0.f;
        const bf16_t* ckb = ckv + (size_t)b * SEQ * KVLAT + hc * 8;
        bf16x8 st[16];
#pragma unroll
        for (int it = 0; it < 16; ++it) { const int key = ssel[2 * it + hr]; st[it] = *(const bf16x8*)(ckb + (size_t)key * KVLAT); }
        for (int ch = 0; ch < nch; ++ch) {
#pragma unroll
            for (int it = 0; it < 16; ++it) *(LAS bf16x8*)(cgl + cg_off(2 * it + hr, hc)) = st[it];
            if (ch + 1 < nch) {
#pragma unroll
                for (int it = 0; it < 16; ++it) { const int key = ssel[(ch + 1) * 32 + 2 * it + hr]; st[it] = *(const bf16x8*)(ckb + (size_t)key * KVLAT); }
            }
            if (lane < 32) bkt[lane] = t5_bucket_dev(ssel[ch * 32 + lane] - pos) * 16;
            f32x4 s0 = (f32x4){0.f, 0.f, 0.f, 0.f}, s1 = (f32x4){0.f, 0.f, 0.f, 0.f};
#pragma unroll
            for (int j = 0; j < 8; ++j) {
                const bf16x8 a0 = *(const LAS bf16x8*)(qkb[j & 3] + (j >> 2) * 256);
                const bf16x8 a1 = *(const LAS bf16x8*)(qkb[j & 3] + (j >> 2) * 256 + 8192);
                s0 = __builtin_amdgcn_mfma_f32_16x16x32_bf16(a0, qb[j], s0, 0, 0, 0);
                s1 = __builtin_amdgcn_mfma_f32_16x16x32_bf16(a1, qb[j], s1, 0, 0, 0);
            }
            const u32x4 bo0 = *(LAS u32x4*)(bkt + 4 * fq), bo1 = *(LAS u32x4*)(bkt + 16 + 4 * fq);
            float cmax = -1e30f;
#pragma unroll
            for (int i = 0; i < 4; ++i) {
                s0[i] = fmaf(s0[i], 0.12751743082459868f, rbl[bo0[i] + fr]);
                s1[i] = fmaf(s1[i], 0.12751743082459868f, rbl[bo1[i] + fr]);
                cmax = fmaxf(cmax, fmaxf(s0[i], s1[i]));
            }
            { const auto x16 = __builtin_amdgcn_permlane16_swap(__float_as_uint(cmax), __float_as_uint(cmax), false, false); cmax = fmaxf(__uint_as_float(x16[0]), __uint_as_float(x16[1]));
              const auto x32 = __builtin_amdgcn_permlane32_swap(__float_as_uint(cmax), __float_as_uint(cmax), false, false); cmax = fmaxf(__uint_as_float(x32[0]), __uint_as_float(x32[1])); }
            if (!__all(cmax - mrun <= 11.5f)) {
                const float mnew = fmaxf(mrun, cmax), alpha = __builtin_amdgcn_exp2f(mrun - mnew);
                mrun = mnew; lsum *= alpha;
#pragma unroll
                for (int n = 0; n < 16; ++n) acc[n] *= alpha;
            }
            float ps = 0.f;
#pragma unroll
            for (int i = 0; i < 4; ++i) { s0[i] = __builtin_amdgcn_exp2f(s0[i] - mrun); s1[i] = __builtin_amdgcn_exp2f(s1[i] - mrun); ps += s0[i] + s1[i]; }
            lsum += ps;
            u32x4 pw; pw.x = cvt_pk_bf16(s0[0], s0[1]); pw.y = cvt_pk_bf16(s0[2], s0[3]); pw.z = cvt_pk_bf16(s1[0], s1[1]); pw.w = cvt_pk_bf16(s1[2], s1[3]);
            const bf16x8 pb = *reinterpret_cast<bf16x8*>(&pw);
#define TRRD2(dst, base, off) asm volatile("ds_read_b64_tr_b16 %0, %1 offset:%2" : "=&v"(dst) : "v"(base), "i"(off) : "memory")
#define PV_4(n0) do { s16x4 l0, h0, l1, h1, l2, h2, l3, h3; \
                TRRD2(l0, trb[((n0) + 0) & 7], (((n0) + 0) >> 3) * 256); TRRD2(h0, trb[((n0) + 0) & 7], (((n0) + 0) >> 3) * 256 + 8192); \
                TRRD2(l1, trb[((n0) + 1) & 7], (((n0) + 1) >> 3) * 256); TRRD2(h1, trb[((n0) + 1) & 7], (((n0) + 1) >> 3) * 256 + 8192); \
                TRRD2(l2, trb[((n0) + 2) & 7], (((n0) + 2) >> 3) * 256); TRRD2(h2, trb[((n0) + 2) & 7], (((n0) + 2) >> 3) * 256 + 8192); \
                TRRD2(l3, trb[((n0) + 3) & 7], (((n0) + 3) >> 3) * 256); TRRD2(h3, trb[((n0) + 3) & 7], (((n0) + 3) >> 3) * 256 + 8192); \
                asm volatile("s_waitcnt lgkmcnt(0)" ::: "memory"); __builtin_amdgcn_sched_barrier(0); \
                acc[(n0) + 0] = __builtin_amdgcn_mfma_f32_16x16x32_bf16((bf16x8){l0[0], l0[1], l0[2], l0[3], h0[0], h0[1], h0[2], h0[3]}, pb, acc[(n0) + 0], 0, 0, 0); \
                acc[(n0) + 1] = __builtin_amdgcn_mfma_f32_16x16x32_bf16((bf16x8){l1[0], l1[1], l1[2], l1[3], h1[0], h1[1], h1[2], h1[3]}, pb, acc[(n0) + 1], 0, 0, 0); \
                acc[(n0) + 2] = __builtin_amdgcn_mfma_f32_16x16x32_bf16((bf16x8){l2[0], l2[1], l2[2], l2[3], h2[0], h2[1], h2[2], h2[3]}, pb, acc[(n0) + 2], 0, 0, 0); \
                acc[(n0) + 3] = __builtin_amdgcn_mfma_f32_16x16x32_bf16((bf16x8){l3[0], l3[1], l3[2], l3[3], h3[0], h3[1], h3[2], h3[3]}, pb, acc[(n0) + 3], 0, 0, 0); \
                __builtin_amdgcn_sched_barrier(0); } while (0)
            PV_4(0); PV_4(4); PV_4(8); PV_4(12);
#undef PV_4
#undef TRRD2
            asm volatile("s_waitcnt lgkmcnt(0)" ::: "memory");
        }
        float lt = lsum; lt += __shfl_xor(lt, 16); lt += __shfl_xor(lt, 32);
        const float inv = 1.0f / lt;
        bf16_t* op = olat + (size_t)t * 4096 + fr * 256 + 4 * fq;
#pragma unroll
        for (int n = 0; n < 16; ++n) { u32x2 o; o.x = cvt_pk_bf16(acc[n][0] * inv, acc[n][1] * inv); o.y = cvt_pk_bf16(acc[n][2] * inv, acc[n][3] * inv); *(u32x2*)(op + 16 * n) = o; }
    }
    }
}

#define XB_TMO      128
#define XB_XCNT(j)  (256  + 64 * (j))
#define XB_XSUB(j)  (1280 + 64 * (j))
#define XB_XGEN(j)  (2304 + 64 * (j))
#define XB_TOP      3328
#define XB_TOPGEN   3392
#define XCD_BAR_WORDS 3456
#define XB_SPIN_CAP (1u << 21)

__device__ __forceinline__ unsigned xb_ld(unsigned* p)              { return __hip_atomic_load(p, __ATOMIC_RELAXED, __HIP_MEMORY_SCOPE_AGENT); }
__device__ __forceinline__ unsigned xb_add(unsigned* p, unsigned v) { return __hip_atomic_fetch_add(p, v, __ATOMIC_RELAXED, __HIP_MEMORY_SCOPE_AGENT); }
__device__ __forceinline__ unsigned xb_xcc_id() { return (unsigned)__builtin_amdgcn_s_getreg((3 << 11) | 20) & 0xFu; }
#define XB_SPIN(cond, bar) do { unsigned _sp = 0; while (cond) { __builtin_amdgcn_s_sleep(1); \
    if ((++_sp & 255u) == 0u) { if (xb_ld(&(bar)[XB_TMO])) break; if (_sp > XB_SPIN_CAP) { atomicAdd(&(bar)[XB_TMO], 1u); break; } } } } while (0)

struct XcdBarrier {
    unsigned* bar; unsigned x;
    volatile LAS unsigned* st;
};

__device__ __forceinline__ XcdBarrier xcd_barrier_post(unsigned* bar, volatile LAS unsigned* st) {
    XcdBarrier b; b.bar = bar; b.x = xb_xcc_id(); b.st = st;
    if (threadIdx.x == 0) (void)xb_add(&bar[XB_XCNT(b.x)], 1u);
    return b;
}
__device__ __forceinline__ void xcd_barrier_complete(unsigned* bar, unsigned x, unsigned& nloc, unsigned& nx) {
    const unsigned G = gridDim.x * gridDim.y * gridDim.z;
    unsigned sum, cnt, mine, sp = 0u;
    for (;;) {
        sum = 0u; cnt = 0u; mine = 0u;
#pragma unroll
        for (unsigned j = 0; j < 16; ++j) { const unsigned c = xb_ld(&bar[XB_XCNT(j)]); sum += c; cnt += (c > 0u) ? 1u : 0u; mine = (j == x) ? c : mine; }
        if (sum == G) break;
        __builtin_amdgcn_s_sleep(1);
        if ((++sp & 255u) == 0u) { if (xb_ld(&bar[XB_TMO])) break; if (sp > XB_SPIN_CAP) { atomicAdd(&bar[XB_TMO], 1u); break; } }
    }
    nloc = mine > 0u ? mine : 1u; nx = cnt > 0u ? cnt : 1u;
}

__device__ __forceinline__ void xcd_barrier(const XcdBarrier& b) {
    asm volatile("s_waitcnt vmcnt(0)" ::: "memory");
    __syncthreads();
    if (threadIdx.x == 0) {
        unsigned* bar = b.bar;
        __builtin_amdgcn_s_waitcnt(0);
        unsigned nloc = b.st[0], nx = b.st[1];
        if (nloc == 0u) { xcd_barrier_complete(bar, b.x, nloc, nx); b.st[0] = nloc; b.st[1] = nx; }
        const unsigned old = xb_add(&bar[XB_XSUB(b.x)], 1u);
        const unsigned gen = old / nloc;
        if (old + 1u == (gen + 1u) * nloc) {
            __builtin_amdgcn_fence(__ATOMIC_RELEASE, "agent");
            asm volatile("s_waitcnt vmcnt(0)" ::: "memory");
            const unsigned og = xb_add(&bar[XB_TOP], 1u);
            const unsigned tg = og / nx;
            if (og + 1u == (tg + 1u) * nx) xb_add(&bar[XB_TOPGEN], 1u);
            else XB_SPIN(xb_ld(&bar[XB_TOPGEN]) == tg, bar);
            __builtin_amdgcn_fence(__ATOMIC_ACQUIRE, "agent");
            xb_add(&bar[XB_XGEN(b.x)], 1u);
            asm volatile("s_waitcnt vmcnt(0)" ::: "memory");
        } else {
            XB_SPIN(xb_ld(&bar[XB_XGEN(b.x)]) == gen, bar);
            __builtin_amdgcn_fence(__ATOMIC_ACQUIRE, "agent");
            asm volatile("s_waitcnt vmcnt(0)" ::: "memory");
        }
    }
    __syncthreads();
}


enum { PH_PROLOGUE = 0, PH_INPROJ_A, PH_NORMS, PH_ATTN_A, PH_OUTPROJ_A, PH_LNR_0, PH_RPOS_0, PH_GU_0, PH_DOWN_0, PH_COMB_0,
       PH_INPROJ_B, PH_DSA_PREP, PH_QPROJ_B, PH_INDEXER, PH_SPATTN, PH_UV_B, PH_OUTPROJ_B, PH_LNR_1, PH_RPOS_1, PH_GU_1, PH_DOWN_1, PH_COMB_1, PH_COUNT };

template <int PH>
__device__ __forceinline__ void run_phase(const Params& p, LAS unsigned char* lds) {
    unsigned char* ws = p.ws;
    unsigned* ctrl = (unsigned*)(ws + OFF_CTRL);
    bf16_t* xb = (bf16_t*)(ws + OFF_XB); bf16_t* xlo = (bf16_t*)(ws + OFF_X2F);
    unsigned char* big = ws + OFF_BIG;
    constexpr int LAYER = (PH >= PH_INPROJ_B) ? 1 : 0;
    if constexpr (PH == PH_PROLOGUE) {
        { float* NRM = (float*)(big + BG_NRM); for (int i = blockIdx.x * NTHREADS + tidx(); i < 2 * 64 * 64 * 2; i += NBLK * NTHREADS) NRM[i] = 0.f; }
        phase_cvt_fox(p, lds); phase_cvt_router(p); phase_cvt_fgate(p); phase_cvt_moe(p, lds, 0, CVT0_SPLIT); phase_cvt_dsa(p, lds); phase_wprep(p); phase_cvt_moe(p, lds, 1, CVT1_SPLIT);
    }
    else if constexpr (PH == PH_INPROJ_A) {
        phase_fgate(p);
        if (blockIdx.x >= NBLK - CVB) {
            const int tid = tidx();
            cvt_moe_run4(p, lds + (tid >> 6) * 9216, 0, CVT0_SPLIT + (blockIdx.x - (NBLK - CVB)) * NWAVES + (tid >> 6), CVB * NWAVES, 65 * 768 - CVT0_GU, tid & 63);
        } else {
            pg8::DenseSched S; S.init(xb, (const bf16_t*)(ws + OFF_WA + WA_WINT), NTOK, 6144, DM, NBLK - CVB);
            pg8::EpiBf16T<true> E; E.O0 = (bf16_t*)(big + BG_Q); E.ld0 = DM; E.O1 = nullptr; E.ld1 = 0; E.split0 = 0; E.split_cols = DM; E.split_stride = (size_t)NTOK * DM; E.nrm = (float*)(big + BG_NRM);
            pg8::gemm_phase(lds, S, E);
        }
    }
    else if constexpr (PH == PH_NORMS) phase_scan(p, lds);
    else if constexpr (PH == PH_ATTN_A) phase_fox_attn(p, lds);
    else if constexpr (PH == PH_OUTPROJ_A) {
        pg8::DenseSched S; S.init((const bf16_t*)(big + BG_O), (const bf16_t*)(ws + OFF_WA + WA_WOUTT), NTOK, DM, DM);
        pg8::EpiBf16 E; E.O0 = (bf16_t*)(big + BG_M); E.ld0 = DM; E.O1 = nullptr; E.ld1 = 0; E.split0 = 1 << 30; E.split_cols = 0; E.split_stride = 0;
        pg8::gemm_phase(lds, S, E);
    }
    else if constexpr (PH == PH_LNR_0) phase_router(p, lds, xb, xlo, (const bf16_t*)(ws + OFF_ROUTE + RWT_BYTE_OFF), p.router_b, p.x, (const bf16_t*)(big + BG_M), p.ln1_g, p.ln1_b);
    else if constexpr (PH == PH_LNR_1) phase_router(p, lds, xb, xlo, (const bf16_t*)(ws + OFF_ROUTE + RWT_BYTE_OFF) + (size_t)128 * DM, p.router_b + NEXP, nullptr, (const bf16_t*)(big + BG_M2), p.ln1_g + DM, p.ln1_b + DM);
    else if constexpr (PH == PH_RPOS_0 || PH == PH_RPOS_1) phase_route_pos(p, lds);
    else if constexpr (PH == PH_GU_0 || PH == PH_GU_1) {
        constexpr int NCV = GU0_CV;
        if (NCV > 0 && (int)(blockIdx.x >> 3) >= (NBLK >> 3) - NCV) {
            const int tid = tidx();
            cvt_moe_run4(p, lds + (tid >> 6) * 9216, LAYER, 65 * 768 - CVT0_GU + ((int)(blockIdx.x >> 3) - ((NBLK >> 3) - NCV)) * 64 + (int)(blockIdx.x & 7) * NWAVES + (tid >> 6), NCV * 64, 65 * 768, tid & 63);
        } else {
            pg8::MoeGuSched S; S.init(ctrl, xb, (const bf16_t*)(ws + OFF_WGU + (size_t)LAYER * MOE_LSTRIDE), (const int*)(ws + OFF_ROUTE) + RT_ROWTOK, -1, (LAS int*)(lds + pg8::STAGE_BYTES), NCV);
            pg8::EpiSwiGLU E; E.H = (bf16_t*)(big + BG_H);
            pg8::gemm_phase(lds, S, E);
        }
    }
    else if constexpr (PH == PH_DOWN_0 || PH == PH_DOWN_1) {
        pg8::MoeDownSched S; S.init(ctrl, (const bf16_t*)(big + BG_H), (const bf16_t*)(ws + OFF_WD + (size_t)LAYER * MOE_LSTRIDE), -1);
        if constexpr (PH == PH_DOWN_1 || YS0_FP8) {
            pg8::EpiFp8 E; E.O = big + BG_YS; E.ldc = DM;
            pg8::gemm_phase(lds, S, E);
        } else {
            pg8::EpiBf16 E; E.O0 = (bf16_t*)(big + BG_YS); E.ld0 = DM; E.O1 = nullptr; E.ld1 = 0; E.split0 = 1 << 30; E.split_cols = 0; E.split_stride = 0;
            pg8::gemm_phase(lds, S, E);
        }
    }
    else if constexpr (PH == PH_COMB_0) phase_combine_ln2<(YS0_FP8 != 0)>(p, xb, xlo, p.ln2_g, p.ln2_b, nullptr);
    else if constexpr (PH == PH_COMB_1) phase_combine_ln2<true>(p, xb, xlo, p.ln2_g + DM, p.ln2_b + DM, p.out);
    else if constexpr (PH == PH_INPROJ_B) {
        pg8::DenseSched S; S.init(xb, (const bf16_t*)(ws + OFF_WA + WA_WBINT), NTOK, 1024, DM);
        pg8::EpiF32 E; E.C = (float*)(big + BG_PROJ); E.ldc = 1024;
        pg8::gemm_phase(lds, S, E);
    }
    else if constexpr (PH == PH_DSA_PREP) phase_dsa_prep(p);
    else if constexpr (PH == PH_QPROJ_B) {
        pg8::DenseSched S; S.init((const bf16_t*)(big + BG_CQ), (const bf16_t*)(ws + OFF_WA + WA_WQ2T), NTOK, 5120, QLAT);
        pg8::EpiBf16 E; E.O0 = (bf16_t*)(big + BG_QLAT); E.ld0 = 4096; E.O1 = (bf16_t*)(big + BG_QIDX); E.ld1 = 1024; E.split0 = 4096; E.split_cols = 0; E.split_stride = 0;
        pg8::gemm_phase(lds, S, E);
    }
    else if constexpr (PH == PH_INDEXER) phase_indexer(p, lds);
    else if constexpr (PH == PH_SPATTN) phase_sparse_attn(p, lds);
    else if constexpr (PH == PH_UV_B) {
        pg8::BlockDiagSched S; S.init((const bf16_t*)(big + BG_OLAT), (const bf16_t*)(ws + OFF_WA + WA_WUVOT), NTOK, DM, 512, 4096);
        pg8::EpiBf16 E; E.O0 = (bf16_t*)(big + BG_O2); E.ld0 = DM; E.O1 = nullptr; E.ld1 = 0; E.split0 = 1 << 30; E.split_cols = 0; E.split_stride = 0;
        pg8::gemm_phase(lds, S, E);
    }
    else if constexpr (PH == PH_OUTPROJ_B) {
        pg8::DenseSched S; S.init((const bf16_t*)(big + BG_O2), (const bf16_t*)(ws + OFF_WA + WA_WOUTTB), NTOK, DM, DM);
        pg8::EpiBf16 E; E.O0 = (bf16_t*)(big + BG_M2); E.ld0 = DM; E.O1 = nullptr; E.ld1 = 0; E.split0 = 1 << 30; E.split_cols = 0; E.split_stride = 0;
        pg8::gemm_phase(lds, S, E);
    }
}

#ifndef MK_LAUNCHES
#define MK_LAUNCHES 1
#endif
constexpr int LDS_BAR_OFF = LDS_BYTES - 16;

template <int PH>
__device__ __forceinline__ void run_from(const Params& p, LAS unsigned char* lds, const XcdBarrier& bar) {
    run_phase<PH>(p, lds);
    if constexpr (PH + 1 < PH_COUNT) { xcd_barrier(bar); run_from<PH + 1>(p, lds, bar); }
}
__global__ void __launch_bounds__(NTHREADS, 2) k_mega(Params p) {
    extern __shared__ __attribute__((aligned(16))) unsigned char smem[];
    LAS unsigned char* lds = (LAS unsigned char*)smem;
    if (threadIdx.x == 0) *(LAS u32x4*)(lds + LDS_BAR_OFF) = (u32x4){0u, 0u, 0u, 0u};
    __syncthreads();
    const XcdBarrier bar = xcd_barrier_post((unsigned*)(p.ws + OFF_CTRL) + CW_BAR, (volatile LAS unsigned*)(lds + LDS_BAR_OFF));
    run_from<0>(p, lds, bar);
}
template <int PH>
__global__ void __launch_bounds__(NTHREADS, 2) k_phase(Params p) {
    extern __shared__ __attribute__((aligned(16))) unsigned char smem[];
    run_phase<PH>(p, (LAS unsigned char*)smem);
}
template <int PH>
static void launch_phases(const Params& p, int grid, hipStream_t stream) {
    static bool done = false;
    if (!done) { done = true; (void)hipFuncSetAttribute((const void*)k_phase<PH>, hipFuncAttributeMaxDynamicSharedMemorySize, LDS_BYTES); }
    hipLaunchKernelGGL(k_phase<PH>, dim3(grid), dim3(NTHREADS), LDS_BYTES, stream, p);
    if constexpr (PH + 1 < PH_COUNT) launch_phases<PH + 1>(p, grid, stream);
}

extern "C" void kernel_launch(void* const* d_in, const int* in_sizes, int n_in, void* d_out, int out_size, void* d_ws, size_t ws_size, hipStream_t stream) {
    if (n_in != 25 || out_size != NTOK * DM || ws_size < WS_END) { fprintf(stderr, "kernel_launch: unexpected shapes (n_in %d out %d ws %zu)\n", n_in, out_size, ws_size); return; }
    Params p{};
    const float** pp = (const float**)&p;
    for (int i = 0; i < 25; ++i) pp[i] = (const float*)d_in[i];
    p.out = (float*)d_out; p.ws = (unsigned char*)d_ws;
    static int grid = 0;
    if (!grid) {
        int dev = 0, cus = 0, per_cu = 0; (void)hipGetDevice(&dev);
        if (hipDeviceGetAttribute(&cus, hipDeviceAttributeMultiprocessorCount, dev) != hipSuccess || cus <= 0) cus = 256;
        (void)hipFuncSetAttribute((const void*)k_mega, hipFuncAttributeMaxDynamicSharedMemorySize, LDS_BYTES);
        if (hipOccupancyMaxActiveBlocksPerMultiprocessor(&per_cu, (const void*)k_mega, NTHREADS, LDS_BYTES) != hipSuccess || per_cu < 1) fprintf(stderr, "kernel_launch: occupancy query reports %d workgroups per CU\n", per_cu);
        if (cus < NBLK) fprintf(stderr, "kernel_launch: built for a %d-CU device, found %d CUs\n", NBLK, cus);
        grid = NBLK;
    }
    (void)hipMemsetAsync((char*)d_ws + OFF_CTRL, 0, CTRL_ZERO_BYTES, stream);
#if MK_LAUNCHES
    hipLaunchKernelGGL(k_mega, dim3(grid), dim3(NTHREADS), LDS_BYTES, stream, p);
#else
    launch_phases<0>(p, grid, stream);
#endif
}
```

```cpp
#include <hip/hip_runtime.h>
#include <stdint.h>
#include <stdio.h>

#define LAS __attribute__((address_space(3)))
typedef unsigned short bf16_t;
typedef short bf16x8 __attribute__((ext_vector_type(8)));
typedef short s16x4 __attribute__((ext_vector_type(4)));
typedef float f32x16 __attribute__((ext_vector_type(16)));
typedef float f32x4 __attribute__((ext_vector_type(4)));
typedef float f32x2 __attribute__((ext_vector_type(2)));
typedef unsigned u32x4 __attribute__((ext_vector_type(4)));
typedef unsigned u32x2 __attribute__((ext_vector_type(2)));

constexpr int NTOK = 16384, DM = 2048, SEQ = 4096, NBATCH = 4, NHEAD = 16, HDIM = 128;
constexpr int NEXP = 64, TOPK = 8, DEXP = 512;
constexpr int QLAT = 512, KVLAT = 256, IDXD = 64, IDXH = 16, IDXTOPK = 256, BW = 848;
constexpr float ALPHA = 1.4142135623730951f, LN_EPS = 1e-5f, RMS_EPS = 1e-6f, ROUTED_SCALE = 2.5f;
constexpr int NTHREADS = 512, NWAVES = 8;
#ifndef YS0_FP8
#define YS0_FP8 1
#endif
#ifndef CVT1_SPLIT
#define CVT1_SPLIT 0
#endif
#ifndef CVB
#define CVB 64
#endif
#ifndef GU0_CV
#define GU0_CV 1
#endif
#ifndef CVT0_GU
#define CVT0_GU 8320
#endif
#ifndef CVT0_SPLIT
#define CVT0_SPLIT 0
#endif
#ifndef SPA_CW
#define SPA_CW 2
#endif
constexpr int NBLK = 256;
constexpr int LDS_BYTES = 147456;
constexpr int MAXRT = 576;
constexpr int SH_TILE0 = MAXRT;
constexpr int NSROWS = (MAXRT + 64) * 256;

constexpr size_t MiB = 1048576;
constexpr size_t OFF_CTRL = 0, OFF_ROUTE = 1 * MiB, OFF_WGU = 5 * MiB, OFF_WD = 265 * MiB, MOE_LSTRIDE = 390 * MiB  , OFF_WA = 785 * MiB, OFF_XB = 857 * MiB, OFF_X2F = 921 * MiB, OFF_BIG = 1049 * MiB, WS_END = 1849 * MiB;
constexpr int CW_BAR = 0;
constexpr int CW_NTILES = 4096;
constexpr int CW_TILE_E = 4352;
constexpr int CW_TILE_RT = 5120;
constexpr int CW_HIST = 8192;
constexpr int CTRL_ZERO_BYTES = 16384;
constexpr size_t RT_SEL = 0, RT_GATE = 131072, RT_RANK = 262144, RT_POS = 393216, RT_ROWTOK = 524288;
constexpr size_t FWT_BYTE_OFF = 3 * MiB - 131072;
constexpr size_t RWT_BYTE_OFF = 3 * MiB;
constexpr size_t BG_Q = 0, BG_K = 64 * MiB, BG_V = 128 * MiB, BG_O = 192 * MiB, BG_M = 256 * MiB, BG_LOGF = 384 * MiB, BG_G = 385 * MiB, BG_NRM = 386 * MiB;
constexpr size_t BG_H = 0, BG_YS = 160 * MiB;
constexpr size_t BG_PROJ = 0, BG_CQ = 64 * MiB, BG_CKV = 80 * MiB, BG_KIDX = 88 * MiB, BG_WIDX = 90 * MiB, BG_NSEL = 91 * MiB, BG_QLAT = 96 * MiB, BG_QIDX = 224 * MiB, BG_SEL = 256 * MiB, BG_OLAT = 272 * MiB, BG_M2 = 400 * MiB, BG_O2 = 464 * MiB;
constexpr size_t WA_WINT = 0, WA_WOUTT = 24 * MiB;
constexpr size_t WA_WBINT = 32 * MiB, WA_WQ2T = 36 * MiB, WA_WUVOT = 44 * MiB  , WA_WOUTTB = 60 * MiB;

struct Params {
    const float *x, *a_w_in, *a_b_f, *a_w_out, *b_w_in, *b_q_norm, *b_kv_norm, *b_w_uq, *b_w_iq, *b_w_uk, *b_w_uv, *b_w_out, *rel_bias,
        *ln1_g, *ln1_b, *ln2_g, *ln2_b, *router_w, *router_b, *w_gate, *w_up, *w_down, *sh_gate, *sh_up, *sh_down;
    float* out;
    unsigned char* ws;
};

__device__ __forceinline__ unsigned cvt_pk_bf16(float lo, float hi) { unsigned r; asm volatile("v_cvt_pk_bf16_f32 %0, %1, %2" : "=v"(r) : "v"(lo), "v"(hi)); return r; }
__device__ __forceinline__ bf16x8 pack8(f32x4 a, f32x4 b) {
    u32x4 w = {cvt_pk_bf16(a[0], a[1]), cvt_pk_bf16(a[2], a[3]), cvt_pk_bf16(b[0], b[1]), cvt_pk_bf16(b[2], b[3])};
    return *reinterpret_cast<bf16x8*>(&w);
}
__device__ __forceinline__ void mfma_fence(f32x4& a) { asm volatile("s_nop 15\n\ts_nop 15" : "+v"(a)); }
__device__ __forceinline__ int tidx() { int t = (int)threadIdx.x; asm volatile("" : "+v"(t)); return t; }
__device__ __forceinline__ float bf2f(bf16_t b) { return __uint_as_float(((unsigned)b) << 16); }
__device__ __forceinline__ float wave_sum(float v) {
#pragma unroll
    for (int o = 32; o >= 1; o >>= 1) v += __shfl_xor(v, o);
    return v;
}
__device__ __forceinline__ float wave_max(float v) {
#pragma unroll
    for (int o = 32; o >= 1; o >>= 1) v = fmaxf(v, __shfl_xor(v, o));
    return v;
}

namespace pg8 {
constexpr int BM = 256, BK = 64, HALF = 128, HTB = HALF * BK * 2  , STAGE_BYTES = 8 * HTB, NXCD = 8, WGM = 8;

__host__ __device__ __forceinline__ int lds_byte(int r, int c) { const int st = (r >> 4) * 2 + (c >> 5), rr = r & 15, cc = c & 31, ob = rr * 64 + cc * 2; return st * 1024 + (ob ^ (((ob >> 9) & 1) << 5)); }
__host__ __device__ __forceinline__ void stage_rc(int b, int& R, int& C) { const int st = b / 1024, sb = b % 1024, swz = sb ^ (((sb >> 9) & 1) << 5); R = (st >> 1) * 16 + swz / 64; C = (st & 1) * 32 + (swz % 64) / 2; }
__host__ __device__ __forceinline__ int perm32(int rho) { const int n = rho >> 4, i = rho & 15; return 8 * (i >> 2) + 4 * n + (i & 3); }

struct Unit { int pm, pn, e, idx; };

struct StaticOrder {
    int nM, nN, nwg, G, c;
    __device__ void init(int M, int N, int G_, int c_) { nM = M / BM; nN = N / BM; nwg = nM * nN; G = G_; c = c_; }
    __device__ bool next(int i, Unit& u) const {
        const long L = (long)i * G + c; if (L >= nwg) return false;
        int wgid = (int)L; { const int q = nwg / NXCD, r = nwg % NXCD, xcd = wgid % NXCD, off = wgid / NXCD; wgid = (xcd < r ? xcd * (q + 1) : r * (q + 1) + (xcd - r) * q) + off; }
        const int nig = WGM * nN, gid = wgid / nig, fm = gid * WGM, gsz = (nM - fm) < WGM ? (nM - fm) : WGM;
        u.pm = fm + ((wgid % nig) % gsz); u.pn = (wgid % nig) / gsz; u.e = 0; u.idx = i; return true;
    }
};
struct DenseSched {
    const bf16_t* A; const bf16_t* Bt; int K; StaticOrder so;
    __device__ void init(const bf16_t* A_, const bf16_t* Bt_, int M, int N, int K_, int G_ = NBLK) { A = A_; Bt = Bt_; K = K_; so.init(M, N, G_, blockIdx.x); }
    __device__ __forceinline__ bool next(int i, Unit& u) const { return so.next(i, u); }
    __device__ __forceinline__ int rot() const { return 0; }
    __device__ __forceinline__ int ldk() const { return K; }
    __device__ __forceinline__ size_t kstep_a() const { return BK * 2; }
    __device__ __forceinline__ size_t kstep_b() const { return BK * 2; }
    __device__ __forceinline__ const char* a_base(const Unit& u) const { return (const char*)A + (size_t)u.pm * BM * K * 2; }
    __device__ __forceinline__ const char* b_base(const Unit& u) const { return (const char*)Bt + (size_t)u.pn * BM * K * 2; }
    __device__ __forceinline__ void a_offs(const Unit&, const int (&R)[2], const int (&C)[2], unsigned (&off)[2][2]) const {
#pragma unroll
        for (int h = 0; h < 2; ++h)
#pragma unroll
            for (int i = 0; i < 2; ++i) off[h][i] = (unsigned)((h * HALF + R[i]) * K + C[i]) * 2u;
    }
};
struct BlockDiagSched {
    const bf16_t* A; const bf16_t* Bt; int K, LD; StaticOrder so;
    __device__ void init(const bf16_t* A_, const bf16_t* Bt_, int M, int N, int K_, int LD_) { A = A_; Bt = Bt_; K = K_; LD = LD_; so.init(M, N, NBLK, blockIdx.x); }
    __device__ __forceinline__ bool next(int i, Unit& u) const { return so.next(i, u); }
    __device__ __forceinline__ int rot() const { return 0; }
    __device__ __forceinline__ int ldk() const { return LD; }
    __device__ __forceinline__ size_t kstep_a() const { return BK * 2; }
    __device__ __forceinline__ size_t kstep_b() const { return BK * 2; }
    __device__ __forceinline__ const char* a_base(const Unit& u) const { return (const char*)A + ((size_t)u.pm * BM * LD + (size_t)u.pn * K) * 2; }
    __device__ __forceinline__ const char* b_base(const Unit& u) const { return (const char*)Bt + ((size_t)u.pn * BM * LD + (size_t)u.pn * K) * 2; }
    __device__ __forceinline__ void a_offs(const Unit&, const int (&R)[2], const int (&C)[2], unsigned (&off)[2][2]) const {
#pragma unroll
        for (int h = 0; h < 2; ++h)
#pragma unroll
            for (int i = 0; i < 2; ++i) off[h][i] = (unsigned)((h * HALF + R[i]) * LD + C[i]) * 2u;
    }
};
struct MoeSchedBase {
    const unsigned* ctrl; int npn, ntiles, G, c, tpx, t0, t1, nx, lc;
    __device__ void init_base(const unsigned* ctrl_, int npn_, int part, int nconv = 0) { ctrl = ctrl_; npn = npn_; ntiles = (int)ctrl_[CW_NTILES]; G = NBLK; c = blockIdx.x;
        if ((G & 7) == 0) { const int x = c & 7; nx = (G >> 3) - nconv; lc = c >> 3; tpx = (ntiles + 7) >> 3; t0 = x * tpx; t1 = t0 + tpx < ntiles ? t0 + tpx : ntiles; if (t0 > t1) t0 = t1; }
        else { nx = G; lc = c; tpx = ntiles; t0 = 0; t1 = ntiles; }
        if (part >= 0) { const int ts = t0 + (2 * (t1 - t0) + 2) / 3; if (part == 0) t1 = ts; else t0 = ts; } }
    __device__ __forceinline__ bool next(int i, Unit& u) const {
        const int li = i * nx + lc, T = t0 + li / npn; if (T >= t1) return false;
        u.pn = li % npn; u.e = (int)ctrl[CW_TILE_E + T]; u.pm = (int)ctrl[CW_TILE_RT + T]; u.idx = i; return true;
    }
    __device__ __forceinline__ int rot() const { return 0; }
    __device__ __forceinline__ size_t kstep_a() const { return BK * 2; }
    __device__ __forceinline__ size_t kstep_b() const { return BK * 2; }
};
struct MoeGuSched : MoeSchedBase {
    const bf16_t* A; const bf16_t* Bt; const int* row_tok; int K; LAS int* rowsL;
    __device__ void init(const unsigned* ctrl_, const bf16_t* A_, const bf16_t* Bt_, const int* row_tok_, int part, LAS int* rowsL_, int nconv = 0) { init_base(ctrl_, 4, part, nconv); A = A_; Bt = Bt_; row_tok = row_tok_; K = DM; rowsL = rowsL_;
        const int tid = tidx();
        for (int i = 0; i < 15; ++i) { Unit u; if (!next(i, u)) break; if (tid < 256) rowsL[i * 256 + tid] = row_tok[(size_t)u.pm * BM + tid]; }
        asm volatile("s_waitcnt vmcnt(0) lgkmcnt(0)" ::: "memory"); __syncthreads(); }
    __device__ __forceinline__ int ldk() const { return DM; }
    __device__ __forceinline__ const char* a_base(const Unit&) const { return (const char*)A; }
    __device__ __forceinline__ const char* b_base(const Unit& u) const { return (const char*)Bt + ((size_t)u.e * 1024 + (size_t)u.pn * BM) * DM * 2; }
    __device__ __forceinline__ void a_offs(const Unit& u, const int (&R)[2], const int (&C)[2], unsigned (&off)[2][2]) const {
        const LAS int* rt = rowsL + (u.idx < 15 ? u.idx : 14) * 256;
#pragma unroll
        for (int h = 0; h < 2; ++h)
#pragma unroll
            for (int i = 0; i < 2; ++i) { const int tok = rt[h * HALF + R[i]]; off[h][i] = (unsigned)(tok * DM + C[i]) * 2u; }
    }
};
struct MoeDownSched : MoeSchedBase {
    const bf16_t* A; const bf16_t* Bt; int K;
    __device__ void init(const unsigned* ctrl_, const bf16_t* A_, const bf16_t* Bt_, int part) { init_base(ctrl_, 8, part); A = A_; Bt = Bt_; K = DEXP; }
    __device__ __forceinline__ int ldk() const { return DEXP; }
    __device__ __forceinline__ const char* a_base(const Unit& u) const { return (const char*)A + (size_t)u.pm * BM * DEXP * 2; }
    __device__ __forceinline__ const char* b_base(const Unit& u) const { return (const char*)Bt + ((size_t)u.e * DM + (size_t)u.pn * BM) * DEXP * 2; }
    __device__ __forceinline__ void a_offs(const Unit&, const int (&R)[2], const int (&C)[2], unsigned (&off)[2][2]) const {
#pragma unroll
        for (int h = 0; h < 2; ++h)
#pragma unroll
            for (int i = 0; i < 2; ++i) off[h][i] = (unsigned)((h * HALF + R[i]) * DEXP + C[i]) * 2u;
    }
};

__device__ __forceinline__ unsigned xchg1(unsigned v) { return (unsigned)__builtin_amdgcn_update_dpp(0, (int)v, 0xB1, 0xf, 0xf, false); }
__device__ __forceinline__ float xchg1f(float v) { return __uint_as_float(xchg1(__float_as_uint(v))); }
struct EpiF32 {
    static constexpr int PERM = 0;
    float* C; int ldc;
    __device__ __forceinline__ void operator()(const f32x4 (&acc)[2][2][4][2], const Unit& u, int wr, int wc, int fr, int fq) const {
        const bool odd = (fr & 1) != 0;
        const int rowe = u.pm * BM + wr * 64 + (fr & ~1), col0 = u.pn * BM + wc * 32 + (odd ? 16 : 0) + 4 * fq;
#pragma unroll
        for (int ai = 0; ai < 2; ++ai)
#pragma unroll
            for (int m = 0; m < 4; ++m) { float* rowp = C + (size_t)(rowe + ai * HALF + m * 16) * ldc + col0;
#pragma unroll
                for (int bj = 0; bj < 2; ++bj) {
                    const f32x4 v0 = acc[ai][bj][m][0], v1 = acc[ai][bj][m][1];
                    f32x4 s0, s1;
#pragma unroll
                    for (int k = 0; k < 4; ++k) { const float snd = odd ? v0[k] : v1[k]; const float rcv = xchg1f(snd); s0[k] = odd ? rcv : v0[k]; s1[k] = odd ? v1[k] : rcv; }
                    *(f32x4*)(rowp + bj * HALF) = s0; *(f32x4*)(rowp + ldc + bj * HALF) = s1; } }
    }
};
template <bool NORMS>
struct EpiBf16T {
    static constexpr int PERM = 2;
    bf16_t* O0; int ld0; bf16_t* O1; int ld1; int split0; int split_cols; size_t split_stride;
    float* nrm;
    __device__ __forceinline__ void operator()(const f32x4 (&acc)[2][2][4][2], const Unit& u, int wr, int wc, int fr, int fq) const {
        int colt = u.pn * BM; bf16_t* base = O0; int ldc = ld0;
        int qk = 2;
        if (split_cols) { const int t = colt / split_cols; base += (size_t)t * split_stride; colt -= t * split_cols; qk = t; }
        else if (colt >= split0) { base = O1; ldc = ld1; colt -= split0; }
        const bool odd = (fr & 1) != 0;
        const int col0 = colt + wc * 64 + (odd ? 32 : 0) + 8 * fq;
        const int rowe = u.pm * BM + wr * 64 + (fr & ~1);
#pragma unroll
        for (int ai = 0; ai < 2; ++ai) {
            float mx = 0.f;
#pragma unroll
            for (int m = 0; m < 4; ++m) {
                float lo[8], hi[8], e0[8], e1[8];
#pragma unroll
                for (int k = 0; k < 4; ++k) { lo[k] = acc[ai][0][m][0][k]; lo[4 + k] = acc[ai][0][m][1][k]; hi[k] = acc[ai][1][m][0][k]; hi[4 + k] = acc[ai][1][m][1][k]; }
                if constexpr (NORMS) { float sq = 0.f;
#pragma unroll
                    for (int k = 0; k < 8; ++k) { sq = fmaf(lo[k], lo[k], sq); sq = fmaf(hi[k], hi[k], sq); }
                    sq += __shfl_xor(sq, 16); sq += __shfl_xor(sq, 32); mx = fmaxf(mx, sq); }
#pragma unroll
                for (int k = 0; k < 8; ++k) { const float snd = odd ? lo[k] : hi[k]; const float rcv = xchg1f(snd); e0[k] = odd ? rcv : lo[k]; e1[k] = odd ? hi[k] : rcv; }
                u32x4 s0, s1;
                s0.x = cvt_pk_bf16(e0[0], e0[1]); s0.y = cvt_pk_bf16(e0[2], e0[3]); s0.z = cvt_pk_bf16(e0[4], e0[5]); s0.w = cvt_pk_bf16(e0[6], e0[7]);
                s1.x = cvt_pk_bf16(e1[0], e1[1]); s1.y = cvt_pk_bf16(e1[2], e1[3]); s1.z = cvt_pk_bf16(e1[4], e1[5]); s1.w = cvt_pk_bf16(e1[6], e1[7]);
                bf16_t* rp = base + (size_t)(rowe + ai * HALF + m * 16) * ldc + col0;
                *(u32x4*)rp = s0; *(u32x4*)(rp + ldc) = s1;
            }
            if constexpr (NORMS) {
                mx = fmaxf(mx, __shfl_xor(mx, 1)); mx = fmaxf(mx, __shfl_xor(mx, 2)); mx = fmaxf(mx, __shfl_xor(mx, 4)); mx = fmaxf(mx, __shfl_xor(mx, 8));
                const int Jg = u.pm * 4 + ai * 2 + wr, c = colt + wc * 64;
                if (qk < 2 && fr == 0 && fq == 0) atomicMax((unsigned*)(nrm + ((((size_t)qk * 64 + (Jg >> 6) * 16 + (c >> 7)) * 64 + (Jg & 63)) * 2 + ((c >> 6) & 1))), __float_as_uint(mx));
            }
        }
    }
};
using EpiBf16 = EpiBf16T<false>;
struct EpiFp8 {
    static constexpr int PERM = 2;
    unsigned char* O; int ldc;
    __device__ __forceinline__ void operator()(const f32x4 (&acc)[2][2][4][2], const Unit& u, int wr, int wc, int fr, int fq) const {
        const bool odd = (fr & 1) != 0;
        const int col0 = u.pn * BM + wc * 64 + (odd ? 32 : 0) + 8 * fq;
        const int rowe = u.pm * BM + wr * 64 + (fr & ~1);
#pragma unroll
        for (int ai = 0; ai < 2; ++ai)
#pragma unroll
            for (int m = 0; m < 4; ++m) {
                float lo[8], hi[8];
#pragma unroll
                for (int k = 0; k < 4; ++k) { lo[k] = __builtin_amdgcn_fmed3f(acc[ai][0][m][0][k] * 64.f, -448.f, 448.f); lo[4 + k] = __builtin_amdgcn_fmed3f(acc[ai][0][m][1][k] * 64.f, -448.f, 448.f);
                    hi[k] = __builtin_amdgcn_fmed3f(acc[ai][1][m][0][k] * 64.f, -448.f, 448.f); hi[4 + k] = __builtin_amdgcn_fmed3f(acc[ai][1][m][1][k] * 64.f, -448.f, 448.f); }
                int l0 = __builtin_amdgcn_cvt_pk_fp8_f32(lo[0], lo[1], 0, false); l0 = __builtin_amdgcn_cvt_pk_fp8_f32(lo[2], lo[3], l0, true);
                int l1 = __builtin_amdgcn_cvt_pk_fp8_f32(lo[4], lo[5], 0, false); l1 = __builtin_amdgcn_cvt_pk_fp8_f32(lo[6], lo[7], l1, true);
                int h0 = __builtin_amdgcn_cvt_pk_fp8_f32(hi[0], hi[1], 0, false); h0 = __builtin_amdgcn_cvt_pk_fp8_f32(hi[2], hi[3], h0, true);
                int h1 = __builtin_amdgcn_cvt_pk_fp8_f32(hi[4], hi[5], 0, false); h1 = __builtin_amdgcn_cvt_pk_fp8_f32(hi[6], hi[7], h1, true);
                const unsigned s0 = odd ? (unsigned)l0 : (unsigned)h0, s1 = odd ? (unsigned)l1 : (unsigned)h1;
                const unsigned r0 = xchg1(s0), r1 = xchg1(s1);
                u32x2 e0, e1;
                e0.x = odd ? r0 : (unsigned)l0; e0.y = odd ? r1 : (unsigned)l1; e1.x = odd ? (unsigned)h0 : r0; e1.y = odd ? (unsigned)h1 : r1;
                unsigned char* rp = O + (size_t)(rowe + ai * HALF + m * 16) * ldc + col0;
                *(u32x2*)rp = e0; *(u32x2*)(rp + ldc) = e1;
            }
    }
};
__device__ __forceinline__ float silu_f(float g) { return g * __builtin_amdgcn_rcpf(1.0f + __builtin_amdgcn_exp2f(-1.4426950408889634f * g)); }
struct EpiSwiGLU {
    static constexpr int PERM = 1;
    bf16_t* H;
    __device__ __forceinline__ void operator()(const f32x4 (&acc)[2][2][4][2], const Unit& u, int wr, int wc, int fr, int fq) const {
        const int row0 = u.pm * BM + wr * 64 + fr, col0 = u.pn * HALF + wc * 32 + 8 * fq;
#pragma unroll
        for (int ai = 0; ai < 2; ++ai)
#pragma unroll
            for (int m = 0; m < 4; ++m) { bf16_t* rowp = H + (size_t)(row0 + ai * HALF + m * 16) * DEXP + col0;
                const f32x4 g0 = acc[ai][0][m][0], g1 = acc[ai][0][m][1], u0 = acc[ai][1][m][0], u1 = acc[ai][1][m][1];
                u32x4 w; w.x = cvt_pk_bf16(silu_f(g0[0]) * u0[0], silu_f(g0[1]) * u0[1]); w.y = cvt_pk_bf16(silu_f(g0[2]) * u0[2], silu_f(g0[3]) * u0[3]);
                w.z = cvt_pk_bf16(silu_f(g1[0]) * u1[0], silu_f(g1[1]) * u1[1]); w.w = cvt_pk_bf16(silu_f(g1[2]) * u1[2], silu_f(g1[3]) * u1[3]);
                *(u32x4*)rowp = w; }
    }
};

template <class Epi, class Sched>
__device__ __forceinline__ void gemm_phase(LAS unsigned char* lds, const Sched& S, const Epi& E) {
    const int tid = tidx(), wid = __builtin_amdgcn_readfirstlane(tid >> 6), lane = tid & 63, wr = wid >> 2, wc = wid & 3, fr = lane & 15, fq = lane >> 4;
    const int K = S.K, nt = K / BK;
    int Rr[2], Cc[2]; unsigned voffB[2];
#pragma unroll
    for (int i = 0; i < 2; ++i) { int R, C; stage_rc(tid * 16 + i * 8192, R, C); Rr[i] = R; Cc[i] = C; const int Rb = Epi::PERM == 2 ? (64 * (R >> 5) + perm32(R & 31)) : Epi::PERM ? ((R & ~31) + perm32(R & 31)) : R; voffB[i] = (unsigned)(Rb * S.ldk() + C) * 2u; }
    const size_t kstep = (size_t)(BK * 2);
    const size_t hstep = (size_t)(Epi::PERM == 2 ? 32 : HALF) * S.ldk() * 2;
    const unsigned ldsw = (unsigned)wid * 1024u;
    const int aoff = lds_byte(wr * 64 + fr, fq * 8), boff = lds_byte(wc * 32 + fr, fq * 8);
#define PG8_SA(b, h) (((b) * 2 + (h)) * HTB)
#define PG8_SB(b, h) ((4 + (b) * 2 + (h)) * HTB)
#define PG8_STAGE(bufoff, gbase, voff) do { _Pragma("unroll") for (int _i = 0; _i < 2; ++_i) \
        __builtin_amdgcn_global_load_lds((const unsigned*)((const char*)(gbase) + (voff)[_i]), (LAS unsigned*)(lds + (bufoff) + ldsw + _i * 8192), 16, 0, 0); } while (0)
#define PG8_LDA(dst, b, h) do { _Pragma("unroll") for (int m = 0; m < 4; ++m) _Pragma("unroll") for (int k = 0; k < 2; ++k) dst[m][k] = *(const LAS bf16x8*)(lds + PG8_SA(b, h) + aoff + m * 2048 + k * 1024); } while (0)
#define PG8_LDB(dst, b, h) do { _Pragma("unroll") for (int n = 0; n < 2; ++n) _Pragma("unroll") for (int k = 0; k < 2; ++k) dst[n][k] = *(const LAS bf16x8*)(lds + PG8_SB(b, h) + boff + n * 2048 + k * 1024); } while (0)
#define PG8_MMA(ai, bj, At, Bt) do { __builtin_amdgcn_s_setprio(1); _Pragma("unroll") for (int m = 0; m < 4; ++m) _Pragma("unroll") for (int n = 0; n < 2; ++n) _Pragma("unroll") for (int k = 0; k < 2; ++k) \
        acc[ai][bj][m][n] = __builtin_amdgcn_mfma_f32_16x16x32_bf16(Bt[n][k], At[m][k], acc[ai][bj][m][n], 0, 0, 0); __builtin_amdgcn_s_setprio(0); } while (0)
#define PG8_WAIT_V(n) asm volatile("s_waitcnt vmcnt(" #n ")" ::: "memory")
#define PG8_WAIT_L(n) asm volatile("s_waitcnt lgkmcnt(" #n ")" ::: "memory")
#define PG8_BAR __builtin_amdgcn_s_barrier()
#define PG8_SCHED __builtin_amdgcn_sched_barrier(0)
    Unit cur, nxt; int ui = 0;
    if (!S.next(0, cur)) return;
    f32x4 acc[2][2][4][2];
#pragma unroll
    for (int a = 0; a < 2; ++a)
#pragma unroll
        for (int b = 0; b < 2; ++b)
#pragma unroll
            for (int m = 0; m < 4; ++m)
#pragma unroll
                for (int n = 0; n < 2; ++n) acc[a][b][m][n] = (f32x4){0.f, 0.f, 0.f, 0.f};
    bf16x8 At[4][2], B0[2][2], B1[2][2];
    unsigned offC[2][2], offN[2][2];
    S.a_offs(cur, Rr, Cc, offC);
    const char* cA = S.a_base(cur); const char* cB = S.b_base(cur);
    const int rot = S.rot() & (nt - 1), ntm = nt - 1;
    const size_t kstepA = S.kstep_a(), kstepB = S.kstep_b();
#define PG8_KOFF(t_) ((size_t)(((t_) + rot) & ntm) * kstepB)
#define PG8_KOFFA(t_) ((size_t)(((t_) + rot) & ntm) * kstepA)
    PG8_STAGE(PG8_SB(0, 0), cB + PG8_KOFF(0), voffB); PG8_STAGE(PG8_SA(0, 0), cA + PG8_KOFFA(0), offC[0]); PG8_STAGE(PG8_SB(0, 1), cB + hstep + PG8_KOFF(0), voffB); PG8_STAGE(PG8_SA(0, 1), cA + PG8_KOFFA(0), offC[1]);
    if (wr == 1) PG8_BAR;
    PG8_WAIT_V(4); PG8_BAR;
    PG8_STAGE(PG8_SB(1, 0), cB + PG8_KOFF(1), voffB); PG8_STAGE(PG8_SA(1, 0), cA + PG8_KOFFA(1), offC[0]); PG8_STAGE(PG8_SB(1, 1), cB + hstep + PG8_KOFF(1), voffB);
    PG8_WAIT_V(6); PG8_BAR;
    for (;;) {
        const bool has_next = S.next(ui + 1, nxt);
        const char* nA = has_next ? S.a_base(nxt) : cA; const char* nB = has_next ? S.b_base(nxt) : cB;
        if (has_next) S.a_offs(nxt, Rr, Cc, offN);
        else {
#pragma unroll
            for (int h = 0; h < 2; ++h)
#pragma unroll
                for (int i = 0; i < 2; ++i) offN[h][i] = offC[h][i]; }
        for (int t = 0; t < nt; t += 2) {
            const bool last = (t == nt - 2);
            const char* a1 = cA + PG8_KOFFA(t + 1);
            const char* a2 = (last ? nA : cA) + PG8_KOFFA(t + 2); const char* b2 = (last ? nB : cB) + PG8_KOFF(t + 2);
            const char* a3 = (last ? nA : cA) + PG8_KOFFA(t + 3); const char* b3 = (last ? nB : cB) + PG8_KOFF(t + 3);
            unsigned o2[2][2];
#pragma unroll
            for (int h = 0; h < 2; ++h)
#pragma unroll
                for (int i = 0; i < 2; ++i) o2[h][i] = last ? offN[h][i] : offC[h][i];
            PG8_LDB(B0, 0, 0); PG8_SCHED; PG8_LDA(At, 0, 0); PG8_STAGE(PG8_SA(1, 1), a1, offC[1]);
            PG8_WAIT_L(8); PG8_BAR; PG8_WAIT_L(0); PG8_MMA(0, 0, At, B0); PG8_BAR; PG8_SCHED;
            PG8_LDB(B1, 0, 1); PG8_STAGE(PG8_SB(0, 0), b2, voffB);
            PG8_BAR; PG8_WAIT_L(0); PG8_MMA(0, 1, At, B1); PG8_BAR;
            PG8_LDA(At, 0, 1); PG8_STAGE(PG8_SA(0, 0), a2, o2[0]);
            PG8_BAR; PG8_WAIT_L(0); PG8_MMA(1, 0, At, B0); PG8_BAR; PG8_SCHED;
            PG8_STAGE(PG8_SB(0, 1), b2 + hstep, voffB);
            PG8_WAIT_V(6); PG8_BAR; PG8_MMA(1, 1, At, B1); PG8_BAR;
            PG8_LDB(B0, 1, 0); PG8_SCHED; PG8_LDA(At, 1, 0); PG8_STAGE(PG8_SA(0, 1), a2, o2[1]);
            PG8_WAIT_L(8); PG8_BAR; PG8_WAIT_L(0); PG8_MMA(0, 0, At, B0); PG8_BAR; PG8_SCHED;
            PG8_LDB(B1, 1, 1); PG8_STAGE(PG8_SB(1, 0), b3, voffB);
            PG8_BAR; PG8_WAIT_L(0); PG8_MMA(0, 1, At, B1); PG8_BAR;
            PG8_LDA(At, 1, 1); PG8_STAGE(PG8_SA(1, 0), a3, o2[0]);
            PG8_BAR; PG8_WAIT_L(0); PG8_MMA(1, 0, At, B0); PG8_BAR; PG8_SCHED;
            PG8_STAGE(PG8_SB(1, 1), b3 + hstep, voffB);
            PG8_WAIT_V(6); PG8_BAR; PG8_MMA(1, 1, At, B1); PG8_BAR;
        }
        E(acc, cur, wr, wc, fr, fq);
        if (!has_next) break;
#pragma unroll
        for (int a = 0; a < 2; ++a)
#pragma unroll
            for (int b = 0; b < 2; ++b)
#pragma unroll
                for (int m = 0; m < 4; ++m)
#pragma unroll
                    for (int n = 0; n < 2; ++n) acc[a][b][m][n] = (f32x4){0.f, 0.f, 0.f, 0.f};
        cur = nxt; cA = nA; cB = nB; ++ui;
#pragma unroll
        for (int h = 0; h < 2; ++h)
#pragma unroll
            for (int i = 0; i < 2; ++i) offC[h][i] = offN[h][i];
    }
    PG8_WAIT_V(0);
    if (wr == 0) PG8_BAR;
    PG8_BAR;
#undef PG8_KOFF
#undef PG8_KOFFA
#undef PG8_SA
#undef PG8_SB
#undef PG8_STAGE
#undef PG8_LDA
#undef PG8_LDB
#undef PG8_MMA
#undef PG8_WAIT_V
#undef PG8_WAIT_L
#undef PG8_BAR
#undef PG8_SCHED
}
}

namespace fox {
constexpr int D = 128, LD = DM, NW = 8, QBLK = 32, KVBLK = 64, QB = NW * QBLK;
constexpr int SHM_V = KVBLK * D * 2, SHM_K = KVBLK * D * 2;
constexpr int OFF_WS = 2 * SHM_V + 2 * SHM_K, OFF_G = OFF_WS + NW * 64 * 4, GBUF = SEQ * 4, LDS_BYTES = OFF_G + 2 * GBUF;
constexpr float SCALE = 0.08838834764831845f, THR = 8.f;

#define KSWZ(row, colB) ((row) * 256 + ((colB) ^ (((row) & 7) << 4)))
#define SBAR() __builtin_amdgcn_sched_barrier(0)
__device__ __forceinline__ int v_st(int k, int c) { const int kk = (k & ~0xC) | ((k & 4) << 1) | ((k & 8) >> 1); return ((kk >> 3) * 4 + (c >> 5)) * 512 + ((kk & 7) * 32 + (c & 31)) * 2; }
__device__ __forceinline__ int v_rd_base(int lane) { return ((lane & 3) << 3) | (((lane >> 2) & 3) << 6) | (((lane >> 4) & 1) << 5) | (((lane >> 5) & 1) << 8); }
constexpr int v_rd_off(int d0, int ks, int half) { return d0 * 512 + ks * 4096 + half * 2048; }
__device__ __forceinline__ int crow(int r, int hi) { return (r & 3) + 8 * (r >> 2) + 4 * hi; }
__device__ __forceinline__ bf16x8 load8(const bf16_t* p) { return *reinterpret_cast<const bf16x8*>(p); }

__device__ __forceinline__ void mask_tile(f32x16& p0, f32x16& p1, int dq) {
    const float NEG = -__builtin_inff();
#pragma unroll
    for (int r = 0; r < 16; ++r) {
        const int c = (r & 3) + 8 * (r >> 2);
        if (dq - c < 0) p0[r] = NEG;
        if (dq - c - 32 < 0) p1[r] = NEG;
    }
}
__device__ __forceinline__ void bias_tile(f32x16& p0, f32x16& p1, const float* gl, int hi) {
#pragma unroll
    for (int j = 0; j < 4; ++j) {
        const f32x4 a = *(const f32x4*)(gl + 8 * j + 4 * hi), b = *(const f32x4*)(gl + 32 + 8 * j + 4 * hi);
#pragma unroll
        for (int i = 0; i < 4; ++i) { p0[4 * j + i] += a[i]; p1[4 * j + i] += b[i]; }
    }
}
__device__ __forceinline__ void partialSM(f32x16& p0, f32x16& p1, float& m_reg, float& mn, float& alpha) {
    float pmax = p0[0];
#pragma unroll
    for (int r = 1; r < 16; ++r) pmax = fmaxf(pmax, p0[r]);
#pragma unroll
    for (int r = 0; r < 16; ++r) pmax = fmaxf(pmax, p1[r]);
    { auto rr = __builtin_amdgcn_permlane32_swap(__float_as_uint(pmax), __float_as_uint(pmax), false, false);
      pmax = fmaxf(__uint_as_float(rr[0]), __uint_as_float(rr[1])); }
    constexpr float C2 = 1.4426950408889634f * SCALE;
    if (__builtin_expect(__all((pmax - m_reg) * SCALE <= THR), 1)) { mn = m_reg; alpha = 1.f; }
    else { mn = fmaxf(m_reg, pmax); alpha = __builtin_amdgcn_exp2f((m_reg - mn) * C2); m_reg = mn; }
    const float mnL = -mn * C2;
#pragma unroll
    for (int r = 0; r < 16; ++r) p0[r] = fmaf(p0[r], C2, mnL);
#pragma unroll
    for (int r = 0; r < 16; ++r) p1[r] = fmaf(p1[r], C2, mnL);
#pragma unroll
    for (int r = 0; r < 16; ++r) p0[r] = __builtin_amdgcn_exp2f(p0[r]);
}
__device__ __forceinline__ void finishSM(f32x16& p0, f32x16& p1, float alpha, float& l_reg, bf16x8& pa0, bf16x8& pa1, bf16x8& pa2, bf16x8& pa3) {
#pragma unroll
    for (int r = 0; r < 16; ++r) p1[r] = __builtin_amdgcn_exp2f(p1[r]);
    float ps = 0;
#pragma unroll
    for (int r = 0; r < 16; ++r) ps += p0[r];
#pragma unroll
    for (int r = 0; r < 16; ++r) ps += p1[r];
    { auto rr = __builtin_amdgcn_permlane32_swap(__float_as_uint(ps), __float_as_uint(ps), false, false);
      ps = __uint_as_float(rr[0]) + __uint_as_float(rr[1]); }
    l_reg = l_reg * alpha + ps;
#define PK4(P, B_, OUT) do { unsigned a0 = cvt_pk_bf16(P[B_+0], P[B_+1]), a1 = cvt_pk_bf16(P[B_+2], P[B_+3]);                          \
        unsigned b0 = cvt_pk_bf16(P[B_+4], P[B_+5]), b1 = cvt_pk_bf16(P[B_+6], P[B_+7]);                                             \
        auto r0 = __builtin_amdgcn_permlane32_swap(a0, b0, false, false); auto r1 = __builtin_amdgcn_permlane32_swap(a1, b1, false, false); \
        u32x4 w = {r0[0], r1[0], r0[1], r1[1]}; OUT = *reinterpret_cast<bf16x8*>(&w); } while (0)
    PK4(p0, 0, pa0); PK4(p0, 8, pa1); PK4(p1, 0, pa2); PK4(p1, 8, pa3);
#undef PK4
}
template <int KB>
__device__ __forceinline__ void qkt(f32x16& p0, f32x16& p1, const char* K_lds, int r32, int hi, const bf16x8* qr) {
    p0 = f32x16{}; p1 = f32x16{};
    const char* kb[4];
#pragma unroll
    for (int dd = 0; dd < 4; ++dd) kb[dd] = K_lds + KB * SHM_K + KSWZ(r32, (dd * 16 + hi * 8) * 2);
#pragma unroll
    for (int d0 = 0; d0 < 8; ++d0) { const char* a = kb[d0 & 3] + (d0 >> 2) * 128;
        bf16x8 b0 = *reinterpret_cast<const bf16x8*>(a);
        bf16x8 b1 = *reinterpret_cast<const bf16x8*>(a + 32 * 256);
        p0 = __builtin_amdgcn_mfma_f32_32x32x16_bf16(b0, qr[d0], p0, 0, 0, 0);
        p1 = __builtin_amdgcn_mfma_f32_32x32x16_bf16(b1, qr[d0], p1, 0, 0, 0); }
}
template <int VB>
__device__ __forceinline__ void pv_tile(f32x16* o, int vb0, bf16x8 pa0, bf16x8 pa1, bf16x8 pa2, bf16x8 pa3) {
#define TRRD(dst, off) asm volatile("ds_read_b64_tr_b16 %0, %1 offset:%2" : "=&v"(dst) : "v"(vb0), "i"(off) : "memory")
#define PV_D0(d0) do { s16x4 l0, l1, l2, l3, h0, h1, h2, h3; constexpr int b_ = VB * SHM_V + v_rd_off(d0, 0, 0);     \
        TRRD(l0, b_); TRRD(h0, b_ + 2048); TRRD(l1, b_ + 4096); TRRD(h1, b_ + 6144); TRRD(l2, b_ + 8192); TRRD(h2, b_ + 10240); TRRD(l3, b_ + 12288); TRRD(h3, b_ + 14336); \
        asm volatile("s_waitcnt lgkmcnt(0)" ::: "memory"); SBAR();                                                    \
        o[d0] = __builtin_amdgcn_mfma_f32_32x32x16_bf16(pa0, (bf16x8){l0[0], l0[1], l0[2], l0[3], h0[0], h0[1], h0[2], h0[3]}, o[d0], 0, 0, 0);   \
        o[d0] = __builtin_amdgcn_mfma_f32_32x32x16_bf16(pa1, (bf16x8){l1[0], l1[1], l1[2], l1[3], h1[0], h1[1], h1[2], h1[3]}, o[d0], 0, 0, 0);   \
        o[d0] = __builtin_amdgcn_mfma_f32_32x32x16_bf16(pa2, (bf16x8){l2[0], l2[1], l2[2], l2[3], h2[0], h2[1], h2[2], h2[3]}, o[d0], 0, 0, 0);   \
        o[d0] = __builtin_amdgcn_mfma_f32_32x32x16_bf16(pa3, (bf16x8){l3[0], l3[1], l3[2], l3[3], h3[0], h3[1], h3[2], h3[3]}, o[d0], 0, 0, 0); } while (0)
    PV_D0(0); PV_D0(1); PV_D0(2); PV_D0(3);
#undef PV_D0
#undef TRRD
}

struct BlockRef { const bf16_t* Q; const bf16_t* K; const bf16_t* V; const float* G; bf16_t* O; int P0; int jlo; };
struct Seam { bf16x8 qr[8]; bf16x8 st_v0, st_v1, st_k0, st_k1; int gsel; };
#define ROW(p, k0, rr) ((p) + (size_t)((k0) + (rr)) * LD + sc)
#define VMW() asm volatile("s_waitcnt vmcnt(0)" ::: "memory")
#define VMWN(n) asm volatile("s_waitcnt vmcnt(%0)" :: "i"(n) : "memory")
#define SLOAD_H(Kp, Vp, k0) do { S.st_v0 = load8(ROW(Vp, k0, sr)); S.st_v1 = load8(ROW(Vp, k0, 32 + sr));              \
                         S.st_k0 = load8(ROW(Kp, k0, sr)); S.st_k1 = load8(ROW(Kp, k0, 32 + sr)); } while (0)
#define SWRITE_HK(bf) do { *(bf16x8*)(K_lds + (bf) * SHM_K + kws) = S.st_k0; *(bf16x8*)(K_lds + (bf) * SHM_K + kws + 32 * 256) = S.st_k1; } while (0)
#define GDMA(Gp, gb) do { _Pragma("unroll") for (int k_ = 0; k_ < 2; ++k_) __builtin_amdgcn_global_load_lds((const unsigned*)((const char*)(Gp) + k_ * 8192 + tid * 16), \
                           (LAS unsigned*)((LAS char*)(lds_las) + OFF_G + (gb) * GBUF + k_ * 8192 + wid * 1024), 16, 0, 0); } while (0)
#define SWRITE_HV(bf) do { *(bf16x8*)(V_lds + (bf) * SHM_V + vst0) = S.st_v0; *(bf16x8*)(V_lds + (bf) * SHM_V + vst1) = S.st_v1; } while (0)
#define SWRITE_H(bf) do { SWRITE_HV(bf); SWRITE_HK(bf); } while (0)
__device__ __forceinline__ void fox_prime(const BlockRef& cur, char* lds, Seam& S) {
    const int tid = tidx(), wid = __builtin_amdgcn_readfirstlane(tid >> 6), lane = tid & 63, r32 = lane & 31, hi = lane >> 5;
    const int sr = tid >> 4, sc = (tid & 15) * 8, kws = KSWZ(sr, sc * 2); char* K_lds = lds + 2 * SHM_V; LAS char* lds_las = (LAS char*)lds;
    const int kb0 = cur.jlo * KVBLK;
    S.gsel = 0; GDMA(cur.G, 0);
#pragma unroll
    for (int d0 = 0; d0 < 8; ++d0) S.qr[d0] = load8(cur.Q + (size_t)(wid * QBLK + r32) * LD + d0 * 16 + hi * 8);
    SLOAD_H(cur.K, cur.V, kb0); VMW(); SWRITE_HK(0);
    __syncthreads();
}
__device__ __forceinline__ void fox_block(const BlockRef& cur, const BlockRef& nxt, char* lds, Seam& S) {
    const int tid = tidx(), wid = __builtin_amdgcn_readfirstlane(tid >> 6), lane = tid & 63, r32 = lane & 31, hi = lane >> 5;
    const int j_lo = cur.jlo;
    const int j_hi = (cur.P0 + QB - 1) / KVBLK + 1;
    const int NT = j_hi - j_lo;
    const int kbn = nxt.jlo * KVBLK;
    const int qlo = cur.P0 + wid * QBLK, qm = qlo + r32 - 4 * hi;
    char* V_lds = lds; char* K_lds = lds + 2 * SHM_V; LAS char* lds_las = (LAS char*)lds; const float* G_cur = (const float*)(lds + OFF_G + S.gsel * GBUF);
    float* ws = (float*)(lds + OFF_WS) + wid * 64; float* li_l = ws, * al_l = ws + 32;
    float m_reg = -1e30f, l_reg = 0; f32x16 o[4] = {};
    const int sr = tid >> 4, sc = (tid & 15) * 8, vst0 = v_st(sr, sc), vst1 = v_st(32 + sr, sc), kws = KSWZ(sr, sc * 2);
    const int vb0 = (int)(uintptr_t)V_lds + v_rd_base(lane);
    const bf16_t* Kh = cur.K; const bf16_t* Vh = cur.V;
#define RESC(a) do { if (__any((a) < 1.f)) { if (hi == 0) al_l[r32] = (a); asm volatile("s_waitcnt lgkmcnt(0)" ::: "memory");              \
                     for (int d_ = 0; d_ < 4; ++d_) for (int r = 0; r < 16; ++r) o[d_][r] *= al_l[crow(r, hi)]; } } while (0)
#define KBASE(t) ((j_lo + (t)) * KVBLK)
#define BIASMASK(P0_, P1_, t, KB) do { const int kb_ = KBASE(t); bias_tile(P0_, P1_, G_cur + kb_, hi); if (kb_ + KVBLK - 1 > qlo) mask_tile(P0_, P1_, qm - kb_); } while (0)
    constexpr int NQL = 8;
#define SEAM_K0() do { VMWN(NQL); SWRITE_HK(0); SBAR(); } while (0)
    f32x16 pA0, pA1, pB0, pB1; float mnA, mnB, alA, alB; bf16x8 pa0, pa1, pa2, pa3;
    SWRITE_HV(0); SBAR();
    if (NT > 1) { SLOAD_H(Kh, Vh, KBASE(1)); }
    SBAR(); qkt<0>(pA0, pA1, K_lds, r32, hi, S.qr);
    BIASMASK(pA0, pA1, 0, 0); partialSM(pA0, pA1, m_reg, mnA, alA);
    if (NT > 1) { VMW(); SWRITE_H(1); }
    __syncthreads();
#define HALF_STEP(PX0, PX1, mnX, alX, PY0, PY1, alY, t, KB, VB, SB) do {                                                      \
        SBAR(); qkt<KB>(PX0, PX1, K_lds, r32, hi, S.qr);                                                         \
        finishSM(PY0, PY1, alY, l_reg, pa0, pa1, pa2, pa3); SBAR();                                                           \
        if ((t) + 1 < NT) { SLOAD_H(Kh, Vh, KBASE((t) + 1)); SBAR(); }                                                    \
        pv_tile<VB>(o, vb0, pa0, pa1, pa2, pa3); BIASMASK(PX0, PX1, (t), KB); partialSM(PX0, PX1, m_reg, mnX, alX);          \
        __syncthreads();                                                                                                      \
        if ((t) + 1 < NT) { VMW(); SWRITE_H(SB); }                                                                            \
        RESC(alX); __syncthreads(); } while (0)
    for (int t = 1; t + 1 < NT; t += 2) {
        HALF_STEP(pB0, pB1, mnB, alB, pA0, pA1, alA, t, 1, 0, 0);
        HALF_STEP(pA0, pA1, mnA, alA, pB0, pB1, alB, t + 1, 0, 1, 1);
    }
    const bool even = (NT & 1) == 0;
    if (even) { SBAR(); qkt<1>(pB0, pB1, K_lds, r32, hi, S.qr); SBAR(); }
    GDMA(nxt.G, S.gsel ^ 1); SLOAD_H(nxt.K, nxt.V, kbn); SBAR();
#pragma unroll
    for (int d0 = 0; d0 < 8; ++d0) S.qr[d0] = load8(nxt.Q + (size_t)(wid * QBLK + r32) * LD + d0 * 16 + hi * 8);
    SBAR();
    finishSM(pA0, pA1, alA, l_reg, pa0, pa1, pa2, pa3); SBAR();
    pv_tile<0>(o, vb0, pa0, pa1, pa2, pa3);
    if (even) { BIASMASK(pB0, pB1, NT - 1, 1); partialSM(pB0, pB1, m_reg, mnB, alB); __syncthreads(); RESC(alB);
        finishSM(pB0, pB1, alB, l_reg, pa0, pa1, pa2, pa3); SBAR(); pv_tile<1>(o, vb0, pa0, pa1, pa2, pa3); }
    SBAR(); SEAM_K0();
    if (hi == 0) li_l[r32] = l_reg; asm volatile("s_waitcnt lgkmcnt(0)" ::: "memory");
    float rli[16];
#pragma unroll
    for (int r = 0; r < 16; ++r) rli[r] = __builtin_amdgcn_rcpf(li_l[crow(r, hi)]);
    int lane2 = lane; asm volatile("" : "+v"(lane2));
    const int r32b = lane2 & 31, hib = lane2 >> 5;
    bf16_t* Ow = cur.O + (size_t)(wid * QBLK) * LD + r32b;
#pragma unroll
    for (int r = 0; r < 16; ++r) { const int orow = crow(r, hib);
#pragma unroll
        for (int d0 = 0; d0 < 4; ++d0) { const float v = o[d0][r] * rli[r];
            const float vn = __shfl_xor(v, 1);
            if ((r32b & 1) == 0) *(unsigned*)(Ow + (size_t)orow * LD + d0 * 32) = cvt_pk_bf16(v, vn); } }
    S.gsel ^= 1;
    __syncthreads();
#undef RESC
#undef KBASE
#undef BIASMASK
#undef SEAM_K0
#undef HALF_STEP
}
#undef ROW
#undef VMW
#undef VMWN
#undef SLOAD_H
#undef SWRITE_HK
#undef GDMA
#undef SWRITE_HV
#undef SWRITE_H
#undef KSWZ
#undef SBAR
}

__device__ __forceinline__ int gwave() { return blockIdx.x * NWAVES + (tidx() >> 6); }
__device__ __forceinline__ int nwave() { return NBLK * NWAVES; }

__device__ __forceinline__ void cvt_wtile(LAS unsigned char* tl, const float* src, int ld, int Nvalid, bf16_t* dst, int Kdst, int k0, int n0, int drow0, int lane) {
    const int n = n0 + lane;
    float v[64];
    if (n < Nvalid) {
        const float* sp = src + (size_t)k0 * ld + n;
#pragma unroll
        for (int k = 0; k < 64; ++k) v[k] = __builtin_nontemporal_load(sp + (size_t)k * ld);
    } else {
#pragma unroll
        for (int k = 0; k < 64; ++k) v[k] = 0.f;
    }
    LAS unsigned char* wl = tl + (tidx() >> 6) * 9216;
#pragma unroll
    for (int q = 0; q < 8; ++q) {
        u32x4 w; w.x = cvt_pk_bf16(v[8 * q], v[8 * q + 1]); w.y = cvt_pk_bf16(v[8 * q + 2], v[8 * q + 3]); w.z = cvt_pk_bf16(v[8 * q + 4], v[8 * q + 5]); w.w = cvt_pk_bf16(v[8 * q + 6], v[8 * q + 7]);
        *(LAS u32x4*)(wl + lane * 144 + q * 16) = w;
    }
    const int rr = lane >> 3, ch = lane & 7;
#pragma unroll
    for (int it = 0; it < 8; ++it) {
        const u32x4 w = *(LAS u32x4*)(wl + (it * 8 + rr) * 144 + ch * 16);
        *(u32x4*)(dst + (size_t)(drow0 + it * 8 + rr) * Kdst + k0 + ch * 8) = w;
    }
}
__device__ __forceinline__ void cvt_matrix_tile(LAS float* tl, const float* src, int ld, int K, int Nvalid, bf16_t* dst, int mode, int tile, int ntn) {
    const int kt = tile / ntn, nt_ = tile - kt * ntn, n0 = nt_ * 64;
    int drow0 = n0;
    if (mode == 1) drow0 = (n0 >> 7) * 256 + (n0 & 127);
    else if (mode == 2) drow0 = (n0 >> 7) * 256 + 128 + (n0 & 127);
    cvt_wtile((LAS unsigned char*)tl, src, ld, Nvalid, dst, K, kt * 64, n0, drow0, tidx() & 63);
}
struct CvtRef { const float* sp; size_t ld; bf16_t* dp; int Kdst; };
__device__ __forceinline__ CvtRef cvt_moe_ref(const Params& p, int L, int w, int lane) {
    bf16_t* Wgu = (bf16_t*)(p.ws + OFF_WGU + (size_t)L * MOE_LSTRIDE); bf16_t* Wd = (bf16_t*)(p.ws + OFF_WD + (size_t)L * MOE_LSTRIDE);
    int e, which, tile;
    if (w < 65 * 512) { e = w >> 9; which = (w >> 8) & 1; tile = w & 255; } else { const int v = w - 65 * 512; e = v >> 8; which = 2; tile = v & 255; }
    CvtRef c;
    if (which < 2) {
        const float* src = which == 0 ? (e < 64 ? p.w_gate + ((size_t)L * 64 + e) * DM * DEXP : p.sh_gate + (size_t)L * DM * DEXP) : (e < 64 ? p.w_up + ((size_t)L * 64 + e) * DM * DEXP : p.sh_up + (size_t)L * DM * DEXP);
        const int kt = tile >> 3, n0 = (tile & 7) * 64, drow0 = (n0 >> 7) * 256 + which * 128 + (n0 & 127);
        c.sp = src + (size_t)kt * 64 * DEXP + n0 + lane; c.ld = DEXP; c.Kdst = DM; c.dp = Wgu + (size_t)e * 1024 * DM + (size_t)drow0 * DM + kt * 64;
    } else {
        const float* src = e < 64 ? p.w_down + ((size_t)L * 64 + e) * DEXP * DM : p.sh_down + (size_t)L * DEXP * DM;
        const int kt = tile >> 5, n0 = (tile & 31) * 64;
        c.sp = src + (size_t)kt * 64 * DM + n0 + lane; c.ld = DM; c.Kdst = DEXP; c.dp = Wd + (size_t)e * DM * DEXP + (size_t)n0 * DEXP + kt * 64;
    }
    return c;
}
__device__ __forceinline__ void cvt_ld(const CvtRef& c, float (&v)[64]) {
#pragma unroll
    for (int k = 0; k < 64; ++k) v[k] = __builtin_nontemporal_load(c.sp + (size_t)k * c.ld);
}
__device__ __forceinline__ void cvt_st(const CvtRef& c, const float (&v)[64], LAS unsigned char* wl, int lane) {
#pragma unroll
    for (int q = 0; q < 8; ++q) {
        u32x4 w; w.x = cvt_pk_bf16(v[8 * q], v[8 * q + 1]); w.y = cvt_pk_bf16(v[8 * q + 2], v[8 * q + 3]); w.z = cvt_pk_bf16(v[8 * q + 4], v[8 * q + 5]); w.w = cvt_pk_bf16(v[8 * q + 6], v[8 * q + 7]);
        *(LAS u32x4*)(wl + lane * 144 + q * 16) = w;
    }
    const int rr = lane >> 3, ch = lane & 7;
#pragma unroll
    for (int it = 0; it < 8; ++it) {
        const u32x4 w = *(LAS u32x4*)(wl + (it * 8 + rr) * 144 + ch * 16);
        *(u32x4*)(c.dp + (size_t)(it * 8 + rr) * c.Kdst + ch * 8) = w;
    }
}
__device__ __forceinline__ void cvt_moe_run(const Params& p, LAS unsigned char* wl, int L, int w, const int nw, const int total, const int lane) {
    if (w >= total) return;
    float va[64], vb[64];
    CvtRef ca = cvt_moe_ref(p, L, w, lane), cb = ca;
    cvt_ld(ca, va);
    for (;;) {
        const bool hb = w + nw < total;
        cb = cvt_moe_ref(p, L, hb ? w + nw : w, lane); cvt_ld(cb, vb);
        cvt_st(ca, va, wl, lane);
        if (!hb) break;
        w += nw;
        const bool ha = w + nw < total;
        ca = cvt_moe_ref(p, L, ha ? w + nw : w, lane); cvt_ld(ca, va);
        cvt_st(cb, vb, wl, lane);
        if (!ha) break;
        w += nw;
    }
}
__device__ __forceinline__ void cvt_ld4(const CvtRef& c, int lane, f32x4 (&v)[16]) {
    const float* sp = c.sp + (size_t)(lane >> 4) * c.ld + 4 * (lane & 15);
#pragma unroll
    for (int i = 0; i < 16; ++i) v[i] = __builtin_nontemporal_load((const f32x4*)(sp + (size_t)(4 * i) * c.ld));
}
__device__ __forceinline__ void cvt_st4(const CvtRef& c, const f32x4 (&v)[16], LAS unsigned char* wl, int lane) {
    const int cq = lane & 15, r = lane >> 4;
    LAS unsigned char* wp = wl + (4 * cq + (r & 1)) * 136 + (r >> 1) * 4;
#pragma unroll
    for (int i = 0; i < 16; ++i)
#pragma unroll
        for (int jp = 0; jp < 2; ++jp) {
            const auto sw = __builtin_amdgcn_permlane16_swap(__float_as_uint(v[i][2 * jp]), __float_as_uint(v[i][2 * jp + 1]), false, false);
            *(LAS unsigned*)(wp + jp * 272 + i * 8) = cvt_pk_bf16(__uint_as_float(sw[0]), __uint_as_float(sw[1]));
        }
    const int rr = lane >> 3, ch = lane & 7;
#pragma unroll
    for (int it = 0; it < 8; ++it) {
        const u32x2 w0 = *(LAS u32x2*)(wl + (it * 8 + rr) * 136 + ch * 16), w1 = *(LAS u32x2*)(wl + (it * 8 + rr) * 136 + ch * 16 + 8);
        *(u32x4*)(c.dp + (size_t)(it * 8 + rr) * c.Kdst + ch * 8) = (u32x4){w0.x, w0.y, w1.x, w1.y};
    }
}
__device__ __forceinline__ void cvt_moe_run4(const Params& p, LAS unsigned char* wl, int L, int w, const int nw, const int total, const int lane) {
    if (w >= total) return;
    f32x4 va[16], vb[16];
    CvtRef ca = cvt_moe_ref(p, L, w, 0), cb = ca;
    cvt_ld4(ca, lane, va);
    for (;;) {
        const bool hb = w + nw < total;
        cb = cvt_moe_ref(p, L, hb ? w + nw : w, 0); cvt_ld4(cb, lane, vb);
        cvt_st4(ca, va, wl, lane);
        if (!hb) break;
        w += nw;
        const bool ha = w + nw < total;
        ca = cvt_moe_ref(p, L, ha ? w + nw : w, 0); cvt_ld4(ca, lane, va);
        cvt_st4(cb, vb, wl, lane);
        if (!ha) break;
        w += nw;
    }
}
__device__ __forceinline__ void phase_cvt_moe(const Params& p, LAS unsigned char* lds, int L, int total) {
    const int tid = tidx();
    cvt_moe_run(p, lds + (tid >> 6) * 9216, L, gwave(), nwave(), total, tid & 63);
}
__device__ __forceinline__ void phase_cvt_fox(const Params& p, LAS unsigned char* lds) {
    LAS float* tl = (LAS float*)lds;
    bf16_t* WinT = (bf16_t*)(p.ws + OFF_WA + WA_WINT); bf16_t* WoutT = (bf16_t*)(p.ws + OFF_WA + WA_WOUTT);
    const int t_in = 32 * 96, t_out = 32 * 32;
    for (int w = gwave(); w < t_in + t_out; w += nwave()) {
        if (w < t_in) cvt_matrix_tile(tl, p.a_w_in, 6160, DM, 6144, WinT, 0, w, 96);
        else cvt_matrix_tile(tl, p.a_w_out, DM, DM, DM, WoutT, 0, w - t_in, 32);
    }
    bf16_t* xb = (bf16_t*)(p.ws + OFF_XB);
    const size_t n8 = (size_t)NTOK * DM / 8, stride = (size_t)NBLK * NTHREADS;
    for (size_t i = (size_t)blockIdx.x * NTHREADS + tidx(); i < n8; i += 4 * stride) {
        f32x4 a[4], b[4];
#pragma unroll
        for (int u = 0; u < 4; ++u) { const size_t j = i + u * stride; if (j < n8) { a[u] = __builtin_nontemporal_load((const f32x4*)(p.x + j * 8)); b[u] = __builtin_nontemporal_load((const f32x4*)(p.x + j * 8 + 4)); } }
#pragma unroll
        for (int u = 0; u < 4; ++u) { const size_t j = i + u * stride; if (j < n8) *(bf16x8*)(xb + j * 8) = pack8(a[u], b[u]); }
    }
}
__device__ __forceinline__ void phase_cvt_dsa(const Params& p, LAS unsigned char* lds) {
    LAS float* tl = (LAS float*)lds;
    bf16_t* WbinT = (bf16_t*)(p.ws + OFF_WA + WA_WBINT); bf16_t* Wq2T = (bf16_t*)(p.ws + OFF_WA + WA_WQ2T); bf16_t* WoutTB = (bf16_t*)(p.ws + OFF_WA + WA_WOUTTB); bf16_t* WuvBD = (bf16_t*)(p.ws + OFF_WA + WA_WUVOT);
    const int t0 = 32 * 16, t1 = 8 * 16, t2 = 32 * 32, t3 = 16 * 8;
    for (int w = gwave(); w < t0 + t1 + t2 + t3; w += nwave()) {
        if (w < t0) cvt_matrix_tile(tl, p.b_w_in, BW, DM, BW, WbinT, 0, w, 16);
        else if (w < t0 + t1) cvt_matrix_tile(tl, p.b_w_iq, 1024, QLAT, 1024, Wq2T + (size_t)4096 * QLAT, 0, w - t0, 16);
        else if (w < t0 + t1 + t2) cvt_matrix_tile(tl, p.b_w_out, DM, DM, DM, WoutTB, 0, w - t0 - t1, 32);
        else { const int v = w - t0 - t1 - t2, h = v >> 3, kt = (v >> 1) & 3, nt_ = v & 1;
            cvt_wtile((LAS unsigned char*)tl, p.b_w_uv + (size_t)h * KVLAT * 128, 128, 128, WuvBD + (size_t)(h * 128) * 4096 + h * 256, 4096, kt * 64, nt_ * 64, nt_ * 64, tidx() & 63); }
    }
    for (int i = blockIdx.x * NTHREADS + tidx(); i < 2048 * 32; i += NBLK * NTHREADS) { const int n = i >> 5, ch = i & 31, h = n >> 7;
        *(u32x4*)(WuvBD + (size_t)n * 4096 + (h ^ 1) * 256 + ch * 8) = (u32x4){0u, 0u, 0u, 0u}; }
}
__device__ __forceinline__ bf16x8 ld8_f32(const float* p) { return pack8(*(const f32x4*)p, *(const f32x4*)(p + 4)); }
__device__ __forceinline__ void phase_wprep(const Params& p) {
    const int lane = tidx() & 63, fr = lane & 15, fq = lane >> 4;
    bf16_t* Wq2T = (bf16_t*)(p.ws + OFF_WA + WA_WQ2T);
    const int nq = 16 * 16 * 32;
    for (int w = gwave(); w < nq; w += nwave()) {
        f32x4 acc = (f32x4){0.f, 0.f, 0.f, 0.f};
        {
            const int h = w >> 9, ct = (w >> 5) & 15, lt = w & 31, c0 = ct * 16, l0 = lt * 16;
#pragma unroll
            for (int ks = 0; ks < 4; ++ks) {
                const bf16x8 a = ld8_f32(p.b_w_uq + (size_t)(l0 + fr) * 2048 + h * 128 + ks * 32 + fq * 8);
 bf16x8 b = ld8_f32(p.b_w_uk + ((size_t)h * 256 + c0 + fr) * 128 + ks * 32 + fq * 8);
                asm volatile("s_nop 7" : "+v"(b));
                acc = __builtin_amdgcn_mfma_f32_16x16x32_bf16(a, b, acc, 0, 0, 0);
            }
            mfma_fence(acc);
            u32x2 o; o.x = cvt_pk_bf16(acc[0], acc[1]); o.y = cvt_pk_bf16(acc[2], acc[3]);
            *(u32x2*)(Wq2T + (size_t)(h * 256 + c0 + fr) * QLAT + l0 + 4 * fq) = o;
        }
    }
}

__device__ __forceinline__ void phase_cvt_router(const Params& p) {
    bf16_t* rwt = (bf16_t*)(p.ws + OFF_ROUTE + RWT_BYTE_OFF);
    for (int i = blockIdx.x * NTHREADS + tidx(); i < 2 * DM * 16; i += NBLK * NTHREADS) {
        const int L = i >> 15, d = (i >> 4) & 2047, e4 = (i & 15) * 4;
        const f32x4 w = *(const f32x4*)(p.router_w + ((size_t)L * DM + d) * NEXP + e4);
#pragma unroll
        for (int k = 0; k < 4; ++k) { const unsigned h = cvt_pk_bf16(w[k], 0.f) & 0xffffu; const float lo = w[k] - __uint_as_float(h << 16);
            rwt[((size_t)L * 128 + e4 + k) * DM + d] = (bf16_t)h; rwt[((size_t)L * 128 + 64 + e4 + k) * DM + d] = (bf16_t)(cvt_pk_bf16(lo, 0.f) & 0xffffu); }
    }
}
__device__ __forceinline__ void phase_cvt_fgate(const Params& p) {
    bf16_t* fwt = (bf16_t*)(p.ws + OFF_ROUTE + FWT_BYTE_OFF);
    for (int i = blockIdx.x * NTHREADS + tidx(); i < DM * 16; i += NBLK * NTHREADS) {
        const int d = i >> 4, h = i & 15;
        const float w = p.a_w_in[(size_t)d * 6160 + 6144 + h];
        const unsigned hb = cvt_pk_bf16(w, 0.f) & 0xffffu; const float lo = w - __uint_as_float(hb << 16);
        fwt[(size_t)h * DM + d] = (bf16_t)hb; fwt[(size_t)(16 + h) * DM + d] = (bf16_t)(cvt_pk_bf16(lo, 0.f) & 0xffffu);
    }
}
__device__ __forceinline__ void phase_fgate(const Params& p) {
    const int tid = tidx(), wid = tid >> 6, lane = tid & 63, fr = lane & 15, fq = lane >> 4;
    float* logf = (float*)(p.ws + OFF_BIG + BG_LOGF); const bf16_t* fwt = (const bf16_t*)(p.ws + OFF_ROUTE + FWT_BYTE_OFF);
    if (wid >= 4) return;
    for (int g = blockIdx.x; g < NTOK / 64; g += NBLK) {
        const int tok0 = g * 64 + wid * 16;
        const float* xa = p.x + (size_t)(tok0 + fr) * DM + fq * 8;
        const bf16_t* bh = fwt + (size_t)fr * DM + fq * 8;
        f32x4 acc = (f32x4){0.f, 0.f, 0.f, 0.f};
#pragma unroll 4
        for (int ks = 0; ks < 64; ++ks) {
            const f32x4 x0 = *(const f32x4*)(xa + ks * 32), x1 = *(const f32x4*)(xa + ks * 32 + 4);
            u32x4 hw = {cvt_pk_bf16(x0[0], x0[1]), cvt_pk_bf16(x0[2], x0[3]), cvt_pk_bf16(x1[0], x1[1]), cvt_pk_bf16(x1[2], x1[3])};
            f32x4 r0, r1;
#pragma unroll
            for (int i = 0; i < 4; ++i) { r0[i] = x0[i] - __uint_as_float(i & 1 ? hw[i >> 1] & 0xffff0000u : hw[i >> 1] << 16); r1[i] = x1[i] - __uint_as_float(i & 1 ? hw[2 + (i >> 1)] & 0xffff0000u : hw[2 + (i >> 1)] << 16); }
            bf16x8 ah = *reinterpret_cast<bf16x8*>(&hw), al = pack8(r0, r1);
            asm volatile("s_nop 1" : "+v"(ah), "+v"(al));
            const bf16x8 wh = *(const bf16x8*)(bh + ks * 32), wl = *(const bf16x8*)(bh + (size_t)16 * DM + ks * 32);
            acc = __builtin_amdgcn_mfma_f32_16x16x32_bf16(ah, wh, acc, 0, 0, 0);
            acc = __builtin_amdgcn_mfma_f32_16x16x32_bf16(ah, wl, acc, 0, 0, 0);
            acc = __builtin_amdgcn_mfma_f32_16x16x32_bf16(al, wh, acc, 0, 0, 0);
        }
        const float bf = p.a_b_f[fr];
#pragma unroll
        for (int i = 0; i < 4; ++i) { const float z = acc[i] + bf; logf[(size_t)(tok0 + 4 * fq + i) * 16 + fr] = fminf(z, 0.f) - log1pf(expf(-fabsf(z))); }
    }
}
__device__ __forceinline__ void phase_scan(const Params& p, LAS unsigned char* lds) {
    const int tid = tidx(), lane = tid & 63, wid = tid >> 6;
    const float* logf = (const float*)(p.ws + OFF_BIG + BG_LOGF); float* G = (float*)(p.ws + OFF_BIG + BG_G);
    LAS float* wt = (LAS float*)lds;
    for (int bh = blockIdx.x; bh < NBATCH * NHEAD; bh += NBLK) {
        const int b = bh >> 4, h = bh & 15, s0 = tid * 8;
        float v[8]; float tot = 0.f;
#pragma unroll
        for (int j = 0; j < 8; ++j) { v[j] = logf[((size_t)b * SEQ + s0 + j) * 16 + h]; tot += v[j]; }
        float inc = tot;
#pragma unroll
        for (int o = 1; o < 64; o <<= 1) { const float y = __shfl_up(inc, o); if (lane >= o) inc += y; }
        __syncthreads();
        if (lane == 63) wt[wid] = inc;
        __syncthreads();
        float run = inc - tot;
#pragma unroll
        for (int k = 0; k < 8; ++k) run += k < wid ? wt[k] : 0.f;
        f32x4 o0, o1;
#pragma unroll
        for (int j = 0; j < 4; ++j) { run += v[j]; o0[j] = -run * 11.313708498984761f; }
#pragma unroll
        for (int j = 0; j < 4; ++j) { run += v[4 + j]; o1[j] = -run * 11.313708498984761f; }
        *(f32x4*)(G + (size_t)bh * SEQ + s0) = o0; *(f32x4*)(G + (size_t)bh * SEQ + s0 + 4) = o1;
    }
}
__device__ __forceinline__ int fox_jlo(const Params& p, int item, int pass) {
    const int bh = item >> 3, x = item & 7, qb = pass ? 15 - x : x;
    const float* G = (const float*)(p.ws + OFF_BIG + BG_G) + (size_t)bh * SEQ; const float* NRM = (const float*)(p.ws + OFF_BIG + BG_NRM);
    const int J = tidx() & 63;
    const float* nq = NRM + (size_t)bh * 128, * nk = NRM + (size_t)(64 + bh) * 128;
    float q2 = 0.f, k2 = 0.f;
#pragma unroll
    for (int i = 0; i < 4; ++i) { q2 = fmaxf(q2, nq[(4 * qb + i) * 2] + nq[(4 * qb + i) * 2 + 1]); k2 = fmaxf(k2, nk[(4 * qb + i) * 2] + nk[(4 * qb + i) * 2 + 1]); }
    const float qn = sqrtf(q2), kI = sqrtf(k2), kn = sqrtf(nk[J * 2] + nk[J * 2 + 1]);
    const float Ft0 = -G[qb * 256] * fox::SCALE, Fl = -G[64 * J + 63] * fox::SCALE;
    const float ub = fox::SCALE * qn * (kn + kI) * 1.01f + (Ft0 - Fl);
    const bool skip = (ub < -40.0f) && (64 * J + 63 < qb * 256);
    const unsigned long long keep = __ballot(!skip);
    return keep ? (int)__builtin_ctzll(keep) : 0;
}
__device__ __forceinline__ fox::BlockRef fox_ref(const Params& p, int item, int pass, int jlo) {
    const int bh = item >> 3, x = item & 7, b = bh >> 4, h = bh & 15, qb = pass ? 15 - x : x;
    const bf16_t* Q = (const bf16_t*)(p.ws + OFF_BIG + BG_Q); const bf16_t* K = (const bf16_t*)(p.ws + OFF_BIG + BG_K); const bf16_t* V = (const bf16_t*)(p.ws + OFF_BIG + BG_V);
    bf16_t* O = (bf16_t*)(p.ws + OFF_BIG + BG_O); const float* G = (const float*)(p.ws + OFF_BIG + BG_G);
    fox::BlockRef r;
    const size_t hb = (size_t)b * SEQ * DM + (size_t)h * HDIM;
    r.Q = Q + hb + (size_t)qb * 256 * DM; r.O = O + hb + (size_t)qb * 256 * DM; r.K = K + hb; r.V = V + hb; r.G = G + (size_t)bh * SEQ; r.P0 = qb * 256; r.jlo = jlo;
    return r;
}
__device__ __forceinline__ void phase_fox_attn(const Params& p, LAS unsigned char* lds_) {
    char* lds = (char*)lds_;
    const int total = NBATCH * NHEAD * 8, stride = NBLK;
    int L = blockIdx.x; if (L >= total) return;
    LAS int* jl = (LAS int*)(lds_ + fox::LDS_BYTES);
    { int slot = 0;
      for (int it = L; it < total && slot < 16; it += stride, slot += 2) { const int j0 = fox_jlo(p, it, 0), j1 = fox_jlo(p, it, 1); if (tidx() == 0) { jl[slot] = j0; jl[slot + 1] = j1; } }
      __syncthreads(); }
    int pass = 0, slot = 0;
    fox::BlockRef cur = fox_ref(p, L, 0, __builtin_amdgcn_readfirstlane(jl[0]));
    fox::Seam S;
    fox::fox_prime(cur, lds, S);
    for (;;) {
        const bool more_pass = pass == 0, more_item = L + stride < total, last = !more_pass && !more_item;
        int passn = pass + 1, Ln = L;
        if (!more_pass) { passn = 0; Ln = more_item ? L + stride : L; }
        const int slotn = last ? slot : slot + 1;
        const fox::BlockRef nxt = last ? cur : fox_ref(p, Ln, passn, __builtin_amdgcn_readfirstlane(jl[slotn & 15]));
        fox::fox_block(cur, nxt, lds, S);
        if (last) break;
        cur = nxt; pass = passn; L = Ln; slot = slotn;
    }
}

__device__ __forceinline__ void ln_row_store(float (&v)[32], const float* g, const float* bt, float* yf, bf16_t* yhi, bf16_t* ylo, int lane) {
    float s = 0.f;
#pragma unroll
    for (int i = 0; i < 32; ++i) s += v[i];
    const float mean = wave_sum(s) * (1.0f / DM);
    float q = 0.f;
#pragma unroll
    for (int i = 0; i < 32; ++i) { const float d = v[i] - mean; q += d * d; }
    const float var = wave_sum(q) * (1.0f / DM);
    const float rstd = 1.0f / sqrtf(var + LN_EPS);
#pragma unroll
    for (int j = 0; j < 4; ++j) {
        const int c = j * 512 + lane * 8;
        const f32x4 g0 = *(const f32x4*)(g + c), g1 = *(const f32x4*)(g + c + 4), b0 = *(const f32x4*)(bt + c), b1 = *(const f32x4*)(bt + c + 4);
        f32x4 y0, y1;
#pragma unroll
        for (int i = 0; i < 4; ++i) { y0[i] = (v[j * 8 + i] - mean) * rstd * g0[i] + b0[i]; y1[i] = (v[j * 8 + 4 + i] - mean) * rstd * g1[i] + b1[i]; }
        if (yf) { *(f32x4*)(yf + c) = y0; *(f32x4*)(yf + c + 4) = y1; }
        else {
            const u32x4 hw = {cvt_pk_bf16(y0[0], y0[1]), cvt_pk_bf16(y0[2], y0[3]), cvt_pk_bf16(y1[0], y1[1]), cvt_pk_bf16(y1[2], y1[3])};
            f32x4 r0, r1;
#pragma unroll
            for (int i = 0; i < 4; ++i) { r0[i] = y0[i] - __uint_as_float(i & 1 ? hw[i >> 1] & 0xffff0000u : hw[i >> 1] << 16); r1[i] = y1[i] - __uint_as_float(i & 1 ? hw[2 + (i >> 1)] & 0xffff0000u : hw[2 + (i >> 1)] << 16); }
            *(u32x4*)(yhi + c) = hw; *(bf16x8*)(ylo + c) = pack8(r0, r1);
        }
    }
}
__device__ __forceinline__ void ld_hilo8(const bf16_t* hi, const bf16_t* lo, float (&o)[8]) {
    const u32x4 h = *(const u32x4*)hi, l = *(const u32x4*)lo;
#pragma unroll
    for (int i = 0; i < 4; ++i) { o[2 * i] = __uint_as_float(h[i] << 16) + __uint_as_float(l[i] << 16); o[2 * i + 1] = __uint_as_float(h[i] & 0xffff0000u) + __uint_as_float(l[i] & 0xffff0000u); }
}
struct RawRow { u32x4 a[8]; u32x4 m[4]; };
__device__ __forceinline__ void router_ln_load(RawRow& r, int t, const bf16_t* xhi, const bf16_t* xlo, const float* xin, const bf16_t* mres, int lane) {
#pragma unroll
    for (int j = 0; j < 4; ++j) {
        const size_t o = (size_t)t * DM + j * 512 + lane * 8;
        if (xin) { r.a[2 * j] = *(const u32x4*)(xin + o); r.a[2 * j + 1] = *(const u32x4*)(xin + o + 4); }
        else { r.a[2 * j] = *(const u32x4*)(xhi + o); r.a[2 * j + 1] = *(const u32x4*)(xlo + o); }
        r.m[j] = *(const u32x4*)(mres + o);
    }
}
__device__ __forceinline__ void router_ln_finish(const RawRow& r, int t, bf16_t* xhi, bf16_t* xlo, bool f32in, const float* lng, const float* lnb, int lane) {
    float v[32];
#pragma unroll
    for (int j = 0; j < 4; ++j) {
        float a[8];
        if (f32in) {
#pragma unroll
            for (int i = 0; i < 4; ++i) { a[i] = __uint_as_float(r.a[2 * j][i]); a[4 + i] = __uint_as_float(r.a[2 * j + 1][i]); }
        } else {
            const u32x4 h = r.a[2 * j], l = r.a[2 * j + 1];
#pragma unroll
            for (int i = 0; i < 4; ++i) { a[2 * i] = __uint_as_float(h[i] << 16) + __uint_as_float(l[i] << 16); a[2 * i + 1] = __uint_as_float(h[i] & 0xffff0000u) + __uint_as_float(l[i] & 0xffff0000u); }
        }
        const u32x4 mw = r.m[j];
#pragma unroll
        for (int i = 0; i < 8; ++i) v[j * 8 + i] = ALPHA * a[i] + __uint_as_float(i & 1 ? mw[i >> 1] & 0xffff0000u : mw[i >> 1] << 16);
    }
    ln_row_store(v, lng, lnb, nullptr, xhi + (size_t)t * DM, xlo + (size_t)t * DM, lane);
}
#ifndef ROUTER_SGT
#define ROUTER_SGT 32
#endif
__device__ __forceinline__ void phase_router(const Params& p, LAS unsigned char* lds, bf16_t* xhi, bf16_t* xlo, const bf16_t* rwt, const float* rb,
                                             const float* xin, const bf16_t* mres, const float* lng, const float* lnb) {
    constexpr int SGT = ROUTER_SGT, MT = SGT / 16, RPW = SGT / 4, NLN = 64 / SGT, SPW = SGT / 4;
    LAS float* lgp = (LAS float*)lds;
    LAS float* sbl = lgp + 4 * SGT * 64;
    LAS unsigned char* flag = (LAS unsigned char*)(sbl + 4096);
    LAS int* sel_l = (LAS int*)(flag + 4096);
    LAS unsigned long long* Me = (LAS unsigned long long*)(sel_l + 512);
    unsigned* ctrl = (unsigned*)(p.ws + OFF_CTRL); int* rt = (int*)(p.ws + OFF_ROUTE);
    const int tid = tidx(), lane = tid & 63, wid = __builtin_amdgcn_readfirstlane(tid >> 6);
    const bool f32in = xin != nullptr;
    for (int g = blockIdx.x; g < NTOK / 64; g += NBLK) {
        const int tok0 = g * 64;
        __syncthreads();
        RawRow ra, rb_;
        if (wid < 4) router_ln_load(ra, tok0 + RPW * wid, xhi, xlo, xin, mres, lane);
#pragma unroll 1
        for (int st = 0; st <= NLN; ++st) {
            const int sg = st - 1;
            const int t0 = tok0 + SGT * st + RPW * wid;
            if (wid < 4) {
                if (st < NLN) {
#pragma unroll
                    for (int i = 0; i < RPW / 2; ++i) {
                        if (i & 1) { router_ln_load(ra, t0 + i + 1, xhi, xlo, xin, mres, lane); router_ln_finish(rb_, t0 + i, xhi, xlo, f32in, lng, lnb, lane); }
                        else { router_ln_load(rb_, t0 + i + 1, xhi, xlo, xin, mres, lane); router_ln_finish(ra, t0 + i, xhi, xlo, f32in, lng, lnb, lane); }
                    }
                }
            } else if (st >= 1) {
                const int fr = lane & 15, fq = lane >> 4, kq = wid - 4;
                f32x4 acc[MT][4];
#pragma unroll
                for (int mt = 0; mt < MT; ++mt)
#pragma unroll
                    for (int nt = 0; nt < 4; ++nt) acc[mt][nt] = (f32x4){0.f, 0.f, 0.f, 0.f};
                const bf16_t* xah = xhi + (size_t)(tok0 + SGT * sg + fr) * DM + kq * 512 + fq * 8; const bf16_t* xal = xlo + (size_t)(tok0 + SGT * sg + fr) * DM + kq * 512 + fq * 8;
                const bf16_t* bh = rwt + (size_t)fr * DM + kq * 512 + fq * 8;
#pragma unroll 2
                for (int ks = 0; ks < 16; ++ks) {
                    bf16x8 ah[MT], al[MT];
#pragma unroll
                    for (int mt = 0; mt < MT; ++mt) { ah[mt] = *(const bf16x8*)(xah + (size_t)(16 * mt) * DM + ks * 32); al[mt] = *(const bf16x8*)(xal + (size_t)(16 * mt) * DM + ks * 32); }
#pragma unroll
                    for (int nt = 0; nt < 4; ++nt) {
                        const bf16x8 wh = *(const bf16x8*)(bh + (size_t)(16 * nt) * DM + ks * 32), wl = *(const bf16x8*)(bh + (size_t)(64 + 16 * nt) * DM + ks * 32);
#pragma unroll
                        for (int mt = 0; mt < MT; ++mt) {
                            acc[mt][nt] = __builtin_amdgcn_mfma_f32_16x16x32_bf16(ah[mt], wh, acc[mt][nt], 0, 0, 0);
                            acc[mt][nt] = __builtin_amdgcn_mfma_f32_16x16x32_bf16(ah[mt], wl, acc[mt][nt], 0, 0, 0);
                            acc[mt][nt] = __builtin_amdgcn_mfma_f32_16x16x32_bf16(al[mt], wh, acc[mt][nt], 0, 0, 0);
                        }
                    }
                }
#pragma unroll
                for (int mt = 0; mt < MT; ++mt)
#pragma unroll
                    for (int nt = 0; nt < 4; ++nt)
#pragma unroll
                        for (int i = 0; i < 4; ++i) lgp[(kq * SGT + 16 * mt + 4 * fq + i) * 64 + 16 * nt + fr] = acc[mt][nt][i];
            }
            __syncthreads();
            if (wid < 4) {
                if (st < NLN) {
#pragma unroll
                    for (int i = RPW / 2; i < RPW; ++i) {
                        const int tn = i + 1 < RPW ? t0 + i + 1 : (st + 1 < NLN ? t0 + SGT : t0 + i);
                        if (i & 1) { router_ln_load(ra, tn, xhi, xlo, xin, mres, lane); router_ln_finish(rb_, t0 + i, xhi, xlo, f32in, lng, lnb, lane); }
                        else { router_ln_load(rb_, tn, xhi, xlo, xin, mres, lane); router_ln_finish(ra, t0 + i, xhi, xlo, f32in, lng, lnb, lane); }
                    }
                }
                asm volatile("s_waitcnt vmcnt(0)" ::: "memory");
            } else if (st >= 1) {
                const float bias = rb[lane];
                for (int q = 0; q < SPW; ++q) {
                    const int il = SPW * (wid - 4) + q, i = SGT * sg + il, t = tok0 + i;
                    const float z = (lgp[il * 64 + lane] + lgp[(SGT + il) * 64 + lane]) + (lgp[(2 * SGT + il) * 64 + lane] + lgp[(3 * SGT + il) * 64 + lane]);
                    const float score = 1.0f / (1.0f + expf(-z));
                    const float sb = score + bias;
                    sbl[i * 64 + lane] = sb;
                    int rank = 0;
#pragma unroll
                    for (int m4 = 0; m4 < 16; ++m4) { const f32x4 o = *(LAS f32x4*)(sbl + i * 64 + 4 * m4);
                        rank += (int)(o[0] > sb); rank += (int)(o[1] > sb); rank += (int)(o[2] > sb); rank += (int)(o[3] > sb); }
                    bool taken = rank < 8;
                    bool ok = __builtin_popcountll(__ballot(taken)) == 8;
#pragma unroll
                    for (int r = 0; r < 8; ++r) ok = ok && (__builtin_popcountll(__ballot(rank == r)) == 1);
                    float gsum = 0.f;
                    if (ok) {
                        const float gmine = taken ? score : 0.f;
                        gsum = wave_sum(gmine);
                        if (taken) { rt[RT_SEL + (size_t)t * 8 + rank] = lane; ((float*)rt)[RT_GATE + (size_t)t * 8 + rank] = score / gsum * ROUTED_SCALE; sel_l[i * 8 + rank] = lane; }
                    } else {
                        taken = false; int myidx = 0; float mygate = 0.f;
#pragma unroll 1
                        for (int r = 0; r < 8; ++r) {
                            float v = taken ? -__builtin_inff() : sb; int idx = lane;
#pragma unroll
                            for (int o = 32; o >= 1; o >>= 1) { const float ov = __shfl_xor(v, o); const int oi = __shfl_xor(idx, o); if (ov > v || (ov == v && oi < idx)) { v = ov; idx = oi; } }
                            const float gs = __shfl(score, idx);
                            if (lane == idx) taken = true;
                            if (lane == r) { myidx = idx; mygate = gs; }
                            gsum += gs;
                        }
                        if (lane < 8) { rt[RT_SEL + (size_t)t * 8 + lane] = myidx; ((float*)rt)[RT_GATE + (size_t)t * 8 + lane] = mygate / gsum * ROUTED_SCALE; sel_l[i * 8 + lane] = myidx; }
                    }
                    flag[i * 64 + lane] = taken ? 1 : 0;
                }
            }
            __syncthreads();
        }
        if (tid < 64) { unsigned long long M = 0ull;
            for (int i = 0; i < 64; ++i) M |= (unsigned long long)flag[i * 64 + tid] << i;
            Me[tid] = M; ctrl[CW_HIST + g * 64 + tid] = (unsigned)__builtin_popcountll(M); }
        __syncthreads();
        { const int i = tid >> 3, r = tid & 7, e = sel_l[i * 8 + r];
          const unsigned long long M = Me[e], below = (i == 0) ? 0ull : (M & ((1ull << i) - 1ull));
          rt[RT_RANK + (size_t)(tok0 + i) * 8 + r] = __builtin_popcountll(below); }
        __syncthreads();
    }
}
__device__ __forceinline__ void phase_route_pos(const Params& p, LAS unsigned char* lds) {
    LAS int* base_l = (LAS int*)lds; LAS int* cnt_l = base_l + 64; LAS int* rs_l = cnt_l + 64; LAS int* ts_l = rs_l + 64; LAS int* ntr_l = ts_l + 64; LAS int* part_l = ntr_l + 64;
    unsigned* ctrl = (unsigned*)(p.ws + OFF_CTRL); int* rt = (int*)(p.ws + OFF_ROUTE);
    const int tid = tidx(), lane = tid & 63;
    for (int g = blockIdx.x; g < NTOK / 64; g += NBLK) {
        __syncthreads();
        { const int e = tid & 63, pt = tid >> 6; int base = 0, tot = 0;
#pragma unroll 8
          for (int k = 0; k < 32; ++k) { const int gg = pt * 32 + k; const int hv = (int)ctrl[CW_HIST + gg * 64 + e]; tot += hv; base += gg < g ? hv : 0; }
          part_l[(pt * 64 + e) * 2] = base; part_l[(pt * 64 + e) * 2 + 1] = tot; }
        __syncthreads();
        if (tid < 64) { int base = 0, tot = 0;
#pragma unroll
            for (int k = 0; k < 8; ++k) { base += part_l[(k * 64 + tid) * 2]; tot += part_l[(k * 64 + tid) * 2 + 1]; }
            base_l[tid] = base; cnt_l[tid] = tot;
            const int ntl = (tot + 255) >> 8; int inc = ntl;
#pragma unroll
            for (int o = 1; o < 64; o <<= 1) { const int y = __shfl_up(inc, o); if (lane >= o) inc += y; }
            ts_l[tid] = inc - ntl; rs_l[tid] = (inc - ntl) * 256; if (tid == 63) ntr_l[0] = inc; }
        __syncthreads();
        { const int i = tid >> 3, r = tid & 7, t = g * 64 + i;
          const int e = rt[RT_SEL + (size_t)t * 8 + r], rank = rt[RT_RANK + (size_t)t * 8 + r];
          const int pos = rs_l[e] + base_l[e] + rank;
          rt[RT_POS + (size_t)t * 8 + r] = pos; rt[RT_ROWTOK + pos] = t; }
        if (tid < 64) rt[RT_ROWTOK + SH_TILE0 * 256 + g * 64 + tid] = g * 64 + tid;
        if (g < 64) { const int e = g, c = cnt_l[e], ntl = (c + 255) >> 8, padn = ntl * 256 - c, ts = ts_l[e], ntr = ntr_l[0];
            if (tid < padn) rt[RT_ROWTOK + rs_l[e] + c + tid] = 0;
            for (int k = tid; k < ntl; k += NTHREADS) { ctrl[CW_TILE_E + ts + k] = (unsigned)e; ctrl[CW_TILE_RT + ts + k] = (unsigned)(ts + k); }
            if (tid == 0) { ctrl[CW_TILE_E + ntr + g] = 64u; ctrl[CW_TILE_RT + ntr + g] = (unsigned)(SH_TILE0 + g); if (g == 0) ctrl[CW_NTILES] = (unsigned)(ntr + 64); } }
    }
}
template <bool FP8>
__device__ __forceinline__ void phase_combine_ln2(const Params& p, bf16_t* xhi, bf16_t* xlo, const float* g, const float* bt, float* yf) {
    const int lane = tidx() & 63;
    const bf16_t* Ys = (const bf16_t*)(p.ws + OFF_BIG + BG_YS); const int* rt = (const int*)(p.ws + OFF_ROUTE);
    for (int t = gwave(); t < NTOK; t += nwave()) {
        float v[32];
#pragma unroll
        for (int i = 0; i < 32; ++i) v[i] = 0.f;
        constexpr int RG = FP8 ? 5 : 3;
#pragma unroll 1
        for (int r3 = 0; r3 < (9 + RG - 1) / RG; ++r3) {
            u32x4 w[FP8 ? 1 : RG][4]; u32x2 w8[FP8 ? RG : 1][4]; float gt[RG];
#pragma unroll
            for (int q = 0; q < RG; ++q) {
                const int r = r3 * RG + q, rr = r < 8 ? r : 0;
                int pos = rt[RT_POS + (size_t)t * 8 + rr]; gt[q] = ((const float*)rt)[RT_GATE + (size_t)t * 8 + rr];
                if (r == 8) { pos = SH_TILE0 * 256 + t; gt[q] = 1.0f; }
                if (r > 8) gt[q] = 0.f;
                if constexpr (FP8) { const unsigned char* row = (const unsigned char*)Ys + (size_t)pos * DM; gt[q] *= (1.0f / 64.0f);
#pragma unroll
                    for (int j = 0; j < 4; ++j) w8[q][j] = *(const u32x2*)(row + j * 512 + lane * 8); }
                else { const bf16_t* row = Ys + (size_t)pos * DM;
#pragma unroll
                    for (int j = 0; j < 4; ++j) w[q][j] = *(const u32x4*)(row + j * 512 + lane * 8); }
            }
#pragma unroll
            for (int q = 0; q < RG; ++q)
#pragma unroll
                for (int j = 0; j < 4; ++j) {
                    if constexpr (FP8) {
                        const auto f0 = __builtin_amdgcn_cvt_pk_f32_fp8((int)w8[q][j].x, false), f1 = __builtin_amdgcn_cvt_pk_f32_fp8((int)w8[q][j].x, true), f2 = __builtin_amdgcn_cvt_pk_f32_fp8((int)w8[q][j].y, false), f3 = __builtin_amdgcn_cvt_pk_f32_fp8((int)w8[q][j].y, true);
                        v[j * 8 + 0] += gt[q] * f0[0]; v[j * 8 + 1] += gt[q] * f0[1]; v[j * 8 + 2] += gt[q] * f1[0]; v[j * 8 + 3] += gt[q] * f1[1];
                        v[j * 8 + 4] += gt[q] * f2[0]; v[j * 8 + 5] += gt[q] * f2[1]; v[j * 8 + 6] += gt[q] * f3[0]; v[j * 8 + 7] += gt[q] * f3[1];
                    } else {
#pragma unroll
                        for (int i = 0; i < 4; ++i) { v[j * 8 + 2 * i] += gt[q] * __uint_as_float(w[q][j][i] << 16); v[j * 8 + 2 * i + 1] += gt[q] * __uint_as_float(w[q][j][i] & 0xffff0000u); } } }
        }
#pragma unroll
        for (int j = 0; j < 4; ++j) { const size_t o = (size_t)t * DM + j * 512 + lane * 8;
            float a[8]; ld_hilo8(xhi + o, xlo + o, a);
#pragma unroll
            for (int i = 0; i < 8; ++i) v[j * 8 + i] += ALPHA * a[i]; }
        ln_row_store(v, g, bt, yf ? yf + (size_t)t * DM : nullptr, xhi + (size_t)t * DM, xlo + (size_t)t * DM, lane);
    }
}
__device__ __forceinline__ void phase_dsa_prep(const Params& p) {
    const int lane = tidx() & 63;
    const float* proj = (const float*)(p.ws + OFF_BIG + BG_PROJ);
    bf16_t* cq = (bf16_t*)(p.ws + OFF_BIG + BG_CQ); bf16_t* ckv = (bf16_t*)(p.ws + OFF_BIG + BG_CKV); bf16_t* kidx = (bf16_t*)(p.ws + OFF_BIG + BG_KIDX); float* widx = (float*)(p.ws + OFF_BIG + BG_WIDX);
    for (int t = gwave(); t < NTOK; t += nwave()) {
        const float* row = proj + (size_t)t * 1024;
        const f32x4 a0 = *(const f32x4*)(row + lane * 8), a1 = *(const f32x4*)(row + lane * 8 + 4);
        float s = 0.f;
#pragma unroll
        for (int i = 0; i < 4; ++i) s += a0[i] * a0[i] + a1[i] * a1[i];
        const float rq = 1.0f / sqrtf(wave_sum(s) * (1.0f / QLAT) + RMS_EPS);
        const f32x4 g0 = *(const f32x4*)(p.b_q_norm + lane * 8), g1 = *(const f32x4*)(p.b_q_norm + lane * 8 + 4);
        *(bf16x8*)(cq + (size_t)t * QLAT + lane * 8) = pack8(a0 * rq * g0, a1 * rq * g1);
        const f32x4 c0 = *(const f32x4*)(row + 512 + lane * 4);
        float s2 = 0.f;
#pragma unroll
        for (int i = 0; i < 4; ++i) s2 += c0[i] * c0[i];
        const float rk = 1.0f / sqrtf(wave_sum(s2) * (1.0f / KVLAT) + RMS_EPS);
        const f32x4 gk = *(const f32x4*)(p.b_kv_norm + lane * 4);
        const f32x4 ck = c0 * rk * gk;
        u32x2 o; o.x = cvt_pk_bf16(ck[0], ck[1]); o.y = cvt_pk_bf16(ck[2], ck[3]);
        *(u32x2*)(ckv + (size_t)t * KVLAT + lane * 4) = o;
        const float kv = row[768 + lane], kn = __shfl_down(kv, 1);
        if ((lane & 1) == 0) *(unsigned*)(kidx + (size_t)t * IDXD + lane) = cvt_pk_bf16(kv, kn);
        if (lane < 16) widx[(size_t)t * 16 + lane] = row[832 + lane] * 0.25f;
    }
}

__device__ __forceinline__ unsigned f2sortable(float v) { const unsigned b = __float_as_uint(v); return b ^ ((b >> 31) ? 0xffffffffu : 0x80000000u); }
__device__ __forceinline__ void phase_indexer(const Params& p, LAS unsigned char* lds) {
    const int tid = tidx(), wid = __builtin_amdgcn_readfirstlane(tid >> 6), lane = tid & 63, fr = lane & 15, fq = lane >> 4;
    const bf16_t* qidx = (const bf16_t*)(p.ws + OFF_BIG + BG_QIDX); const bf16_t* kidx = (const bf16_t*)(p.ws + OFF_BIG + BG_KIDX); const float* widx = (const float*)(p.ws + OFF_BIG + BG_WIDX);
    int* sel = (int*)(p.ws + OFF_BIG + BG_SEL); int* nsel = (int*)(p.ws + OFF_BIG + BG_NSEL);
    const int skey = tid >> 3, sc = tid & 7;
    const int swr = skey * 128 + ((sc ^ ((skey >> 1) & 7)) << 4);
    const int k32 = lane & 31, hi = lane >> 5;
    LAS unsigned char* rdb[4];
#pragma unroll
    for (int ks = 0; ks < 4; ++ks) rdb[ks] = lds + k32 * 128 + ((((2 * ks + hi)) ^ ((k32 >> 1) & 7)) << 4);
    for (int pr = blockIdx.x; pr < 256; pr += NBLK)
    for (int tk = 0; tk < 8; ++tk) {
        const int b = tk >> 1, pg = (tk & 1) ? 511 - pr : pr;
        const int pos = pg * 8 + wid, t = b * SEQ + pos, nchunks = (pg >> 3) + 1, kmax = nchunks * 64;
        int* selp = sel + (size_t)t * IDXTOPK;
        if (kmax <= IDXTOPK) {
#pragma unroll
            for (int k = 0; k < 4; ++k) if (lane + 64 * k < kmax) selp[lane + 64 * k] = lane + 64 * k;
            if (lane == 0) nsel[t] = kmax;
            continue;
        }
        bf16x8 qa[4];
#pragma unroll
        for (int ks = 0; ks < 4; ++ks) { qa[ks] = (bf16x8){0, 0, 0, 0, 0, 0, 0, 0}; if (k32 < 16) qa[ks] = *(const bf16x8*)(qidx + (size_t)t * 1024 + k32 * 64 + ks * 16 + hi * 8); }
        const f32x4 wA = *(const f32x4*)(widx + (size_t)t * 16 + 4 * hi), wB = *(const f32x4*)(widx + (size_t)t * 16 + 8 + 4 * hi);
        unsigned u[64];
        const bf16_t* kg = kidx + ((size_t)b * SEQ + skey) * IDXD + sc * 8;
        const int nsc = (nchunks + 3) >> 2;
        bf16x8 stg[4];
#pragma unroll
        for (int q = 0; q < 4; ++q) stg[q] = *(const bf16x8*)(kg + (size_t)q * 64 * IDXD);
        __syncthreads();
#pragma unroll
        for (int q = 0; q < 4; ++q) *(LAS bf16x8*)(lds + q * 8192 + swr) = stg[q];
        __syncthreads();
#pragma unroll
        for (int sc4 = 0; sc4 < 16; ++sc4) {
            if (sc4 < nsc) {
                if (sc4 + 1 < nsc) {
#pragma unroll
                    for (int q = 0; q < 4; ++q) stg[q] = *(const bf16x8*)(kg + (size_t)(4 * (sc4 + 1) + q) * 64 * IDXD);
                }
#pragma unroll
                for (int q = 0; q < 4; ++q) {
                    const int j = 4 * sc4 + q;
                    if (j < nchunks) {
                        float part[2];
#pragma unroll
                        for (int T2 = 0; T2 < 2; ++T2) {
                            f32x16 acc = {};
#pragma unroll
                            for (int ks = 0; ks < 4; ++ks) {
                                const bf16x8 kf = *(const LAS bf16x8*)(rdb[ks] + (sc4 & 1) * 32768 + q * 8192 + T2 * 4096);
                                acc = __builtin_amdgcn_mfma_f32_32x32x16_bf16(qa[ks], kf, acc, 0, 0, 0);
                            }
                            float pt = 0.f;
#pragma unroll
                            for (int r = 0; r < 4; ++r) { pt = fmaf(wA[r], __int_as_float(max(__float_as_int(acc[r]), 0)), pt); pt = fmaf(wB[r], __int_as_float(max(__float_as_int(acc[4 + r]), 0)), pt); }
                            part[T2] = pt;
                        }
                        const auto xs = __builtin_amdgcn_permlane32_swap(__float_as_uint(part[0]), __float_as_uint(part[1]), false, false);
                        const float val = hi ? part[1] + __uint_as_float(xs[0]) : part[0] + __uint_as_float(xs[1]);
                        u[j] = f2sortable(val);
                    } else u[j] = 0u;
                }
                if (sc4 + 1 < nsc) {
#pragma unroll
                    for (int q = 0; q < 4; ++q) *(LAS bf16x8*)(lds + ((sc4 + 1) & 1) * 32768 + q * 8192 + swr) = stg[q];
                    __syncthreads();
                }
            } else {
#pragma unroll
                for (int q = 0; q < 4; ++q) u[4 * sc4 + q] = 0u;
            }
        }
        unsigned thr = 0u; int c_gt = 0; bool exact = false;
        for (int bit = 31; bit >= 0; --bit) {
            const unsigned cand = thr | (1u << bit);
            int cnt = 0;
#pragma unroll
            for (int j = 0; j < 64; j += 8) {
                if (j < nchunks) {
                const unsigned long long m0 = __ballot(u[j] >= cand), m1 = __ballot(u[j + 1] >= cand), m2 = __ballot(u[j + 2] >= cand), m3 = __ballot(u[j + 3] >= cand),
                                         m4 = __ballot(u[j + 4] >= cand), m5 = __ballot(u[j + 5] >= cand), m6 = __ballot(u[j + 6] >= cand), m7 = __ballot(u[j + 7] >= cand);
                cnt += ((__builtin_popcountll(m0) + __builtin_popcountll(m1)) + (__builtin_popcountll(m2) + __builtin_popcountll(m3))) +
                       ((__builtin_popcountll(m4) + __builtin_popcountll(m5)) + (__builtin_popcountll(m6) + __builtin_popcountll(m7)));
                }
            }
            if (cnt >= IDXTOPK) thr = cand; else c_gt = cnt;
            if (cnt == IDXTOPK) { exact = true; break; }
        }
        const unsigned t_gt = exact ? thr - 1u : thr;
        const int eq_base = exact ? IDXTOPK : c_gt, quota = IDXTOPK - eq_base;
        LAS int* ssel = (LAS int*)(lds + 65536 + wid * 1024);
        int rg = 0, re = 0;
#pragma unroll
        for (int j = 0; j < 64; ++j) {
            if (j < nchunks) {
            const bool sg = u[j] > t_gt, se = u[j] == thr && !exact;
            const unsigned long long mg = __ballot(sg), me = __ballot(se);
            const int pg_ = rg + __builtin_amdgcn_mbcnt_hi((unsigned)(mg >> 32), __builtin_amdgcn_mbcnt_lo((unsigned)mg, 0u));
            const int pe_ = re + __builtin_amdgcn_mbcnt_hi((unsigned)(me >> 32), __builtin_amdgcn_mbcnt_lo((unsigned)me, 0u));
            const int key = 64 * j + 32 * hi + k32;
            if (sg) ssel[pg_] = key;
            if (se && pe_ < quota) ssel[eq_base + pe_] = key;
            rg += __builtin_popcountll(mg); re += __builtin_popcountll(me);
            }
        }
        *(u32x4*)(selp + 4 * lane) = *(LAS u32x4*)(ssel + 4 * lane);
        if (lane == 0) nsel[t] = IDXTOPK;
    }
}

__device__ __forceinline__ int t5_bucket_dev(int rel) {
    const int n = rel < 0 ? -rel : rel;
    int large = 2 + (31 - __builtin_clz((unsigned)(n * n) | 1u)); large = large > 15 ? 15 : large;
    return (rel > 0 ? 16 : 0) + (n < 8 ? n : large);
}
__device__ __forceinline__ int cg_off(int r, int c) { return r * 512 + ((c ^ ((r & 7) << 1)) << 4); }
__device__ __forceinline__ void phase_sparse_attn(const Params& p, LAS unsigned char* lds) {
    const int tid = tidx(), wid = __builtin_amdgcn_readfirstlane(tid >> 6), lane = tid & 63, fr = lane & 15, fq = lane >> 4;
    LAS unsigned char* cgl = lds + wid * 16384;
    LAS float* rbl = (LAS float*)(lds + 131072);
    LAS int* qctr = (LAS int*)(lds + 133120 + 8 * 1280);
    if (tid == 0) *qctr = 0;
    if (tid < 512) rbl[tid] = p.rel_bias[tid] * 1.4426950408889634f;
    __syncthreads();
    if (wid >= NWAVES - SPA_CW) { cvt_moe_run4(p, cgl, 1, CVT1_SPLIT + blockIdx.x * SPA_CW + (wid - (NWAVES - SPA_CW)), NBLK * SPA_CW, 65 * 768 - CVT0_GU, lane); }
    else {
    const bf16_t* qlat = (const bf16_t*)(p.ws + OFF_BIG + BG_QLAT); const bf16_t* ckv = (const bf16_t*)(p.ws + OFF_BIG + BG_CKV);
    const int* sel = (const int*)(p.ws + OFF_BIG + BG_SEL); const int* nsel = (const int*)(p.ws + OFF_BIG + BG_NSEL);
    bf16_t* olat = (bf16_t*)(p.ws + OFF_BIG + BG_OLAT);
    const int hr = lane >> 5, hc = lane & 31;
    const int q4 = fr >> 2, p4 = fr & 3;
    const int trbase = (int)(uintptr_t)cgl;
    LAS unsigned char* qkb[4]; int trb[8];
#pragma unroll
    for (int jj = 0; jj < 4; ++jj) qkb[jj] = cgl + cg_off(fr, 4 * jj + fq);
#pragma unroll
    for (int m = 0; m < 8; ++m) trb[m] = trbase + cg_off(4 * fq + q4, 2 * m + (p4 >> 1)) + (p4 & 1) * 8;
    LAS int* ssel = (LAS int*)(lds + 133120 + wid * 1280);
    LAS int* bkt = ssel + 256;
    for (;;) {
        int qk = 0; if (lane == 0) qk = __atomic_fetch_add(qctr, 1, __ATOMIC_RELAXED);
        qk = __builtin_amdgcn_readfirstlane(qk); if (qk >= 64) break;
        const int t = blockIdx.x * 8 + (qk & 7) + NBLK * 8 * (qk >> 3);
        const int b = t >> 12, pos = t & 4095, ns = __builtin_amdgcn_readfirstlane(nsel[t]), nch = ns >> 5;
        const int* selp = sel + (size_t)t * IDXTOPK;
        *(LAS u32x4*)(ssel + 4 * lane) = *(const u32x4*)(selp + 4 * lane);
        bf16x8 qb[8];
#pragma unroll
        for (int j = 0; j < 8; ++j) qb[j] = *(const bf16x8*)(qlat + (size_t)t * 4096 + fr * 256 + j * 32 + fq * 8);
        f32x4 acc[16];
#pragma unroll
        for (int n = 0; n < 16; ++n) acc[n] = (f32x4){0.f, 0.f, 0.f, 0.f};
        float mrun = -1e30f, lsum = 0.f;
        const bf16_t* ckb = ckv + (size_t)b * SEQ * KVLAT + hc * 8;
        bf16x8 st[16];
#pragma unroll
        for (int it = 0; it < 16; ++it) { const int key = ssel[2 * it + hr]; st[it] = *(const bf16x8*)(ckb + (size_t)key * KVLAT); }
        for (int ch = 0; ch < nch; ++ch) {
#pragma unroll
            for (int it = 0; it < 16; ++it) *(LAS bf16x8*)(cgl + cg_off(2 * it + hr, hc)) = st[it];
            if (ch + 1 < nch) {
#pragma unroll
                for (int it = 0; it < 16; ++it) { const int key = ssel[(ch + 1) * 32 + 2 * it + hr]; st[it] = *(const bf16x8*)(ckb + (size_t)key * KVLAT); }
            }
            if (lane < 32) bkt[lane] = t5_bucket_dev(ssel[ch * 32 + lane] - pos) * 16;
            f32x4 s0 = (f32x4){0.f, 0.f, 0.f, 0.f}, s1 = (f32x4){0.f, 0.f, 0.f, 0.f};
#pragma unroll
            for (int j = 0; j < 8; ++j) {
                const bf16x8 a0 = *(const LAS bf16x8*)(qkb[j & 3] + (j >> 2) * 256);
                const bf16x8 a1 = *(const LAS bf16x8*)(qkb[j & 3] + (j >> 2) * 256 + 8192);
                s0 = __builtin_amdgcn_mfma_f32_16x16x32_bf16(a0, qb[j], s0, 0, 0, 0);
                s1 = __builtin_amdgcn_mfma_f32_16x16x32_bf16(a1, qb[j], s1, 0, 0, 0);
            }
            const u32x4 bo0 = *(LAS u32x4*)(bkt + 4 * fq), bo1 = *(LAS u32x4*)(bkt + 16 + 4 * fq);
            float cmax = -1e30f;
#pragma unroll
            for (int i = 0; i < 4; ++i) {
                s0[i] = fmaf(s0[i], 0.12751743082459868f, rbl[bo0[i] + fr]);
                s1[i] = fmaf(s1[i], 0.12751743082459868f, rbl[bo1[i] + fr]);
                cmax = fmaxf(cmax, fmaxf(s0[i], s1[i]));
            }
            { const auto x16 = __builtin_amdgcn_permlane16_swap(__float_as_uint(cmax), __float_as_uint(cmax), false, false); cmax = fmaxf(__uint_as_float(x16[0]), __uint_as_float(x16[1]));
              const auto x32 = __builtin_amdgcn_permlane32_swap(__float_as_uint(cmax), __float_as_uint(cmax), false, false); cmax = fmaxf(__uint_as_float(x32[0]), __uint_as_float(x32[1])); }
            if (!__all(cmax - mrun <= 11.5f)) {
                const float mnew = fmaxf(mrun, cmax), alpha = __builtin_amdgcn_exp2f(mrun - mnew);
                mrun = mnew; lsum *= alpha;
#pragma unroll
                for (int n = 0; n < 16; ++n) acc[n] *= alpha;
            }
            float ps = 0.f;
#pragma unroll
            for (int i = 0; i < 4; ++i) { s0[i] = __builtin_amdgcn_exp2f(s0[i] - mrun); s1[i] = __builtin_amdgcn_exp2f(s1[i] - mrun); ps += s0[i] + s1[i]; }
            lsum += ps;
            u32x4 pw; pw.x = cvt_pk_bf16(s0[0], s0[1]); pw.y = cvt_pk_bf16(s0[2], s0[3]); pw.z = cvt_pk_bf16(s1[0], s1[1]); pw.w = cvt_pk_bf16(s1[2], s1[3]);
            const bf16x8 pb = *reinterpret_cast<bf16x8*>(&pw);
#define TRRD2(dst, base, off) asm volatile("ds_read_b64_tr_b16 %0, %1 offset:%2" : "=&v"(dst) : "v"(base), "i"(off) : "memory")
#define PV_4(n0) do { s16x4 l0, h0, l1, h1, l2, h2, l3, h3; \
                TRRD2(l0, trb[((n0) + 0) & 7], (((n0) + 0) >> 3) * 256); TRRD2(h0, trb[((n0) + 0) & 7], (((n0) + 0) >> 3) * 256 + 8192); \
                TRRD2(l1, trb[((n0) + 1) & 7], (((n0) + 1) >> 3) * 256); TRRD2(h1, trb[((n0) + 1) & 7], (((n0) + 1) >> 3) * 256 + 8192); \
                TRRD2(l2, trb[((n0) + 2) & 7], (((n0) + 2) >> 3) * 256); TRRD2(h2, trb[((n0) + 2) & 7], (((n0) + 2) >> 3) * 256 + 8192); \
                TRRD2(l3, trb[((n0) + 3) & 7], (((n0) + 3) >> 3) * 256); TRRD2(h3, trb[((n0) + 3) & 7], (((n0) + 3) >> 3) * 256 + 8192); \
                asm volatile("s_waitcnt lgkmcnt(0)" ::: "memory"); __builtin_amdgcn_sched_barrier(0); \
                acc[(n0) + 0] = __builtin_amdgcn_mfma_f32_16x16x32_bf16((bf16x8){l0[0], l0[1], l0[2], l0[3], h0[0], h0[1], h0[2], h0[3]}, pb, acc[(n0) + 0], 0, 0, 0); \
                acc[(n0) + 1] = __builtin_amdgcn_mfma_f32_16x16x32_bf16((bf16x8){l1[0], l1[1], l1[2], l1[3], h1[0], h1[1], h1[2], h1[3]}, pb, acc[(n0) + 1], 0, 0, 0); \
                acc[(n0) + 2] = __builtin_amdgcn_mfma_f32_16x16x32_bf16((bf16x8){l2[0], l2[1], l2[2], l2[3], h2[0], h2[1], h2[2], h2[3]}, pb, acc[(n0) + 2], 0, 0, 0); \
                acc[(n0) + 3] = __builtin_amdgcn_mfma_f32_16x16x32_bf16((bf16x8){l3[0], l3[1], l3[2], l3[3], h3[0], h3[1], h3[2], h3[3]}, pb, acc[(n0) + 3], 0, 0, 0); \
                __builtin_amdgcn_sched_barrier(0); } while (0)
            PV_4(0); PV_4(4); PV_4(8); PV_4(12);
#undef PV_4
#undef TRRD2
            asm volatile("s_waitcnt lgkmcnt(0)" ::: "memory");
        }
        float lt = lsum; lt += __shfl_xor(lt, 16); lt += __shfl_xor(lt, 32);
        const float inv = 1.0f / lt;
        bf16_t* op = olat + (size_t)t * 4096 + fr * 256 + 4 * fq;
#pragma unroll
        for (int n = 0; n < 16; ++n) { u32x2 o; o.x = cvt_pk_bf16(acc[n][0] * inv, acc[n][1] * inv); o.y = cvt_pk_bf16(acc[n][2] * inv, acc[n][3] * inv); *(u32x2*)(op + 16 * n) = o; }
    }
    }
}

#define XB_TMO      128
#define XB_XCNT(j)  (256  + 64 * (j))
#define XB_XSUB(j)  (1280 + 64 * (j))
#define XB_XGEN(j)  (2304 + 64 * (j))
#define XB_TOP      3328
#define XB_TOPGEN   3392
#define XCD_BAR_WORDS 3456
#define XB_SPIN_CAP (1u << 21)

__device__ __forceinline__ unsigned xb_ld(unsigned* p)              { return __hip_atomic_load(p, __ATOMIC_RELAXED, __HIP_MEMORY_SCOPE_AGENT); }
__device__ __forceinline__ unsigned xb_add(unsigned* p, unsigned v) { return __hip_atomic_fetch_add(p, v, __ATOMIC_RELAXED, __HIP_MEMORY_SCOPE_AGENT); }
__device__ __forceinline__ unsigned xb_xcc_id() { return (unsigned)__builtin_amdgcn_s_getreg((3 << 11) | 20) & 0xFu; }
#define XB_SPIN(cond, bar) do { unsigned _sp = 0; while (cond) { __builtin_amdgcn_s_sleep(1); \
    if ((++_sp & 255u) == 0u) { if (xb_ld(&(bar)[XB_TMO])) break; if (_sp > XB_SPIN_CAP) { atomicAdd(&(bar)[XB_TMO], 1u); break; } } } } while (0)

struct XcdBarrier {
    unsigned* bar; unsigned x;
    volatile LAS unsigned* st;
};

__device__ __forceinline__ XcdBarrier xcd_barrier_post(unsigned* bar, volatile LAS unsigned* st) {
    XcdBarrier b; b.bar = bar; b.x = xb_xcc_id(); b.st = st;
    if (threadIdx.x == 0) (void)xb_add(&bar[XB_XCNT(b.x)], 1u);
    return b;
}
__device__ __forceinline__ void xcd_barrier_complete(unsigned* bar, unsigned x, unsigned& nloc, unsigned& nx) {
    const unsigned G = gridDim.x * gridDim.y * gridDim.z;
    unsigned sum, cnt, mine, sp = 0u;
    for (;;) {
        sum = 0u; cnt = 0u; mine = 0u;
#pragma unroll
        for (unsigned j = 0; j < 16; ++j) { const unsigned c = xb_ld(&bar[XB_XCNT(j)]); sum += c; cnt += (c > 0u) ? 1u : 0u; mine = (j == x) ? c : mine; }
        if (sum == G) break;
        __builtin_amdgcn_s_sleep(1);
        if ((++sp & 255u) == 0u) { if (xb_ld(&bar[XB_TMO])) break; if (sp > XB_SPIN_CAP) { atomicAdd(&bar[XB_TMO], 1u); break; } }
    }
    nloc = mine > 0u ? mine : 1u; nx = cnt > 0u ? cnt : 1u;
}

__device__ __forceinline__ void xcd_barrier(const XcdBarrier& b) {
    asm volatile("s_waitcnt vmcnt(0)" ::: "memory");
    __syncthreads();
    if (threadIdx.x == 0) {
        unsigned* bar = b.bar;
        __builtin_amdgcn_s_waitcnt(0);
        unsigned nloc = b.st[0], nx = b.st[1];
        if (nloc == 0u) { xcd_barrier_complete(bar, b.x, nloc, nx); b.st[0] = nloc; b.st[1] = nx; }
        const unsigned old = xb_add(&bar[XB_XSUB(b.x)], 1u);
        const unsigned gen = old / nloc;
        if (old + 1u == (gen + 1u) * nloc) {
            __builtin_amdgcn_fence(__ATOMIC_RELEASE, "agent");
            asm volatile("s_waitcnt vmcnt(0)" ::: "memory");
            const unsigned og = xb_add(&bar[XB_TOP], 1u);
            const unsigned tg = og / nx;
            if (og + 1u == (tg + 1u) * nx) xb_add(&bar[XB_TOPGEN], 1u);
            else XB_SPIN(xb_ld(&bar[XB_TOPGEN]) == tg, bar);
            __builtin_amdgcn_fence(__ATOMIC_ACQUIRE, "agent");
            xb_add(&bar[XB_XGEN(b.x)], 1u);
            asm volatile("s_waitcnt vmcnt(0)" ::: "memory");
        } else {
            XB_SPIN(xb_ld(&bar[XB_XGEN(b.x)]) == gen, bar);
            __builtin_amdgcn_fence(__ATOMIC_ACQUIRE, "agent");
            asm volatile("s_waitcnt vmcnt(0)" ::: "memory");
        }
    }
    __syncthreads();
}


enum { PH_PROLOGUE = 0, PH_INPROJ_A, PH_NORMS, PH_ATTN_A, PH_OUTPROJ_A, PH_LNR_0, PH_RPOS_0, PH_GU_0, PH_DOWN_0, PH_COMB_0,
       PH_INPROJ_B, PH_DSA_PREP, PH_QPROJ_B, PH_INDEXER, PH_SPATTN, PH_UV_B, PH_OUTPROJ_B, PH_LNR_1, PH_RPOS_1, PH_GU_1, PH_DOWN_1, PH_COMB_1, PH_COUNT };

template <int PH>
__device__ __forceinline__ void run_phase(const Params& p, LAS unsigned char* lds) {
    unsigned char* ws = p.ws;
    unsigned* ctrl = (unsigned*)(ws + OFF_CTRL);
    bf16_t* xb = (bf16_t*)(ws + OFF_XB); bf16_t* xlo = (bf16_t*)(ws + OFF_X2F);
    unsigned char* big = ws + OFF_BIG;
    constexpr int LAYER = (PH >= PH_INPROJ_B) ? 1 : 0;
    if constexpr (PH == PH_PROLOGUE) {
        { float* NRM = (float*)(big + BG_NRM); for (int i = blockIdx.x * NTHREADS + tidx(); i < 2 * 64 * 64 * 2; i += NBLK * NTHREADS) NRM[i] = 0.f; }
        phase_cvt_fox(p, lds); phase_cvt_router(p); phase_cvt_fgate(p); phase_cvt_moe(p, lds, 0, CVT0_SPLIT); phase_cvt_dsa(p, lds); phase_wprep(p); phase_cvt_moe(p, lds, 1, CVT1_SPLIT);
    }
    else if constexpr (PH == PH_INPROJ_A) {
        phase_fgate(p);
        if (blockIdx.x >= NBLK - CVB) {
            const int tid = tidx();
            cvt_moe_run4(p, lds + (tid >> 6) * 9216, 0, CVT0_SPLIT + (blockIdx.x - (NBLK - CVB)) * NWAVES + (tid >> 6), CVB * NWAVES, 65 * 768 - CVT0_GU, tid & 63);
        } else {
            pg8::DenseSched S; S.init(xb, (const bf16_t*)(ws + OFF_WA + WA_WINT), NTOK, 6144, DM, NBLK - CVB);
            pg8::EpiBf16T<true> E; E.O0 = (bf16_t*)(big + BG_Q); E.ld0 = DM; E.O1 = nullptr; E.ld1 = 0; E.split0 = 0; E.split_cols = DM; E.split_stride = (size_t)NTOK * DM; E.nrm = (float*)(big + BG_NRM);
            pg8::gemm_phase(lds, S, E);
        }
    }
    else if constexpr (PH == PH_NORMS) phase_scan(p, lds);
    else if constexpr (PH == PH_ATTN_A) phase_fox_attn(p, lds);
    else if constexpr (PH == PH_OUTPROJ_A) {
        pg8::DenseSched S; S.init((const bf16_t*)(big + BG_O), (const bf16_t*)(ws + OFF_WA + WA_WOUTT), NTOK, DM, DM);
        pg8::EpiBf16 E; E.O0 = (bf16_t*)(big + BG_M); E.ld0 = DM; E.O1 = nullptr; E.ld1 = 0; E.split0 = 1 << 30; E.split_cols = 0; E.split_stride = 0;
        pg8::gemm_phase(lds, S, E);
    }
    else if constexpr (PH == PH_LNR_0) phase_router(p, lds, xb, xlo, (const bf16_t*)(ws + OFF_ROUTE + RWT_BYTE_OFF), p.router_b, p.x, (const bf16_t*)(big + BG_M), p.ln1_g, p.ln1_b);
    else if constexpr (PH == PH_LNR_1) phase_router(p, lds, xb, xlo, (const bf16_t*)(ws + OFF_ROUTE + RWT_BYTE_OFF) + (size_t)128 * DM, p.router_b + NEXP, nullptr, (const bf16_t*)(big + BG_M2), p.ln1_g + DM, p.ln1_b + DM);
    else if constexpr (PH == PH_RPOS_0 || PH == PH_RPOS_1) phase_route_pos(p, lds);
    else if constexpr (PH == PH_GU_0 || PH == PH_GU_1) {
        constexpr int NCV = GU0_CV;
        if (NCV > 0 && (int)(blockIdx.x >> 3) >= (NBLK >> 3) - NCV) {
            const int tid = tidx();
            cvt_moe_run4(p, lds + (tid >> 6) * 9216, LAYER, 65 * 768 - CVT0_GU + ((int)(blockIdx.x >> 3) - ((NBLK >> 3) - NCV)) * 64 + (int)(blockIdx.x & 7) * NWAVES + (tid >> 6), NCV * 64, 65 * 768, tid & 63);
        } else {
            pg8::MoeGuSched S; S.init(ctrl, xb, (const bf16_t*)(ws + OFF_WGU + (size_t)LAYER * MOE_LSTRIDE), (const int*)(ws + OFF_ROUTE) + RT_ROWTOK, -1, (LAS int*)(lds + pg8::STAGE_BYTES), NCV);
            pg8::EpiSwiGLU E; E.H = (bf16_t*)(big + BG_H);
            pg8::gemm_phase(lds, S, E);
        }
    }
    else if constexpr (PH == PH_DOWN_0 || PH == PH_DOWN_1) {
        pg8::MoeDownSched S; S.init(ctrl, (const bf16_t*)(big + BG_H), (const bf16_t*)(ws + OFF_WD + (size_t)LAYER * MOE_LSTRIDE), -1);
        if constexpr (PH == PH_DOWN_1 || YS0_FP8) {
            pg8::EpiFp8 E; E.O = big + BG_YS; E.ldc = DM;
            pg8::gemm_phase(lds, S, E);
        } else {
            pg8::EpiBf16 E; E.O0 = (bf16_t*)(big + BG_YS); E.ld0 = DM; E.O1 = nullptr; E.ld1 = 0; E.split0 = 1 << 30; E.split_cols = 0; E.split_stride = 0;
            pg8::gemm_phase(lds, S, E);
        }
    }
    else if constexpr (PH == PH_COMB_0) phase_combine_ln2<(YS0_FP8 != 0)>(p, xb, xlo, p.ln2_g, p.ln2_b, nullptr);
    else if constexpr (PH == PH_COMB_1) phase_combine_ln2<true>(p, xb, xlo, p.ln2_g + DM, p.ln2_b + DM, p.out);
    else if constexpr (PH == PH_INPROJ_B) {
        pg8::DenseSched S; S.init(xb, (const bf16_t*)(ws + OFF_WA + WA_WBINT), NTOK, 1024, DM);
        pg8::EpiF32 E; E.C = (float*)(big + BG_PROJ); E.ldc = 1024;
        pg8::gemm_phase(lds, S, E);
    }
    else if constexpr (PH == PH_DSA_PREP) phase_dsa_prep(p);
    else if constexpr (PH == PH_QPROJ_B) {
        pg8::DenseSched S; S.init((const bf16_t*)(big + BG_CQ), (const bf16_t*)(ws + OFF_WA + WA_WQ2T), NTOK, 5120, QLAT);
        pg8::EpiBf16 E; E.O0 = (bf16_t*)(big + BG_QLAT); E.ld0 = 4096; E.O1 = (bf16_t*)(big + BG_QIDX); E.ld1 = 1024; E.split0 = 4096; E.split_cols = 0; E.split_stride = 0;
        pg8::gemm_phase(lds, S, E);
    }
    else if constexpr (PH == PH_INDEXER) phase_indexer(p, lds);
    else if constexpr (PH == PH_SPATTN) phase_sparse_attn(p, lds);
    else if constexpr (PH == PH_UV_B) {
        pg8::BlockDiagSched S; S.init((const bf16_t*)(big + BG_OLAT), (const bf16_t*)(ws + OFF_WA + WA_WUVOT), NTOK, DM, 512, 4096);
        pg8::EpiBf16 E; E.O0 = (bf16_t*)(big + BG_O2); E.ld0 = DM; E.O1 = nullptr; E.ld1 = 0; E.split0 = 1 << 30; E.split_cols = 0; E.split_stride = 0;
        pg8::gemm_phase(lds, S, E);
    }
    else if constexpr (PH == PH_OUTPROJ_B) {
        pg8::DenseSched S; S.init((const bf16_t*)(big + BG_O2), (const bf16_t*)(ws + OFF_WA + WA_WOUTTB), NTOK, DM, DM);
        pg8::EpiBf16 E; E.O0 = (bf16_t*)(big + BG_M2); E.ld0 = DM; E.O1 = nullptr; E.ld1 = 0; E.split0 = 1 << 30; E.split_cols = 0; E.split_stride = 0;
        pg8::gemm_phase(lds, S, E);
    }
}

#ifndef MK_LAUNCHES
#define MK_LAUNCHES 1
#endif
constexpr int LDS_BAR_OFF = LDS_BYTES - 16;

template <int PH>
__device__ __forceinline__ void run_from(const Params& p, LAS unsigned char* lds, const XcdBarrier& bar) {
    run_phase<PH>(p, lds);
    if constexpr (PH + 1 < PH_COUNT) { xcd_barrier(bar); run_from<PH + 1>(p, lds, bar); }
}
__global__ void __launch_bounds__(NTHREADS, 2) k_mega(Params p) {
    extern __shared__ __attribute__((aligned(16))) unsigned char smem[];
    LAS unsigned char* lds = (LAS unsigned char*)smem;
    if (threadIdx.x == 0) *(LAS u32x4*)(lds + LDS_BAR_OFF) = (u32x4){0u, 0u, 0u, 0u};
    __syncthreads();
    const XcdBarrier bar = xcd_barrier_post((unsigned*)(p.ws + OFF_CTRL) + CW_BAR, (volatile LAS unsigned*)(lds + LDS_BAR_OFF));
    run_from<0>(p, lds, bar);
}
template <int PH>
__global__ void __launch_bounds__(NTHREADS, 2) k_phase(Params p) {
    extern __shared__ __attribute__((aligned(16))) unsigned char smem[];
    run_phase<PH>(p, (LAS unsigned char*)smem);
}
template <int PH>
static void launch_phases(const Params& p, int grid, hipStream_t stream) {
    static bool done = false;
    if (!done) { done = true; (void)hipFuncSetAttribute((const void*)k_phase<PH>, hipFuncAttributeMaxDynamicSharedMemorySize, LDS_BYTES); }
    hipLaunchKernelGGL(k_phase<PH>, dim3(grid), dim3(NTHREADS), LDS_BYTES, stream, p);
    if constexpr (PH + 1 < PH_COUNT) launch_phases<PH + 1>(p, grid, stream);
}

extern "C" void kernel_launch(void* const* d_in, const int* in_sizes, int n_in, void* d_out, int out_size, void* d_ws, size_t ws_size, hipStream_t stream) {
    if (n_in != 25 || out_size != NTOK * DM || ws_size < WS_END) { fprintf(stderr, "kernel_launch: unexpected shapes (n_in %d out %d ws %zu)\n", n_in, out_size, ws_size); return; }
    Params p{};
    const float** pp = (const float**)&p;
    for (int i = 0; i < 25; ++i) pp[i] = (const float*)d_in[i];
    p.out = (float*)d_out; p.ws = (unsigned char*)d_ws;
    static int grid = 0;
    if (!grid) {
        int dev = 0, cus = 0, per_cu = 0; (void)hipGetDevice(&dev);
        if (hipDeviceGetAttribute(&cus, hipDeviceAttributeMultiprocessorCount, dev) != hipSuccess || cus <= 0) cus = 256;
        (void)hipFuncSetAttribute((const void*)k_mega, hipFuncAttributeMaxDynamicSharedMemorySize, LDS_BYTES);
        if (hipOccupancyMaxActiveBlocksPerMultiprocessor(&per_cu, (const void*)k_mega, NTHREADS, LDS_BYTES) != hipSuccess || per_cu < 1) fprintf(stderr, "kernel_launch: occupancy query reports %d workgroups per CU\n", per_cu);
        if (cus < NBLK) fprintf(stderr, "kernel_launch: built for a %d-CU device, found %d CUs\n", NBLK, cus);
        grid = NBLK;
    }
    (void)hipMemsetAsync((char*)d_ws + OFF_CTRL, 0, CTRL_ZERO_BYTES, stream);
#if MK_LAUNCHES
    hipLaunchKernelGGL(k_mega, dim3(grid), dim3(NTHREADS), LDS_BYTES, stream, p);
#else
    launch_phases<0>(p, grid, stream);
#endif
}
```

```cpp
#include <hip/hip_runtime.h>
#include <stdint.h>
#include <stdio.h>

#define LAS __attribute__((address_space(3)))
typedef unsigned short bf16_t;
typedef short bf16x8 __attribute__((ext_vector_type(8)));
typedef short s16x4 __attribute__((ext_vector_type(4)));
typedef float f32x16 __attribute__((ext_vector_type(16)));
typedef float f32x4 __attribute__((ext_vector_type(4)));
typedef float f32x2 __attribute__((ext_vector_type(2)));
typedef unsigned u32x4 __attribute__((ext_vector_type(4)));
typedef unsigned u32x2 __attribute__((ext_vector_type(2)));

constexpr int NTOK = 16384, DM = 2048, SEQ = 4096, NBATCH = 4, NHEAD = 16, HDIM = 128;
constexpr int NEXP = 64, TOPK = 8, DEXP = 512;
constexpr int QLAT = 512, KVLAT = 256, IDXD = 64, IDXH = 16, IDXTOPK = 256, BW = 848;
constexpr float ALPHA = 1.4142135623730951f, LN_EPS = 1e-5f, RMS_EPS = 1e-6f, ROUTED_SCALE = 2.5f;
constexpr int NTHREADS = 512, NWAVES = 8;
#ifndef YS0_FP8
#define YS0_FP8 1
#endif
#ifndef CVT1_SPLIT
#define CVT1_SPLIT 0
#endif
#ifndef CVB
#define CVB 64
#endif
#ifndef GU0_CV
#define GU0_CV 1
#endif
#ifndef CVT0_GU
#define CVT0_GU 8320
#endif
#ifndef CVT0_SPLIT
#define CVT0_SPLIT 0
#endif
#ifndef FOX_PRIO
#define FOX_PRIO 1
#endif
#ifndef SPA_CW
#define SPA_CW 2
#endif
constexpr int NBLK = 256;
constexpr int LDS_BYTES = 147456;
constexpr int MAXRT = 576;
constexpr int SH_TILE0 = MAXRT;
constexpr int NSROWS = (MAXRT + 64) * 256;

constexpr size_t MiB = 1048576;
constexpr size_t OFF_CTRL = 0, OFF_ROUTE = 1 * MiB, OFF_WGU = 5 * MiB, OFF_WD = 265 * MiB, MOE_LSTRIDE = 390 * MiB  , OFF_WA = 785 * MiB, OFF_XB = 857 * MiB, OFF_X2F = 921 * MiB, OFF_BIG = 1049 * MiB, WS_END = 1849 * MiB;
constexpr int CW_BAR = 0;
constexpr int CW_NTILES = 4096;
constexpr int CW_TILE_E = 4352;
constexpr int CW_TILE_RT = 5120;
constexpr int CW_HIST = 8192;
constexpr int CTRL_ZERO_BYTES = 16384;
constexpr size_t RT_SEL = 0, RT_GATE = 131072, RT_RANK = 262144, RT_POS = 393216, RT_ROWTOK = 524288;
constexpr size_t FWT_BYTE_OFF = 3 * MiB - 131072;
constexpr size_t RWT_BYTE_OFF = 3 * MiB;
constexpr size_t BG_Q = 0, BG_K = 64 * MiB, BG_V = 128 * MiB, BG_O = 192 * MiB, BG_M = 256 * MiB, BG_LOGF = 384 * MiB, BG_G = 385 * MiB, BG_NRM = 386 * MiB;
constexpr size_t BG_H = 0, BG_YS = 160 * MiB;
constexpr size_t BG_PROJ = 0, BG_CQ = 64 * MiB, BG_CKV = 80 * MiB, BG_KIDX = 88 * MiB, BG_WIDX = 90 * MiB, BG_NSEL = 91 * MiB, BG_QLAT = 96 * MiB, BG_QIDX = 224 * MiB, BG_SEL = 256 * MiB, BG_OLAT = 272 * MiB, BG_M2 = 400 * MiB, BG_O2 = 464 * MiB;
constexpr size_t WA_WINT = 0, WA_WOUTT = 24 * MiB;
constexpr size_t WA_WBINT = 32 * MiB, WA_WQ2T = 36 * MiB, WA_WUVOT = 44 * MiB  , WA_WOUTTB = 60 * MiB;

struct Params {
    const float *x, *a_w_in, *a_b_f, *a_w_out, *b_w_in, *b_q_norm, *b_kv_norm, *b_w_uq, *b_w_iq, *b_w_uk, *b_w_uv, *b_w_out, *rel_bias,
        *ln1_g, *ln1_b, *ln2_g, *ln2_b, *router_w, *router_b, *w_gate, *w_up, *w_down, *sh_gate, *sh_up, *sh_down;
    float* out;
    unsigned char* ws;
};

__device__ __forceinline__ unsigned cvt_pk_bf16(float lo, float hi) { unsigned r; asm volatile("v_cvt_pk_bf16_f32 %0, %1, %2" : "=v"(r) : "v"(lo), "v"(hi)); return r; }
__device__ __forceinline__ bf16x8 pack8(f32x4 a, f32x4 b) {
    u32x4 w = {cvt_pk_bf16(a[0], a[1]), cvt_pk_bf16(a[2], a[3]), cvt_pk_bf16(b[0], b[1]), cvt_pk_bf16(b[2], b[3])};
    return *reinterpret_cast<bf16x8*>(&w);
}
__device__ __forceinline__ void mfma_fence(f32x4& a) { asm volatile("s_nop 15\n\ts_nop 15" : "+v"(a)); }
__device__ __forceinline__ int tidx() { int t = (int)threadIdx.x; asm volatile("" : "+v"(t)); return t; }
__device__ __forceinline__ float bf2f(bf16_t b) { return __uint_as_float(((unsigned)b) << 16); }
__device__ __forceinline__ float wave_sum(float v) {
#pragma unroll
    for (int o = 32; o >= 1; o >>= 1) v += __shfl_xor(v, o);
    return v;
}
__device__ __forceinline__ float wave_max(float v) {
#pragma unroll
    for (int o = 32; o >= 1; o >>= 1) v = fmaxf(v, __shfl_xor(v, o));
    return v;
}

namespace pg8 {
constexpr int BM = 256, BK = 64, HALF = 128, HTB = HALF * BK * 2  , STAGE_BYTES = 8 * HTB, NXCD = 8, WGM = 8;

__host__ __device__ __forceinline__ int lds_byte(int r, int c) { const int st = (r >> 4) * 2 + (c >> 5), rr = r & 15, cc = c & 31, ob = rr * 64 + cc * 2; return st * 1024 + (ob ^ (((ob >> 9) & 1) << 5)); }
__host__ __device__ __forceinline__ void stage_rc(int b, int& R, int& C) { const int st = b / 1024, sb = b % 1024, swz = sb ^ (((sb >> 9) & 1) << 5); R = (st >> 1) * 16 + swz / 64; C = (st & 1) * 32 + (swz % 64) / 2; }
__host__ __device__ __forceinline__ int perm32(int rho) { const int n = rho >> 4, i = rho & 15; return 8 * (i >> 2) + 4 * n + (i & 3); }

struct Unit { int pm, pn, e, idx; };

struct StaticOrder {
    int nM, nN, nwg, G, c;
    __device__ void init(int M, int N, int G_, int c_) { nM = M / BM; nN = N / BM; nwg = nM * nN; G = G_; c = c_; }
    __device__ bool next(int i, Unit& u) const {
        const long L = (long)i * G + c; if (L >= nwg) return false;
        int wgid = (int)L; { const int q = nwg / NXCD, r = nwg % NXCD, xcd = wgid % NXCD, off = wgid / NXCD; wgid = (xcd < r ? xcd * (q + 1) : r * (q + 1) + (xcd - r) * q) + off; }
        const int nig = WGM * nN, gid = wgid / nig, fm = gid * WGM, gsz = (nM - fm) < WGM ? (nM - fm) : WGM;
        u.pm = fm + ((wgid % nig) % gsz); u.pn = (wgid % nig) / gsz; u.e = 0; u.idx = i; return true;
    }
};
struct DenseSched {
    const bf16_t* A; const bf16_t* Bt; int K; StaticOrder so;
    __device__ void init(const bf16_t* A_, const bf16_t* Bt_, int M, int N, int K_, int G_ = NBLK) { A = A_; Bt = Bt_; K = K_; so.init(M, N, G_, blockIdx.x); }
    __device__ __forceinline__ bool next(int i, Unit& u) const { return so.next(i, u); }
    __device__ __forceinline__ int rot() const { return 0; }
    __device__ __forceinline__ int ldk() const { return K; }
    __device__ __forceinline__ size_t kstep_a() const { return BK * 2; }
    __device__ __forceinline__ size_t kstep_b() const { return BK * 2; }
    __device__ __forceinline__ const char* a_base(const Unit& u) const { return (const char*)A + (size_t)u.pm * BM * K * 2; }
    __device__ __forceinline__ const char* b_base(const Unit& u) const { return (const char*)Bt + (size_t)u.pn * BM * K * 2; }
    __device__ __forceinline__ void a_offs(const Unit&, const int (&R)[2], const int (&C)[2], unsigned (&off)[2][2]) const {
#pragma unroll
        for (int h = 0; h < 2; ++h)
#pragma unroll
            for (int i = 0; i < 2; ++i) off[h][i] = (unsigned)((h * HALF + R[i]) * K + C[i]) * 2u;
    }
};
struct BlockDiagSched {
    const bf16_t* A; const bf16_t* Bt; int K, LD; StaticOrder so;
    __device__ void init(const bf16_t* A_, const bf16_t* Bt_, int M, int N, int K_, int LD_) { A = A_; Bt = Bt_; K = K_; LD = LD_; so.init(M, N, NBLK, blockIdx.x); }
    __device__ __forceinline__ bool next(int i, Unit& u) const { return so.next(i, u); }
    __device__ __forceinline__ int rot() const { return 0; }
    __device__ __forceinline__ int ldk() const { return LD; }
    __device__ __forceinline__ size_t kstep_a() const { return BK * 2; }
    __device__ __forceinline__ size_t kstep_b() const { return BK * 2; }
    __device__ __forceinline__ const char* a_base(const Unit& u) const { return (const char*)A + ((size_t)u.pm * BM * LD + (size_t)u.pn * K) * 2; }
    __device__ __forceinline__ const char* b_base(const Unit& u) const { return (const char*)Bt + ((size_t)u.pn * BM * LD + (size_t)u.pn * K) * 2; }
    __device__ __forceinline__ void a_offs(const Unit&, const int (&R)[2], const int (&C)[2], unsigned (&off)[2][2]) const {
#pragma unroll
        for (int h = 0; h < 2; ++h)
#pragma unroll
            for (int i = 0; i < 2; ++i) off[h][i] = (unsigned)((h * HALF + R[i]) * LD + C[i]) * 2u;
    }
};
struct MoeSchedBase {
    const unsigned* ctrl; int npn, ntiles, G, c, tpx, t0, t1, nx, lc;
    __device__ void init_base(const unsigned* ctrl_, int npn_, int part, int nconv = 0) { ctrl = ctrl_; npn = npn_; ntiles = (int)ctrl_[CW_NTILES]; G = NBLK; c = blockIdx.x;
        if ((G & 7) == 0) { const int x = c & 7; nx = (G >> 3) - nconv; lc = c >> 3; tpx = (ntiles + 7) >> 3; t0 = x * tpx; t1 = t0 + tpx < ntiles ? t0 + tpx : ntiles; if (t0 > t1) t0 = t1; }
        else { nx = G; lc = c; tpx = ntiles; t0 = 0; t1 = ntiles; }
        if (part >= 0) { const int ts = t0 + (2 * (t1 - t0) + 2) / 3; if (part == 0) t1 = ts; else t0 = ts; } }
    __device__ __forceinline__ bool next(int i, Unit& u) const {
        const int li = i * nx + lc, T = t0 + li / npn; if (T >= t1) return false;
        u.pn = li % npn; u.e = (int)ctrl[CW_TILE_E + T]; u.pm = (int)ctrl[CW_TILE_RT + T]; u.idx = i; return true;
    }
    __device__ __forceinline__ int rot() const { return 0; }
    __device__ __forceinline__ size_t kstep_a() const { return BK * 2; }
    __device__ __forceinline__ size_t kstep_b() const { return BK * 2; }
};
struct MoeGuSched : MoeSchedBase {
    const bf16_t* A; const bf16_t* Bt; const int* row_tok; int K; LAS int* rowsL;
    __device__ void init(const unsigned* ctrl_, const bf16_t* A_, const bf16_t* Bt_, const int* row_tok_, int part, LAS int* rowsL_, int nconv = 0) { init_base(ctrl_, 4, part, nconv); A = A_; Bt = Bt_; row_tok = row_tok_; K = DM; rowsL = rowsL_;
        const int tid = tidx();
        for (int i = 0; i < 15; ++i) { Unit u; if (!next(i, u)) break; if (tid < 256) rowsL[i * 256 + tid] = row_tok[(size_t)u.pm * BM + tid]; }
        asm volatile("s_waitcnt vmcnt(0) lgkmcnt(0)" ::: "memory"); __syncthreads(); }
    __device__ __forceinline__ int ldk() const { return DM; }
    __device__ __forceinline__ const char* a_base(const Unit&) const { return (const char*)A; }
    __device__ __forceinline__ const char* b_base(const Unit& u) const { return (const char*)Bt + ((size_t)u.e * 1024 + (size_t)u.pn * BM) * DM * 2; }
    __device__ __forceinline__ void a_offs(const Unit& u, const int (&R)[2], const int (&C)[2], unsigned (&off)[2][2]) const {
        const LAS int* rt = rowsL + (u.idx < 15 ? u.idx : 14) * 256;
#pragma unroll
        for (int h = 0; h < 2; ++h)
#pragma unroll
            for (int i = 0; i < 2; ++i) { const int tok = rt[h * HALF + R[i]]; off[h][i] = (unsigned)(tok * DM + C[i]) * 2u; }
    }
};
struct MoeDownSched : MoeSchedBase {
    const bf16_t* A; const bf16_t* Bt; int K;
    __device__ void init(const unsigned* ctrl_, const bf16_t* A_, const bf16_t* Bt_, int part) { init_base(ctrl_, 8, part); A = A_; Bt = Bt_; K = DEXP; }
    __device__ __forceinline__ int ldk() const { return DEXP; }
    __device__ __forceinline__ const char* a_base(const Unit& u) const { return (const char*)A + (size_t)u.pm * BM * DEXP * 2; }
    __device__ __forceinline__ const char* b_base(const Unit& u) const { return (const char*)Bt + ((size_t)u.e * DM + (size_t)u.pn * BM) * DEXP * 2; }
    __device__ __forceinline__ void a_offs(const Unit&, const int (&R)[2], const int (&C)[2], unsigned (&off)[2][2]) const {
#pragma unroll
        for (int h = 0; h < 2; ++h)
#pragma unroll
            for (int i = 0; i < 2; ++i) off[h][i] = (unsigned)((h * HALF + R[i]) * DEXP + C[i]) * 2u;
    }
};

__device__ __forceinline__ unsigned xchg1(unsigned v) { return (unsigned)__builtin_amdgcn_update_dpp(0, (int)v, 0xB1, 0xf, 0xf, false); }
__device__ __forceinline__ float xchg1f(float v) { return __uint_as_float(xchg1(__float_as_uint(v))); }
struct EpiF32 {
    static constexpr int PERM = 0;
    float* C; int ldc;
    __device__ __forceinline__ void operator()(const f32x4 (&acc)[2][2][4][2], const Unit& u, int wr, int wc, int fr, int fq) const {
        const bool odd = (fr & 1) != 0;
        const int rowe = u.pm * BM + wr * 64 + (fr & ~1), col0 = u.pn * BM + wc * 32 + (odd ? 16 : 0) + 4 * fq;
#pragma unroll
        for (int ai = 0; ai < 2; ++ai)
#pragma unroll
            for (int m = 0; m < 4; ++m) { float* rowp = C + (size_t)(rowe + ai * HALF + m * 16) * ldc + col0;
#pragma unroll
                for (int bj = 0; bj < 2; ++bj) {
                    const f32x4 v0 = acc[ai][bj][m][0], v1 = acc[ai][bj][m][1];
                    f32x4 s0, s1;
#pragma unroll
                    for (int k = 0; k < 4; ++k) { const float snd = odd ? v0[k] : v1[k]; const float rcv = xchg1f(snd); s0[k] = odd ? rcv : v0[k]; s1[k] = odd ? v1[k] : rcv; }
                    *(f32x4*)(rowp + bj * HALF) = s0; *(f32x4*)(rowp + ldc + bj * HALF) = s1; } }
    }
};
template <bool NORMS>
struct EpiBf16T {
    static constexpr int PERM = 2;
    bf16_t* O0; int ld0; bf16_t* O1; int ld1; int split0; int split_cols; size_t split_stride;
    float* nrm;
    __device__ __forceinline__ void operator()(const f32x4 (&acc)[2][2][4][2], const Unit& u, int wr, int wc, int fr, int fq) const {
        int colt = u.pn * BM; bf16_t* base = O0; int ldc = ld0;
        int qk = 2;
        if (split_cols) { const int t = colt / split_cols; base += (size_t)t * split_stride; colt -= t * split_cols; qk = t; }
        else if (colt >= split0) { base = O1; ldc = ld1; colt -= split0; }
        const bool odd = (fr & 1) != 0;
        const int col0 = colt + wc * 64 + (odd ? 32 : 0) + 8 * fq;
        const int rowe = u.pm * BM + wr * 64 + (fr & ~1);
#pragma unroll
        for (int ai = 0; ai < 2; ++ai) {
            float mx = 0.f;
#pragma unroll
            for (int m = 0; m < 4; ++m) {
                float lo[8], hi[8], e0[8], e1[8];
#pragma unroll
                for (int k = 0; k < 4; ++k) { lo[k] = acc[ai][0][m][0][k]; lo[4 + k] = acc[ai][0][m][1][k]; hi[k] = acc[ai][1][m][0][k]; hi[4 + k] = acc[ai][1][m][1][k]; }
                if constexpr (NORMS) { float sq = 0.f;
#pragma unroll
                    for (int k = 0; k < 8; ++k) { sq = fmaf(lo[k], lo[k], sq); sq = fmaf(hi[k], hi[k], sq); }
                    sq += __shfl_xor(sq, 16); sq += __shfl_xor(sq, 32); mx = fmaxf(mx, sq); }
#pragma unroll
                for (int k = 0; k < 8; ++k) { const float snd = odd ? lo[k] : hi[k]; const float rcv = xchg1f(snd); e0[k] = odd ? rcv : lo[k]; e1[k] = odd ? hi[k] : rcv; }
                u32x4 s0, s1;
                s0.x = cvt_pk_bf16(e0[0], e0[1]); s0.y = cvt_pk_bf16(e0[2], e0[3]); s0.z = cvt_pk_bf16(e0[4], e0[5]); s0.w = cvt_pk_bf16(e0[6], e0[7]);
                s1.x = cvt_pk_bf16(e1[0], e1[1]); s1.y = cvt_pk_bf16(e1[2], e1[3]); s1.z = cvt_pk_bf16(e1[4], e1[5]); s1.w = cvt_pk_bf16(e1[6], e1[7]);
                bf16_t* rp = base + (size_t)(rowe + ai * HALF + m * 16) * ldc + col0;
                *(u32x4*)rp = s0; *(u32x4*)(rp + ldc) = s1;
            }
            if constexpr (NORMS) {
                mx = fmaxf(mx, __shfl_xor(mx, 1)); mx = fmaxf(mx, __shfl_xor(mx, 2)); mx = fmaxf(mx, __shfl_xor(mx, 4)); mx = fmaxf(mx, __shfl_xor(mx, 8));
                const int Jg = u.pm * 4 + ai * 2 + wr, c = colt + wc * 64;
                if (qk < 2 && fr == 0 && fq == 0) atomicMax((unsigned*)(nrm + ((((size_t)qk * 64 + (Jg >> 6) * 16 + (c >> 7)) * 64 + (Jg & 63)) * 2 + ((c >> 6) & 1))), __float_as_uint(mx));
            }
        }
    }
};
using EpiBf16 = EpiBf16T<false>;
struct EpiFp8 {
    static constexpr int PERM = 2;
    unsigned char* O; int ldc;
    __device__ __forceinline__ void operator()(const f32x4 (&acc)[2][2][4][2], const Unit& u, int wr, int wc, int fr, int fq) const {
        const bool odd = (fr & 1) != 0;
        const int col0 = u.pn * BM + wc * 64 + (odd ? 32 : 0) + 8 * fq;
        const int rowe = u.pm * BM + wr * 64 + (fr & ~1);
#pragma unroll
        for (int ai = 0; ai < 2; ++ai)
#pragma unroll
            for (int m = 0; m < 4; ++m) {
                float lo[8], hi[8];
#pragma unroll
                for (int k = 0; k < 4; ++k) { lo[k] = __builtin_amdgcn_fmed3f(acc[ai][0][m][0][k] * 64.f, -448.f, 448.f); lo[4 + k] = __builtin_amdgcn_fmed3f(acc[ai][0][m][1][k] * 64.f, -448.f, 448.f);
                    hi[k] = __builtin_amdgcn_fmed3f(acc[ai][1][m][0][k] * 64.f, -448.f, 448.f); hi[4 + k] = __builtin_amdgcn_fmed3f(acc[ai][1][m][1][k] * 64.f, -448.f, 448.f); }
                int l0 = __builtin_amdgcn_cvt_pk_fp8_f32(lo[0], lo[1], 0, false); l0 = __builtin_amdgcn_cvt_pk_fp8_f32(lo[2], lo[3], l0, true);
                int l1 = __builtin_amdgcn_cvt_pk_fp8_f32(lo[4], lo[5], 0, false); l1 = __builtin_amdgcn_cvt_pk_fp8_f32(lo[6], lo[7], l1, true);
                int h0 = __builtin_amdgcn_cvt_pk_fp8_f32(hi[0], hi[1], 0, false); h0 = __builtin_amdgcn_cvt_pk_fp8_f32(hi[2], hi[3], h0, true);
                int h1 = __builtin_amdgcn_cvt_pk_fp8_f32(hi[4], hi[5], 0, false); h1 = __builtin_amdgcn_cvt_pk_fp8_f32(hi[6], hi[7], h1, true);
                const unsigned s0 = odd ? (unsigned)l0 : (unsigned)h0, s1 = odd ? (unsigned)l1 : (unsigned)h1;
                const unsigned r0 = xchg1(s0), r1 = xchg1(s1);
                u32x2 e0, e1;
                e0.x = odd ? r0 : (unsigned)l0; e0.y = odd ? r1 : (unsigned)l1; e1.x = odd ? (unsigned)h0 : r0; e1.y = odd ? (unsigned)h1 : r1;
                unsigned char* rp = O + (size_t)(rowe + ai * HALF + m * 16) * ldc + col0;
                *(u32x2*)rp = e0; *(u32x2*)(rp + ldc) = e1;
            }
    }
};
__device__ __forceinline__ float silu_f(float g) { return g * __builtin_amdgcn_rcpf(1.0f + __builtin_amdgcn_exp2f(-1.4426950408889634f * g)); }
struct EpiSwiGLU {
    static constexpr int PERM = 1;
    bf16_t* H;
    __device__ __forceinline__ void operator()(const f32x4 (&acc)[2][2][4][2], const Unit& u, int wr, int wc, int fr, int fq) const {
        const int row0 = u.pm * BM + wr * 64 + fr, col0 = u.pn * HALF + wc * 32 + 8 * fq;
#pragma unroll
        for (int ai = 0; ai < 2; ++ai)
#pragma unroll
            for (int m = 0; m < 4; ++m) { bf16_t* rowp = H + (size_t)(row0 + ai * HALF + m * 16) * DEXP + col0;
                const f32x4 g0 = acc[ai][0][m][0], g1 = acc[ai][0][m][1], u0 = acc[ai][1][m][0], u1 = acc[ai][1][m][1];
                u32x4 w; w.x = cvt_pk_bf16(silu_f(g0[0]) * u0[0], silu_f(g0[1]) * u0[1]); w.y = cvt_pk_bf16(silu_f(g0[2]) * u0[2], silu_f(g0[3]) * u0[3]);
                w.z = cvt_pk_bf16(silu_f(g1[0]) * u1[0], silu_f(g1[1]) * u1[1]); w.w = cvt_pk_bf16(silu_f(g1[2]) * u1[2], silu_f(g1[3]) * u1[3]);
                *(u32x4*)rowp = w; }
    }
};

template <class Epi, class Sched>
__device__ __forceinline__ void gemm_phase(LAS unsigned char* lds, const Sched& S, const Epi& E) {
    const int tid = tidx(), wid = __builtin_amdgcn_readfirstlane(tid >> 6), lane = tid & 63, wr = wid >> 2, wc = wid & 3, fr = lane & 15, fq = lane >> 4;
    const int K = S.K, nt = K / BK;
    int Rr[2], Cc[2]; unsigned voffB[2];
#pragma unroll
    for (int i = 0; i < 2; ++i) { int R, C; stage_rc(tid * 16 + i * 8192, R, C); Rr[i] = R; Cc[i] = C; const int Rb = Epi::PERM == 2 ? (64 * (R >> 5) + perm32(R & 31)) : Epi::PERM ? ((R & ~31) + perm32(R & 31)) : R; voffB[i] = (unsigned)(Rb * S.ldk() + C) * 2u; }
    const size_t kstep = (size_t)(BK * 2);
    const size_t hstep = (size_t)(Epi::PERM == 2 ? 32 : HALF) * S.ldk() * 2;
    const unsigned ldsw = (unsigned)wid * 1024u;
    const int aoff = lds_byte(wr * 64 + fr, fq * 8), boff = lds_byte(wc * 32 + fr, fq * 8);
#define PG8_SA(b, h) (((b) * 2 + (h)) * HTB)
#define PG8_SB(b, h) ((4 + (b) * 2 + (h)) * HTB)
#define PG8_STAGE(bufoff, gbase, voff) do { _Pragma("unroll") for (int _i = 0; _i < 2; ++_i) \
        __builtin_amdgcn_global_load_lds((const unsigned*)((const char*)(gbase) + (voff)[_i]), (LAS unsigned*)(lds + (bufoff) + ldsw + _i * 8192), 16, 0, 0); } while (0)
#define PG8_LDA(dst, b, h) do { _Pragma("unroll") for (int m = 0; m < 4; ++m) _Pragma("unroll") for (int k = 0; k < 2; ++k) dst[m][k] = *(const LAS bf16x8*)(lds + PG8_SA(b, h) + aoff + m * 2048 + k * 1024); } while (0)
#define PG8_LDB(dst, b, h) do { _Pragma("unroll") for (int n = 0; n < 2; ++n) _Pragma("unroll") for (int k = 0; k < 2; ++k) dst[n][k] = *(const LAS bf16x8*)(lds + PG8_SB(b, h) + boff + n * 2048 + k * 1024); } while (0)
#ifndef PG8_PRIO
#define PG8_PRIO 1
#endif
#define PG8_MMA(ai, bj, At, Bt) do { if (PG8_PRIO) __builtin_amdgcn_s_setprio(PG8_PRIO); _Pragma("unroll") for (int m = 0; m < 4; ++m) _Pragma("unroll") for (int n = 0; n < 2; ++n) _Pragma("unroll") for (int k = 0; k < 2; ++k) \
        acc[ai][bj][m][n] = __builtin_amdgcn_mfma_f32_16x16x32_bf16(Bt[n][k], At[m][k], acc[ai][bj][m][n], 0, 0, 0); if (PG8_PRIO) __builtin_amdgcn_s_setprio(0); } while (0)
#define PG8_WAIT_V(n) asm volatile("s_waitcnt vmcnt(" #n ")" ::: "memory")
#define PG8_WAIT_L(n) asm volatile("s_waitcnt lgkmcnt(" #n ")" ::: "memory")
#define PG8_BAR __builtin_amdgcn_s_barrier()
#define PG8_SCHED __builtin_amdgcn_sched_barrier(0)
    Unit cur, nxt; int ui = 0;
    if (!S.next(0, cur)) return;
    f32x4 acc[2][2][4][2];
#pragma unroll
    for (int a = 0; a < 2; ++a)
#pragma unroll
        for (int b = 0; b < 2; ++b)
#pragma unroll
            for (int m = 0; m < 4; ++m)
#pragma unroll
                for (int n = 0; n < 2; ++n) acc[a][b][m][n] = (f32x4){0.f, 0.f, 0.f, 0.f};
    bf16x8 At[4][2], B0[2][2], B1[2][2];
    unsigned offC[2][2], offN[2][2];
    S.a_offs(cur, Rr, Cc, offC);
    const char* cA = S.a_base(cur); const char* cB = S.b_base(cur);
    const int rot = S.rot() & (nt - 1), ntm = nt - 1;
    const size_t kstepA = S.kstep_a(), kstepB = S.kstep_b();
#define PG8_KOFF(t_) ((size_t)(((t_) + rot) & ntm) * kstepB)
#define PG8_KOFFA(t_) ((size_t)(((t_) + rot) & ntm) * kstepA)
    PG8_STAGE(PG8_SB(0, 0), cB + PG8_KOFF(0), voffB); PG8_STAGE(PG8_SA(0, 0), cA + PG8_KOFFA(0), offC[0]); PG8_STAGE(PG8_SB(0, 1), cB + hstep + PG8_KOFF(0), voffB); PG8_STAGE(PG8_SA(0, 1), cA + PG8_KOFFA(0), offC[1]);
    if (wr == 1) PG8_BAR;
    PG8_WAIT_V(4); PG8_BAR;
    PG8_STAGE(PG8_SB(1, 0), cB + PG8_KOFF(1), voffB); PG8_STAGE(PG8_SA(1, 0), cA + PG8_KOFFA(1), offC[0]); PG8_STAGE(PG8_SB(1, 1), cB + hstep + PG8_KOFF(1), voffB);
    PG8_WAIT_V(6); PG8_BAR;
    for (;;) {
        const bool has_next = S.next(ui + 1, nxt);
        const char* nA = has_next ? S.a_base(nxt) : cA; const char* nB = has_next ? S.b_base(nxt) : cB;
        if (has_next) S.a_offs(nxt, Rr, Cc, offN);
        else {
#pragma unroll
            for (int h = 0; h < 2; ++h)
#pragma unroll
                for (int i = 0; i < 2; ++i) offN[h][i] = offC[h][i]; }
        for (int t = 0; t < nt; t += 2) {
            const bool last = (t == nt - 2);
            const char* a1 = cA + PG8_KOFFA(t + 1);
            const char* a2 = (last ? nA : cA) + PG8_KOFFA(t + 2); const char* b2 = (last ? nB : cB) + PG8_KOFF(t + 2);
            const char* a3 = (last ? nA : cA) + PG8_KOFFA(t + 3); const char* b3 = (last ? nB : cB) + PG8_KOFF(t + 3);
            unsigned o2[2][2];
#pragma unroll
            for (int h = 0; h < 2; ++h)
#pragma unroll
                for (int i = 0; i < 2; ++i) o2[h][i] = last ? offN[h][i] : offC[h][i];
            PG8_LDB(B0, 0, 0); PG8_SCHED; PG8_LDA(At, 0, 0); PG8_STAGE(PG8_SA(1, 1), a1, offC[1]);
            PG8_WAIT_L(8); PG8_BAR; PG8_WAIT_L(0); PG8_MMA(0, 0, At, B0); PG8_BAR; PG8_SCHED;
            PG8_LDB(B1, 0, 1); PG8_STAGE(PG8_SB(0, 0), b2, voffB);
            PG8_BAR; PG8_WAIT_L(0); PG8_MMA(0, 1, At, B1); PG8_BAR;
            PG8_LDA(At, 0, 1); PG8_STAGE(PG8_SA(0, 0), a2, o2[0]);
            PG8_BAR; PG8_WAIT_L(0); PG8_MMA(1, 0, At, B0); PG8_BAR; PG8_SCHED;
            PG8_STAGE(PG8_SB(0, 1), b2 + hstep, voffB);
            PG8_WAIT_V(6); PG8_BAR; PG8_MMA(1, 1, At, B1); PG8_BAR;
            PG8_LDB(B0, 1, 0); PG8_SCHED; PG8_LDA(At, 1, 0); PG8_STAGE(PG8_SA(0, 1), a2, o2[1]);
            PG8_WAIT_L(8); PG8_BAR; PG8_WAIT_L(0); PG8_MMA(0, 0, At, B0); PG8_BAR; PG8_SCHED;
            PG8_LDB(B1, 1, 1); PG8_STAGE(PG8_SB(1, 0), b3, voffB);
            PG8_BAR; PG8_WAIT_L(0); PG8_MMA(0, 1, At, B1); PG8_BAR;
            PG8_LDA(At, 1, 1); PG8_STAGE(PG8_SA(1, 0), a3, o2[0]);
            PG8_BAR; PG8_WAIT_L(0); PG8_MMA(1, 0, At, B0); PG8_BAR; PG8_SCHED;
            PG8_STAGE(PG8_SB(1, 1), b3 + hstep, voffB);
            PG8_WAIT_V(6); PG8_BAR; PG8_MMA(1, 1, At, B1); PG8_BAR;
        }
        E(acc, cur, wr, wc, fr, fq);
        if (!has_next) break;
#pragma unroll
        for (int a = 0; a < 2; ++a)
#pragma unroll
            for (int b = 0; b < 2; ++b)
#pragma unroll
                for (int m = 0; m < 4; ++m)
#pragma unroll
                    for (int n = 0; n < 2; ++n) acc[a][b][m][n] = (f32x4){0.f, 0.f, 0.f, 0.f};
        cur = nxt; cA = nA; cB = nB; ++ui;
#pragma unroll
        for (int h = 0; h < 2; ++h)
#pragma unroll
            for (int i = 0; i < 2; ++i) offC[h][i] = offN[h][i];
    }
    PG8_WAIT_V(0);
    if (wr == 0) PG8_BAR;
    PG8_BAR;
#undef PG8_KOFF
#undef PG8_KOFFA
#undef PG8_SA
#undef PG8_SB
#undef PG8_STAGE
#undef PG8_LDA
#undef PG8_LDB
#undef PG8_MMA
#undef PG8_WAIT_V
#undef PG8_WAIT_L
#undef PG8_BAR
#undef PG8_SCHED
}
}

namespace fox {
constexpr int D = 128, LD = DM, NW = 8, QBLK = 32, KVBLK = 64, QB = NW * QBLK;
constexpr int SHM_V = KVBLK * D * 2, SHM_K = KVBLK * D * 2;
constexpr int OFF_WS = 2 * SHM_V + 2 * SHM_K, OFF_G = OFF_WS + NW * 64 * 4, GBUF = SEQ * 4, LDS_BYTES = OFF_G + 2 * GBUF;
constexpr float SCALE = 0.08838834764831845f, THR = 8.f;

#define KSWZ(row, colB) ((row) * 256 + ((colB) ^ (((row) & 7) << 4)))
#define SBAR() __builtin_amdgcn_sched_barrier(0)
__device__ __forceinline__ int v_st(int k, int c) { const int kk = (k & ~0xC) | ((k & 4) << 1) | ((k & 8) >> 1); return ((kk >> 3) * 4 + (c >> 5)) * 512 + ((kk & 7) * 32 + (c & 31)) * 2; }
__device__ __forceinline__ int v_rd_base(int lane) { return ((lane & 3) << 3) | (((lane >> 2) & 3) << 6) | (((lane >> 4) & 1) << 5) | (((lane >> 5) & 1) << 8); }
constexpr int v_rd_off(int d0, int ks, int half) { return d0 * 512 + ks * 4096 + half * 2048; }
__device__ __forceinline__ int crow(int r, int hi) { return (r & 3) + 8 * (r >> 2) + 4 * hi; }
__device__ __forceinline__ bf16x8 load8(const bf16_t* p) { return *reinterpret_cast<const bf16x8*>(p); }

__device__ __forceinline__ void mask_tile(f32x16& p0, f32x16& p1, int dq) {
    const float NEG = -__builtin_inff();
#pragma unroll
    for (int r = 0; r < 16; ++r) {
        const int c = (r & 3) + 8 * (r >> 2);
        if (dq - c < 0) p0[r] = NEG;
        if (dq - c - 32 < 0) p1[r] = NEG;
    }
}
__device__ __forceinline__ void bias_tile(f32x16& p0, f32x16& p1, const float* gl, int hi) {
#pragma unroll
    for (int j = 0; j < 4; ++j) {
        const f32x4 a = *(const f32x4*)(gl + 8 * j + 4 * hi), b = *(const f32x4*)(gl + 32 + 8 * j + 4 * hi);
#pragma unroll
        for (int i = 0; i < 4; ++i) { p0[4 * j + i] += a[i]; p1[4 * j + i] += b[i]; }
    }
}
__device__ __forceinline__ void partialSM(f32x16& p0, f32x16& p1, float& m_reg, float& mn, float& alpha) {
    float pmax = p0[0];
#pragma unroll
    for (int r = 1; r < 16; ++r) pmax = fmaxf(pmax, p0[r]);
#pragma unroll
    for (int r = 0; r < 16; ++r) pmax = fmaxf(pmax, p1[r]);
    { auto rr = __builtin_amdgcn_permlane32_swap(__float_as_uint(pmax), __float_as_uint(pmax), false, false);
      pmax = fmaxf(__uint_as_float(rr[0]), __uint_as_float(rr[1])); }
    constexpr float C2 = 1.4426950408889634f * SCALE;
    if (__builtin_expect(__all((pmax - m_reg) * SCALE <= THR), 1)) { mn = m_reg; alpha = 1.f; }
    else { mn = fmaxf(m_reg, pmax); alpha = __builtin_amdgcn_exp2f((m_reg - mn) * C2); m_reg = mn; }
    const float mnL = -mn * C2;
#pragma unroll
    for (int r = 0; r < 16; ++r) p0[r] = fmaf(p0[r], C2, mnL);
#pragma unroll
    for (int r = 0; r < 16; ++r) p1[r] = fmaf(p1[r], C2, mnL);
#pragma unroll
    for (int r = 0; r < 16; ++r) p0[r] = __builtin_amdgcn_exp2f(p0[r]);
}
__device__ __forceinline__ void finishSM(f32x16& p0, f32x16& p1, float alpha, float& l_reg, bf16x8& pa0, bf16x8& pa1, bf16x8& pa2, bf16x8& pa3) {
#pragma unroll
    for (int r = 0; r < 16; ++r) p1[r] = __builtin_amdgcn_exp2f(p1[r]);
    float ps = 0;
#pragma unroll
    for (int r = 0; r < 16; ++r) ps += p0[r];
#pragma unroll
    for (int r = 0; r < 16; ++r) ps += p1[r];
    { auto rr = __builtin_amdgcn_permlane32_swap(__float_as_uint(ps), __float_as_uint(ps), false, false);
      ps = __uint_as_float(rr[0]) + __uint_as_float(rr[1]); }
    l_reg = l_reg * alpha + ps;
#define PK4(P, B_, OUT) do { unsigned a0 = cvt_pk_bf16(P[B_+0], P[B_+1]), a1 = cvt_pk_bf16(P[B_+2], P[B_+3]);                          \
        unsigned b0 = cvt_pk_bf16(P[B_+4], P[B_+5]), b1 = cvt_pk_bf16(P[B_+6], P[B_+7]);                                             \
        auto r0 = __builtin_amdgcn_permlane32_swap(a0, b0, false, false); auto r1 = __builtin_amdgcn_permlane32_swap(a1, b1, false, false); \
        u32x4 w = {r0[0], r1[0], r0[1], r1[1]}; OUT = *reinterpret_cast<bf16x8*>(&w); } while (0)
    PK4(p0, 0, pa0); PK4(p0, 8, pa1); PK4(p1, 0, pa2); PK4(p1, 8, pa3);
#undef PK4
}
template <int KB>
__device__ __forceinline__ void qkt(f32x16& p0, f32x16& p1, const char* K_lds, int r32, int hi, const bf16x8* qr) {
    p0 = f32x16{}; p1 = f32x16{};
    const char* kb[4];
#pragma unroll
    for (int dd = 0; dd < 4; ++dd) kb[dd] = K_lds + KB * SHM_K + KSWZ(r32, (dd * 16 + hi * 8) * 2);
    if (FOX_PRIO) __builtin_amdgcn_s_setprio(1);
#pragma unroll
    for (int d0 = 0; d0 < 8; ++d0) { const char* a = kb[d0 & 3] + (d0 >> 2) * 128;
        bf16x8 b0 = *reinterpret_cast<const bf16x8*>(a);
        bf16x8 b1 = *reinterpret_cast<const bf16x8*>(a + 32 * 256);
        p0 = __builtin_amdgcn_mfma_f32_32x32x16_bf16(b0, qr[d0], p0, 0, 0, 0);
        p1 = __builtin_amdgcn_mfma_f32_32x32x16_bf16(b1, qr[d0], p1, 0, 0, 0); }
    if (FOX_PRIO) __builtin_amdgcn_s_setprio(0);
}
template <int VB>
__device__ __forceinline__ void pv_tile(f32x16* o, int vb0, bf16x8 pa0, bf16x8 pa1, bf16x8 pa2, bf16x8 pa3) {
#define TRRD(dst, off) asm volatile("ds_read_b64_tr_b16 %0, %1 offset:%2" : "=&v"(dst) : "v"(vb0), "i"(off) : "memory")
#define PV_D0(d0) do { s16x4 l0, l1, l2, l3, h0, h1, h2, h3; constexpr int b_ = VB * SHM_V + v_rd_off(d0, 0, 0);     \
        TRRD(l0, b_); TRRD(h0, b_ + 2048); TRRD(l1, b_ + 4096); TRRD(h1, b_ + 6144); TRRD(l2, b_ + 8192); TRRD(h2, b_ + 10240); TRRD(l3, b_ + 12288); TRRD(h3, b_ + 14336); \
        asm volatile("s_waitcnt lgkmcnt(0)" ::: "memory"); SBAR();                                                    \
        o[d0] = __builtin_amdgcn_mfma_f32_32x32x16_bf16(pa0, (bf16x8){l0[0], l0[1], l0[2], l0[3], h0[0], h0[1], h0[2], h0[3]}, o[d0], 0, 0, 0);   \
        o[d0] = __builtin_amdgcn_mfma_f32_32x32x16_bf16(pa1, (bf16x8){l1[0], l1[1], l1[2], l1[3], h1[0], h1[1], h1[2], h1[3]}, o[d0], 0, 0, 0);   \
        o[d0] = __builtin_amdgcn_mfma_f32_32x32x16_bf16(pa2, (bf16x8){l2[0], l2[1], l2[2], l2[3], h2[0], h2[1], h2[2], h2[3]}, o[d0], 0, 0, 0);   \
        o[d0] = __builtin_amdgcn_mfma_f32_32x32x16_bf16(pa3, (bf16x8){l3[0], l3[1], l3[2], l3[3], h3[0], h3[1], h3[2], h3[3]}, o[d0], 0, 0, 0); } while (0)
    if (FOX_PRIO) __builtin_amdgcn_s_setprio(1);
    PV_D0(0); PV_D0(1); PV_D0(2); PV_D0(3);
    if (FOX_PRIO) __builtin_amdgcn_s_setprio(0);
#undef PV_D0
#undef TRRD
}

struct BlockRef { const bf16_t* Q; const bf16_t* K; const bf16_t* V; const float* G; bf16_t* O; int P0; int jlo; };
struct Seam { bf16x8 qr[8]; bf16x8 st_v0, st_v1, st_k0, st_k1; int gsel; };
#define ROW(p, k0, rr) ((p) + (size_t)((k0) + (rr)) * LD + sc)
#define VMW() asm volatile("s_waitcnt vmcnt(0)" ::: "memory")
#define VMWN(n) asm volatile("s_waitcnt vmcnt(%0)" :: "i"(n) : "memory")
#define SLOAD_H(Kp, Vp, k0) do { S.st_v0 = load8(ROW(Vp, k0, sr)); S.st_v1 = load8(ROW(Vp, k0, 32 + sr));              \
                         S.st_k0 = load8(ROW(Kp, k0, sr)); S.st_k1 = load8(ROW(Kp, k0, 32 + sr)); } while (0)
#define SWRITE_HK(bf) do { *(bf16x8*)(K_lds + (bf) * SHM_K + kws) = S.st_k0; *(bf16x8*)(K_lds + (bf) * SHM_K + kws + 32 * 256) = S.st_k1; } while (0)
#define GDMA(Gp, gb) do { _Pragma("unroll") for (int k_ = 0; k_ < 2; ++k_) __builtin_amdgcn_global_load_lds((const unsigned*)((const char*)(Gp) + k_ * 8192 + tid * 16), \
                           (LAS unsigned*)((LAS char*)(lds_las) + OFF_G + (gb) * GBUF + k_ * 8192 + wid * 1024), 16, 0, 0); } while (0)
#define SWRITE_HV(bf) do { *(bf16x8*)(V_lds + (bf) * SHM_V + vst0) = S.st_v0; *(bf16x8*)(V_lds + (bf) * SHM_V + vst1) = S.st_v1; } while (0)
#define SWRITE_H(bf) do { SWRITE_HV(bf); SWRITE_HK(bf); } while (0)
__device__ __forceinline__ void fox_prime(const BlockRef& cur, char* lds, Seam& S) {
    const int tid = tidx(), wid = __builtin_amdgcn_readfirstlane(tid >> 6), lane = tid & 63, r32 = lane & 31, hi = lane >> 5;
    const int sr = tid >> 4, sc = (tid & 15) * 8, kws = KSWZ(sr, sc * 2); char* K_lds = lds + 2 * SHM_V; LAS char* lds_las = (LAS char*)lds;
    const int kb0 = cur.jlo * KVBLK;
    S.gsel = 0; GDMA(cur.G, 0);
#pragma unroll
    for (int d0 = 0; d0 < 8; ++d0) S.qr[d0] = load8(cur.Q + (size_t)(wid * QBLK + r32) * LD + d0 * 16 + hi * 8);
    SLOAD_H(cur.K, cur.V, kb0); VMW(); SWRITE_HK(0);
    __syncthreads();
}
__device__ __forceinline__ void fox_block(const BlockRef& cur, const BlockRef& nxt, char* lds, Seam& S) {
    const int tid = tidx(), wid = __builtin_amdgcn_readfirstlane(tid >> 6), lane = tid & 63, r32 = lane & 31, hi = lane >> 5;
    const int j_lo = cur.jlo;
    const int j_hi = (cur.P0 + QB - 1) / KVBLK + 1;
    const int NT = j_hi - j_lo;
    const int kbn = nxt.jlo * KVBLK;
    const int qlo = cur.P0 + wid * QBLK, qm = qlo + r32 - 4 * hi;
    char* V_lds = lds; char* K_lds = lds + 2 * SHM_V; LAS char* lds_las = (LAS char*)lds; const float* G_cur = (const float*)(lds + OFF_G + S.gsel * GBUF);
    float* ws = (float*)(lds + OFF_WS) + wid * 64; float* li_l = ws, * al_l = ws + 32;
    float m_reg = -1e30f, l_reg = 0; f32x16 o[4] = {};
    const int sr = tid >> 4, sc = (tid & 15) * 8, vst0 = v_st(sr, sc), vst1 = v_st(32 + sr, sc), kws = KSWZ(sr, sc * 2);
    const int vb0 = (int)(uintptr_t)V_lds + v_rd_base(lane);
    const bf16_t* Kh = cur.K; const bf16_t* Vh = cur.V;
#define RESC(a) do { if (__any((a) < 1.f)) { if (hi == 0) al_l[r32] = (a); asm volatile("s_waitcnt lgkmcnt(0)" ::: "memory");              \
                     for (int d_ = 0; d_ < 4; ++d_) for (int r = 0; r < 16; ++r) o[d_][r] *= al_l[crow(r, hi)]; } } while (0)
#define KBASE(t) ((j_lo + (t)) * KVBLK)
#define BIASMASK(P0_, P1_, t, KB) do { const int kb_ = KBASE(t); bias_tile(P0_, P1_, G_cur + kb_, hi); if (kb_ + KVBLK - 1 > qlo) mask_tile(P0_, P1_, qm - kb_); } while (0)
    constexpr int NQL = 8;
#define SEAM_K0() do { VMWN(NQL); SWRITE_HK(0); SBAR(); } while (0)
    f32x16 pA0, pA1, pB0, pB1; float mnA, mnB, alA, alB; bf16x8 pa0, pa1, pa2, pa3;
    SWRITE_HV(0); SBAR();
    if (NT > 1) { SLOAD_H(Kh, Vh, KBASE(1)); }
    SBAR(); qkt<0>(pA0, pA1, K_lds, r32, hi, S.qr);
    BIASMASK(pA0, pA1, 0, 0); partialSM(pA0, pA1, m_reg, mnA, alA);
    if (NT > 1) { VMW(); SWRITE_H(1); }
    __syncthreads();
#define HALF_STEP(PX0, PX1, mnX, alX, PY0, PY1, alY, t, KB, VB, SB) do {                                                      \
        SBAR(); qkt<KB>(PX0, PX1, K_lds, r32, hi, S.qr);                                                         \
        finishSM(PY0, PY1, alY, l_reg, pa0, pa1, pa2, pa3); SBAR();                                                           \
        if ((t) + 1 < NT) { SLOAD_H(Kh, Vh, KBASE((t) + 1)); SBAR(); }                                                    \
        pv_tile<VB>(o, vb0, pa0, pa1, pa2, pa3); BIASMASK(PX0, PX1, (t), KB); partialSM(PX0, PX1, m_reg, mnX, alX);          \
        __syncthreads();                                                                                                      \
        if ((t) + 1 < NT) { VMW(); SWRITE_H(SB); }                                                                            \
        RESC(alX); __syncthreads(); } while (0)
    for (int t = 1; t + 1 < NT; t += 2) {
        HALF_STEP(pB0, pB1, mnB, alB, pA0, pA1, alA, t, 1, 0, 0);
        HALF_STEP(pA0, pA1, mnA, alA, pB0, pB1, alB, t + 1, 0, 1, 1);
    }
    const bool even = (NT & 1) == 0;
    if (even) { SBAR(); qkt<1>(pB0, pB1, K_lds, r32, hi, S.qr); SBAR(); }
    GDMA(nxt.G, S.gsel ^ 1); SLOAD_H(nxt.K, nxt.V, kbn); SBAR();
#pragma unroll
    for (int d0 = 0; d0 < 8; ++d0) S.qr[d0] = load8(nxt.Q + (size_t)(wid * QBLK + r32) * LD + d0 * 16 + hi * 8);
    SBAR();
    finishSM(pA0, pA1, alA, l_reg, pa0, pa1, pa2, pa3); SBAR();
    pv_tile<0>(o, vb0, pa0, pa1, pa2, pa3);
    if (even) { BIASMASK(pB0, pB1, NT - 1, 1); partialSM(pB0, pB1, m_reg, mnB, alB); __syncthreads(); RESC(alB);
        finishSM(pB0, pB1, alB, l_reg, pa0, pa1, pa2, pa3); SBAR(); pv_tile<1>(o, vb0, pa0, pa1, pa2, pa3); }
    SBAR(); SEAM_K0();
    if (hi == 0) li_l[r32] = l_reg; asm volatile("s_waitcnt lgkmcnt(0)" ::: "memory");
    float rli[16];
#pragma unroll
    for (int r = 0; r < 16; ++r) rli[r] = __builtin_amdgcn_rcpf(li_l[crow(r, hi)]);
    int lane2 = lane; asm volatile("" : "+v"(lane2));
    const int r32b = lane2 & 31, hib = lane2 >> 5;
    bf16_t* Ow = cur.O + (size_t)(wid * QBLK) * LD + r32b;
#pragma unroll
    for (int r = 0; r < 16; ++r) { const int orow = crow(r, hib);
#pragma unroll
        for (int d0 = 0; d0 < 4; ++d0) { const float v = o[d0][r] * rli[r];
            const float vn = __shfl_xor(v, 1);
            if ((r32b & 1) == 0) *(unsigned*)(Ow + (size_t)orow * LD + d0 * 32) = cvt_pk_bf16(v, vn); } }
    S.gsel ^= 1;
    __syncthreads();
#undef RESC
#undef KBASE
#undef BIASMASK
#undef SEAM_K0
#undef HALF_STEP
}
#undef ROW
#undef VMW
#undef VMWN
#undef SLOAD_H
#undef SWRITE_HK
#undef GDMA
#undef SWRITE_HV
#undef SWRITE_H
#undef KSWZ
#undef SBAR
}

__device__ __forceinline__ int gwave() { return blockIdx.x * NWAVES + (tidx() >> 6); }
__device__ __forceinline__ int nwave() { return NBLK * NWAVES; }

__device__ __forceinline__ void cvt_wtile(LAS unsigned char* tl, const float* src, int ld, int Nvalid, bf16_t* dst, int Kdst, int k0, int n0, int drow0, int lane) {
    const int n = n0 + lane;
    float v[64];
    if (n < Nvalid) {
        const float* sp = src + (size_t)k0 * ld + n;
#pragma unroll
        for (int k = 0; k < 64; ++k) v[k] = __builtin_nontemporal_load(sp + (size_t)k * ld);
    } else {
#pragma unroll
        for (int k = 0; k < 64; ++k) v[k] = 0.f;
    }
    LAS unsigned char* wl = tl + (tidx() >> 6) * 9216;
#pragma unroll
    for (int q = 0; q < 8; ++q) {
        u32x4 w; w.x = cvt_pk_bf16(v[8 * q], v[8 * q + 1]); w.y = cvt_pk_bf16(v[8 * q + 2], v[8 * q + 3]); w.z = cvt_pk_bf16(v[8 * q + 4], v[8 * q + 5]); w.w = cvt_pk_bf16(v[8 * q + 6], v[8 * q + 7]);
        *(LAS u32x4*)(wl + lane * 144 + q * 16) = w;
    }
    const int rr = lane >> 3, ch = lane & 7;
#pragma unroll
    for (int it = 0; it < 8; ++it) {
        const u32x4 w = *(LAS u32x4*)(wl + (it * 8 + rr) * 144 + ch * 16);
        *(u32x4*)(dst + (size_t)(drow0 + it * 8 + rr) * Kdst + k0 + ch * 8) = w;
    }
}
__device__ __forceinline__ void cvt_matrix_tile(LAS float* tl, const float* src, int ld, int K, int Nvalid, bf16_t* dst, int mode, int tile, int ntn) {
    const int kt = tile / ntn, nt_ = tile - kt * ntn, n0 = nt_ * 64;
    int drow0 = n0;
    if (mode == 1) drow0 = (n0 >> 7) * 256 + (n0 & 127);
    else if (mode == 2) drow0 = (n0 >> 7) * 256 + 128 + (n0 & 127);
    cvt_wtile((LAS unsigned char*)tl, src, ld, Nvalid, dst, K, kt * 64, n0, drow0, tidx() & 63);
}
struct CvtRef { const float* sp; size_t ld; bf16_t* dp; int Kdst; };
__device__ __forceinline__ CvtRef cvt_moe_ref(const Params& p, int L, int w, int lane) {
    bf16_t* Wgu = (bf16_t*)(p.ws + OFF_WGU + (size_t)L * MOE_LSTRIDE); bf16_t* Wd = (bf16_t*)(p.ws + OFF_WD + (size_t)L * MOE_LSTRIDE);
    int e, which, tile;
    if (w < 65 * 512) { e = w >> 9; which = (w >> 8) & 1; tile = w & 255; } else { const int v = w - 65 * 512; e = v >> 8; which = 2; tile = v & 255; }
    CvtRef c;
    if (which < 2) {
        const float* src = which == 0 ? (e < 64 ? p.w_gate + ((size_t)L * 64 + e) * DM * DEXP : p.sh_gate + (size_t)L * DM * DEXP) : (e < 64 ? p.w_up + ((size_t)L * 64 + e) * DM * DEXP : p.sh_up + (size_t)L * DM * DEXP);
        const int kt = tile >> 3, n0 = (tile & 7) * 64, drow0 = (n0 >> 7) * 256 + which * 128 + (n0 & 127);
        c.sp = src + (size_t)kt * 64 * DEXP + n0 + lane; c.ld = DEXP; c.Kdst = DM; c.dp = Wgu + (size_t)e * 1024 * DM + (size_t)drow0 * DM + kt * 64;
    } else {
        const float* src = e < 64 ? p.w_down + ((size_t)L * 64 + e) * DEXP * DM : p.sh_down + (size_t)L * DEXP * DM;
        const int kt = tile >> 5, n0 = (tile & 31) * 64;
        c.sp = src + (size_t)kt * 64 * DM + n0 + lane; c.ld = DM; c.Kdst = DEXP; c.dp = Wd + (size_t)e * DM * DEXP + (size_t)n0 * DEXP + kt * 64;
    }
    return c;
}
__device__ __forceinline__ void cvt_ld(const CvtRef& c, float (&v)[64]) {
#pragma unroll
    for (int k = 0; k < 64; ++k) v[k] = __builtin_nontemporal_load(c.sp + (size_t)k * c.ld);
}
__device__ __forceinline__ void cvt_st(const CvtRef& c, const float (&v)[64], LAS unsigned char* wl, int lane) {
#pragma unroll
    for (int q = 0; q < 8; ++q) {
        u32x4 w; w.x = cvt_pk_bf16(v[8 * q], v[8 * q + 1]); w.y = cvt_pk_bf16(v[8 * q + 2], v[8 * q + 3]); w.z = cvt_pk_bf16(v[8 * q + 4], v[8 * q + 5]); w.w = cvt_pk_bf16(v[8 * q + 6], v[8 * q + 7]);
        *(LAS u32x4*)(wl + lane * 144 + q * 16) = w;
    }
    const int rr = lane >> 3, ch = lane & 7;
#pragma unroll
    for (int it = 0; it < 8; ++it) {
        const u32x4 w = *(LAS u32x4*)(wl + (it * 8 + rr) * 144 + ch * 16);
        *(u32x4*)(c.dp + (size_t)(it * 8 + rr) * c.Kdst + ch * 8) = w;
    }
}
__device__ __forceinline__ void cvt_moe_run(const Params& p, LAS unsigned char* wl, int L, int w, const int nw, const int total, const int lane) {
    if (w >= total) return;
    float va[64], vb[64];
    CvtRef ca = cvt_moe_ref(p, L, w, lane), cb = ca;
    cvt_ld(ca, va);
    for (;;) {
        const bool hb = w + nw < total;
        cb = cvt_moe_ref(p, L, hb ? w + nw : w, lane); cvt_ld(cb, vb);
        cvt_st(ca, va, wl, lane);
        if (!hb) break;
        w += nw;
        const bool ha = w + nw < total;
        ca = cvt_moe_ref(p, L, ha ? w + nw : w, lane); cvt_ld(ca, va);
        cvt_st(cb, vb, wl, lane);
        if (!ha) break;
        w += nw;
    }
}
__device__ __forceinline__ void cvt_ld4(const CvtRef& c, int lane, f32x4 (&v)[16]) {
    const float* sp = c.sp + (size_t)(lane >> 4) * c.ld + 4 * (lane & 15);
#pragma unroll
    for (int i = 0; i < 16; ++i) v[i] = __builtin_nontemporal_load((const f32x4*)(sp + (size_t)(4 * i) * c.ld));
}
__device__ __forceinline__ void cvt_st4(const CvtRef& c, const f32x4 (&v)[16], LAS unsigned char* wl, int lane) {
    const int cq = lane & 15, r = lane >> 4;
    LAS unsigned char* wp = wl + (4 * cq + (r & 1)) * 136 + (r >> 1) * 4;
#pragma unroll
    for (int i = 0; i < 16; ++i)
#pragma unroll
        for (int jp = 0; jp < 2; ++jp) {
            const auto sw = __builtin_amdgcn_permlane16_swap(__float_as_uint(v[i][2 * jp]), __float_as_uint(v[i][2 * jp + 1]), false, false);
            *(LAS unsigned*)(wp + jp * 272 + i * 8) = cvt_pk_bf16(__uint_as_float(sw[0]), __uint_as_float(sw[1]));
        }
    const int rr = lane >> 3, ch = lane & 7;
#pragma unroll
    for (int it = 0; it < 8; ++it) {
        const u32x2 w0 = *(LAS u32x2*)(wl + (it * 8 + rr) * 136 + ch * 16), w1 = *(LAS u32x2*)(wl + (it * 8 + rr) * 136 + ch * 16 + 8);
        *(u32x4*)(c.dp + (size_t)(it * 8 + rr) * c.Kdst + ch * 8) = (u32x4){w0.x, w0.y, w1.x, w1.y};
    }
}
__device__ __forceinline__ void cvt_moe_run4(const Params& p, LAS unsigned char* wl, int L, int w, const int nw, const int total, const int lane) {
    if (w >= total) return;
    f32x4 va[16], vb[16];
    CvtRef ca = cvt_moe_ref(p, L, w, 0), cb = ca;
    cvt_ld4(ca, lane, va);
    for (;;) {
        const bool hb = w + nw < total;
        cb = cvt_moe_ref(p, L, hb ? w + nw : w, 0); cvt_ld4(cb, lane, vb);
        cvt_st4(ca, va, wl, lane);
        if (!hb) break;
        w += nw;
        const bool ha = w + nw < total;
        ca = cvt_moe_ref(p, L, ha ? w + nw : w, 0); cvt_ld4(ca, lane, va);
        cvt_st4(cb, vb, wl, lane);
        if (!ha) break;
        w += nw;
    }
}
__device__ __forceinline__ void phase_cvt_moe(const Params& p, LAS unsigned char* lds, int L, int total) {
    const int tid = tidx();
    cvt_moe_run(p, lds + (tid >> 6) * 9216, L, gwave(), nwave(), total, tid & 63);
}
__device__ __forceinline__ void phase_cvt_fox(const Params& p, LAS unsigned char* lds) {
    LAS float* tl = (LAS float*)lds;
    bf16_t* WinT = (bf16_t*)(p.ws + OFF_WA + WA_WINT); bf16_t* WoutT = (bf16_t*)(p.ws + OFF_WA + WA_WOUTT);
    const int t_in = 32 * 96, t_out = 32 * 32;
    for (int w = gwave(); w < t_in + t_out; w += nwave()) {
        if (w < t_in) cvt_matrix_tile(tl, p.a_w_in, 6160, DM, 6144, WinT, 0, w, 96);
        else cvt_matrix_tile(tl, p.a_w_out, DM, DM, DM, WoutT, 0, w - t_in, 32);
    }
    bf16_t* xb = (bf16_t*)(p.ws + OFF_XB);
    const size_t n8 = (size_t)NTOK * DM / 8, stride = (size_t)NBLK * NTHREADS;
    for (size_t i = (size_t)blockIdx.x * NTHREADS + tidx(); i < n8; i += 4 * stride) {
        f32x4 a[4], b[4];
#pragma unroll
        for (int u = 0; u < 4; ++u) { const size_t j = i + u * stride; if (j < n8) { a[u] = __builtin_nontemporal_load((const f32x4*)(p.x + j * 8)); b[u] = __builtin_nontemporal_load((const f32x4*)(p.x + j * 8 + 4)); } }
#pragma unroll
        for (int u = 0; u < 4; ++u) { const size_t j = i + u * stride; if (j < n8) *(bf16x8*)(xb + j * 8) = pack8(a[u], b[u]); }
    }
}
__device__ __forceinline__ void phase_cvt_dsa(const Params& p, LAS unsigned char* lds) {
    LAS float* tl = (LAS float*)lds;
    bf16_t* WbinT = (bf16_t*)(p.ws + OFF_WA + WA_WBINT); bf16_t* Wq2T = (bf16_t*)(p.ws + OFF_WA + WA_WQ2T); bf16_t* WoutTB = (bf16_t*)(p.ws + OFF_WA + WA_WOUTTB); bf16_t* WuvBD = (bf16_t*)(p.ws + OFF_WA + WA_WUVOT);
    const int t0 = 32 * 16, t1 = 8 * 16, t2 = 32 * 32, t3 = 16 * 8;
    for (int w = gwave(); w < t0 + t1 + t2 + t3; w += nwave()) {
        if (w < t0) cvt_matrix_tile(tl, p.b_w_in, BW, DM, BW, WbinT, 0, w, 16);
        else if (w < t0 + t1) cvt_matrix_tile(tl, p.b_w_iq, 1024, QLAT, 1024, Wq2T + (size_t)4096 * QLAT, 0, w - t0, 16);
        else if (w < t0 + t1 + t2) cvt_matrix_tile(tl, p.b_w_out, DM, DM, DM, WoutTB, 0, w - t0 - t1, 32);
        else { const int v = w - t0 - t1 - t2, h = v >> 3, kt = (v >> 1) & 3, nt_ = v & 1;
            cvt_wtile((LAS unsigned char*)tl, p.b_w_uv + (size_t)h * KVLAT * 128, 128, 128, WuvBD + (size_t)(h * 128) * 4096 + h * 256, 4096, kt * 64, nt_ * 64, nt_ * 64, tidx() & 63); }
    }
    for (int i = blockIdx.x * NTHREADS + tidx(); i < 2048 * 32; i += NBLK * NTHREADS) { const int n = i >> 5, ch = i & 31, h = n >> 7;
        *(u32x4*)(WuvBD + (size_t)n * 4096 + (h ^ 1) * 256 + ch * 8) = (u32x4){0u, 0u, 0u, 0u}; }
}
__device__ __forceinline__ bf16x8 ld8_f32(const float* p) { return pack8(*(const f32x4*)p, *(const f32x4*)(p + 4)); }
__device__ __forceinline__ void phase_wprep(const Params& p) {
    const int lane = tidx() & 63, fr = lane & 15, fq = lane >> 4;
    bf16_t* Wq2T = (bf16_t*)(p.ws + OFF_WA + WA_WQ2T);
    const int nq = 16 * 16 * 32;
    for (int w = gwave(); w < nq; w += nwave()) {
        f32x4 acc = (f32x4){0.f, 0.f, 0.f, 0.f};
        {
            const int h = w >> 9, ct = (w >> 5) & 15, lt = w & 31, c0 = ct * 16, l0 = lt * 16;
#pragma unroll
            for (int ks = 0; ks < 4; ++ks) {
                const bf16x8 a = ld8_f32(p.b_w_uq + (size_t)(l0 + fr) * 2048 + h * 128 + ks * 32 + fq * 8);
 bf16x8 b = ld8_f32(p.b_w_uk + ((size_t)h * 256 + c0 + fr) * 128 + ks * 32 + fq * 8);
                asm volatile("s_nop 7" : "+v"(b));
                acc = __builtin_amdgcn_mfma_f32_16x16x32_bf16(a, b, acc, 0, 0, 0);
            }
            mfma_fence(acc);
            u32x2 o; o.x = cvt_pk_bf16(acc[0], acc[1]); o.y = cvt_pk_bf16(acc[2], acc[3]);
            *(u32x2*)(Wq2T + (size_t)(h * 256 + c0 + fr) * QLAT + l0 + 4 * fq) = o;
        }
    }
}

__device__ __forceinline__ void phase_cvt_router(const Params& p) {
    bf16_t* rwt = (bf16_t*)(p.ws + OFF_ROUTE + RWT_BYTE_OFF);
    for (int i = blockIdx.x * NTHREADS + tidx(); i < 2 * DM * 16; i += NBLK * NTHREADS) {
        const int L = i >> 15, d = (i >> 4) & 2047, e4 = (i & 15) * 4;
        const f32x4 w = *(const f32x4*)(p.router_w + ((size_t)L * DM + d) * NEXP + e4);
#pragma unroll
        for (int k = 0; k < 4; ++k) { const unsigned h = cvt_pk_bf16(w[k], 0.f) & 0xffffu; const float lo = w[k] - __uint_as_float(h << 16);
            rwt[((size_t)L * 128 + e4 + k) * DM + d] = (bf16_t)h; rwt[((size_t)L * 128 + 64 + e4 + k) * DM + d] = (bf16_t)(cvt_pk_bf16(lo, 0.f) & 0xffffu); }
    }
}
__device__ __forceinline__ void phase_cvt_fgate(const Params& p) {
    bf16_t* fwt = (bf16_t*)(p.ws + OFF_ROUTE + FWT_BYTE_OFF);
    for (int i = blockIdx.x * NTHREADS + tidx(); i < DM * 16; i += NBLK * NTHREADS) {
        const int d = i >> 4, h = i & 15;
        const float w = p.a_w_in[(size_t)d * 6160 + 6144 + h];
        const unsigned hb = cvt_pk_bf16(w, 0.f) & 0xffffu; const float lo = w - __uint_as_float(hb << 16);
        fwt[(size_t)h * DM + d] = (bf16_t)hb; fwt[(size_t)(16 + h) * DM + d] = (bf16_t)(cvt_pk_bf16(lo, 0.f) & 0xffffu);
    }
}
__device__ __forceinline__ void phase_fgate(const Params& p) {
    const int tid = tidx(), wid = tid >> 6, lane = tid & 63, fr = lane & 15, fq = lane >> 4;
    float* logf = (float*)(p.ws + OFF_BIG + BG_LOGF); const bf16_t* fwt = (const bf16_t*)(p.ws + OFF_ROUTE + FWT_BYTE_OFF);
    if (wid >= 4) return;
    for (int g = blockIdx.x; g < NTOK / 64; g += NBLK) {
        const int tok0 = g * 64 + wid * 16;
        const float* xa = p.x + (size_t)(tok0 + fr) * DM + fq * 8;
        const bf16_t* bh = fwt + (size_t)fr * DM + fq * 8;
        f32x4 acc = (f32x4){0.f, 0.f, 0.f, 0.f};
#pragma unroll 4
        for (int ks = 0; ks < 64; ++ks) {
            const f32x4 x0 = *(const f32x4*)(xa + ks * 32), x1 = *(const f32x4*)(xa + ks * 32 + 4);
            u32x4 hw = {cvt_pk_bf16(x0[0], x0[1]), cvt_pk_bf16(x0[2], x0[3]), cvt_pk_bf16(x1[0], x1[1]), cvt_pk_bf16(x1[2], x1[3])};
            f32x4 r0, r1;
#pragma unroll
            for (int i = 0; i < 4; ++i) { r0[i] = x0[i] - __uint_as_float(i & 1 ? hw[i >> 1] & 0xffff0000u : hw[i >> 1] << 16); r1[i] = x1[i] - __uint_as_float(i & 1 ? hw[2 + (i >> 1)] & 0xffff0000u : hw[2 + (i >> 1)] << 16); }
            bf16x8 ah = *reinterpret_cast<bf16x8*>(&hw), al = pack8(r0, r1);
            asm volatile("s_nop 1" : "+v"(ah), "+v"(al));
            const bf16x8 wh = *(const bf16x8*)(bh + ks * 32), wl = *(const bf16x8*)(bh + (size_t)16 * DM + ks * 32);
            acc = __builtin_amdgcn_mfma_f32_16x16x32_bf16(ah, wh, acc, 0, 0, 0);
            acc = __builtin_amdgcn_mfma_f32_16x16x32_bf16(ah, wl, acc, 0, 0, 0);
            acc = __builtin_amdgcn_mfma_f32_16x16x32_bf16(al, wh, acc, 0, 0, 0);
        }
        const float bf = p.a_b_f[fr];
#pragma unroll
        for (int i = 0; i < 4; ++i) { const float z = acc[i] + bf; logf[(size_t)(tok0 + 4 * fq + i) * 16 + fr] = fminf(z, 0.f) - log1pf(expf(-fabsf(z))); }
    }
}
__device__ __forceinline__ void phase_scan(const Params& p, LAS unsigned char* lds) {
    const int tid = tidx(), lane = tid & 63, wid = tid >> 6;
    const float* logf = (const float*)(p.ws + OFF_BIG + BG_LOGF); float* G = (float*)(p.ws + OFF_BIG + BG_G);
    LAS float* wt = (LAS float*)lds;
    for (int bh = blockIdx.x; bh < NBATCH * NHEAD; bh += NBLK) {
        const int b = bh >> 4, h = bh & 15, s0 = tid * 8;
        float v[8]; float tot = 0.f;
#pragma unroll
        for (int j = 0; j < 8; ++j) { v[j] = logf[((size_t)b * SEQ + s0 + j) * 16 + h]; tot += v[j]; }
        float inc = tot;
#pragma unroll
        for (int o = 1; o < 64; o <<= 1) { const float y = __shfl_up(inc, o); if (lane >= o) inc += y; }
        __syncthreads();
        if (lane == 63) wt[wid] = inc;
        __syncthreads();
        float run = inc - tot;
#pragma unroll
        for (int k = 0; k < 8; ++k) run += k < wid ? wt[k] : 0.f;
        f32x4 o0, o1;
#pragma unroll
        for (int j = 0; j < 4; ++j) { run += v[j]; o0[j] = -run * 11.313708498984761f; }
#pragma unroll
        for (int j = 0; j < 4; ++j) { run += v[4 + j]; o1[j] = -run * 11.313708498984761f; }
        *(f32x4*)(G + (size_t)bh * SEQ + s0) = o0; *(f32x4*)(G + (size_t)bh * SEQ + s0 + 4) = o1;
    }
}
__device__ __forceinline__ int fox_jlo(const Params& p, int item, int pass) {
    const int bh = item >> 3, x = item & 7, qb = pass ? 15 - x : x;
    const float* G = (const float*)(p.ws + OFF_BIG + BG_G) + (size_t)bh * SEQ; const float* NRM = (const float*)(p.ws + OFF_BIG + BG_NRM);
    const int J = tidx() & 63;
    const float* nq = NRM + (size_t)bh * 128, * nk = NRM + (size_t)(64 + bh) * 128;
    float q2 = 0.f, k2 = 0.f;
#pragma unroll
    for (int i = 0; i < 4; ++i) { q2 = fmaxf(q2, nq[(4 * qb + i) * 2] + nq[(4 * qb + i) * 2 + 1]); k2 = fmaxf(k2, nk[(4 * qb + i) * 2] + nk[(4 * qb + i) * 2 + 1]); }
    const float qn = sqrtf(q2), kI = sqrtf(k2), kn = sqrtf(nk[J * 2] + nk[J * 2 + 1]);
    const float Ft0 = -G[qb * 256] * fox::SCALE, Fl = -G[64 * J + 63] * fox::SCALE;
    const float ub = fox::SCALE * qn * (kn + kI) * 1.01f + (Ft0 - Fl);
    const bool skip = (ub < -40.0f) && (64 * J + 63 < qb * 256);
    const unsigned long long keep = __ballot(!skip);
    return keep ? (int)__builtin_ctzll(keep) : 0;
}
__device__ __forceinline__ fox::BlockRef fox_ref(const Params& p, int item, int pass, int jlo) {
    const int bh = item >> 3, x = item & 7, b = bh >> 4, h = bh & 15, qb = pass ? 15 - x : x;
    const bf16_t* Q = (const bf16_t*)(p.ws + OFF_BIG + BG_Q); const bf16_t* K = (const bf16_t*)(p.ws + OFF_BIG + BG_K); const bf16_t* V = (const bf16_t*)(p.ws + OFF_BIG + BG_V);
    bf16_t* O = (bf16_t*)(p.ws + OFF_BIG + BG_O); const float* G = (const float*)(p.ws + OFF_BIG + BG_G);
    fox::BlockRef r;
    const size_t hb = (size_t)b * SEQ * DM + (size_t)h * HDIM;
    r.Q = Q + hb + (size_t)qb * 256 * DM; r.O = O + hb + (size_t)qb * 256 * DM; r.K = K + hb; r.V = V + hb; r.G = G + (size_t)bh * SEQ; r.P0 = qb * 256; r.jlo = jlo;
    return r;
}
__device__ __forceinline__ void phase_fox_attn(const Params& p, LAS unsigned char* lds_) {
    char* lds = (char*)lds_;
    const int total = NBATCH * NHEAD * 8, stride = NBLK;
    int L = blockIdx.x; if (L >= total) return;
    LAS int* jl = (LAS int*)(lds_ + fox::LDS_BYTES);
    { int slot = 0;
      for (int it = L; it < total && slot < 16; it += stride, slot += 2) { const int j0 = fox_jlo(p, it, 0), j1 = fox_jlo(p, it, 1); if (tidx() == 0) { jl[slot] = j0; jl[slot + 1] = j1; } }
      __syncthreads(); }
    int pass = 0, slot = 0;
    fox::BlockRef cur = fox_ref(p, L, 0, __builtin_amdgcn_readfirstlane(jl[0]));
    fox::Seam S;
    fox::fox_prime(cur, lds, S);
    for (;;) {
        const bool more_pass = pass == 0, more_item = L + stride < total, last = !more_pass && !more_item;
        int passn = pass + 1, Ln = L;
        if (!more_pass) { passn = 0; Ln = more_item ? L + stride : L; }
        const int slotn = last ? slot : slot + 1;
        const fox::BlockRef nxt = last ? cur : fox_ref(p, Ln, passn, __builtin_amdgcn_readfirstlane(jl[slotn & 15]));
        fox::fox_block(cur, nxt, lds, S);
        if (last) break;
        cur = nxt; pass = passn; L = Ln; slot = slotn;
    }
}

__device__ __forceinline__ void ln_row_store(float (&v)[32], const float* g, const float* bt, float* yf, bf16_t* yhi, bf16_t* ylo, int lane) {
    float s = 0.f;
#pragma unroll
    for (int i = 0; i < 32; ++i) s += v[i];
    const float mean = wave_sum(s) * (1.0f / DM);
    float q = 0.f;
#pragma unroll
    for (int i = 0; i < 32; ++i) { const float d = v[i] - mean; q += d * d; }
    const float var = wave_sum(q) * (1.0f / DM);
    const float rstd = 1.0f / sqrtf(var + LN_EPS);
#pragma unroll
    for (int j = 0; j < 4; ++j) {
        const int c = j * 512 + lane * 8;
        const f32x4 g0 = *(const f32x4*)(g + c), g1 = *(const f32x4*)(g + c + 4), b0 = *(const f32x4*)(bt + c), b1 = *(const f32x4*)(bt + c + 4);
        f32x4 y0, y1;
#pragma unroll
        for (int i = 0; i < 4; ++i) { y0[i] = (v[j * 8 + i] - mean) * rstd * g0[i] + b0[i]; y1[i] = (v[j * 8 + 4 + i] - mean) * rstd * g1[i] + b1[i]; }
        if (yf) { *(f32x4*)(yf + c) = y0; *(f32x4*)(yf + c + 4) = y1; }
        else {
            const u32x4 hw = {cvt_pk_bf16(y0[0], y0[1]), cvt_pk_bf16(y0[2], y0[3]), cvt_pk_bf16(y1[0], y1[1]), cvt_pk_bf16(y1[2], y1[3])};
            f32x4 r0, r1;
#pragma unroll
            for (int i = 0; i < 4; ++i) { r0[i] = y0[i] - __uint_as_float(i & 1 ? hw[i >> 1] & 0xffff0000u : hw[i >> 1] << 16); r1[i] = y1[i] - __uint_as_float(i & 1 ? hw[2 + (i >> 1)] & 0xffff0000u : hw[2 + (i >> 1)] << 16); }
            *(u32x4*)(yhi + c) = hw; *(bf16x8*)(ylo + c) = pack8(r0, r1);
        }
    }
}
__device__ __forceinline__ void ld_hilo8(const bf16_t* hi, const bf16_t* lo, float (&o)[8]) {
    const u32x4 h = *(const u32x4*)hi, l = *(const u32x4*)lo;
#pragma unroll
    for (int i = 0; i < 4; ++i) { o[2 * i] = __uint_as_float(h[i] << 16) + __uint_as_float(l[i] << 16); o[2 * i + 1] = __uint_as_float(h[i] & 0xffff0000u) + __uint_as_float(l[i] & 0xffff0000u); }
}
struct RawRow { u32x4 a[8]; u32x4 m[4]; };
__device__ __forceinline__ void router_ln_load(RawRow& r, int t, const bf16_t* xhi, const bf16_t* xlo, const float* xin, const bf16_t* mres, int lane) {
#pragma unroll
    for (int j = 0; j < 4; ++j) {
        const size_t o = (size_t)t * DM + j * 512 + lane * 8;
        if (xin) { r.a[2 * j] = *(const u32x4*)(xin + o); r.a[2 * j + 1] = *(const u32x4*)(xin + o + 4); }
        else { r.a[2 * j] = *(const u32x4*)(xhi + o); r.a[2 * j + 1] = *(const u32x4*)(xlo + o); }
        r.m[j] = *(const u32x4*)(mres + o);
    }
}
__device__ __forceinline__ void router_ln_finish(const RawRow& r, int t, bf16_t* xhi, bf16_t* xlo, bool f32in, const float* lng, const float* lnb, int lane) {
    float v[32];
#pragma unroll
    for (int j = 0; j < 4; ++j) {
        float a[8];
        if (f32in) {
#pragma unroll
            for (int i = 0; i < 4; ++i) { a[i] = __uint_as_float(r.a[2 * j][i]); a[4 + i] = __uint_as_float(r.a[2 * j + 1][i]); }
        } else {
            const u32x4 h = r.a[2 * j], l = r.a[2 * j + 1];
#pragma unroll
            for (int i = 0; i < 4; ++i) { a[2 * i] = __uint_as_float(h[i] << 16) + __uint_as_float(l[i] << 16); a[2 * i + 1] = __uint_as_float(h[i] & 0xffff0000u) + __uint_as_float(l[i] & 0xffff0000u); }
        }
        const u32x4 mw = r.m[j];
#pragma unroll
        for (int i = 0; i < 8; ++i) v[j * 8 + i] = ALPHA * a[i] + __uint_as_float(i & 1 ? mw[i >> 1] & 0xffff0000u : mw[i >> 1] << 16);
    }
    ln_row_store(v, lng, lnb, nullptr, xhi + (size_t)t * DM, xlo + (size_t)t * DM, lane);
}
#ifndef ROUTER_SGT
#define ROUTER_SGT 32
#endif
__device__ __forceinline__ void phase_router(const Params& p, LAS unsigned char* lds, bf16_t* xhi, bf16_t* xlo, const bf16_t* rwt, const float* rb,
                                             const float* xin, const bf16_t* mres, const float* lng, const float* lnb) {
    constexpr int SGT = ROUTER_SGT, MT = SGT / 16, RPW = SGT / 4, NLN = 64 / SGT, SPW = SGT / 4;
    LAS float* lgp = (LAS float*)lds;
    LAS float* sbl = lgp + 4 * SGT * 64;
    LAS unsigned char* flag = (LAS unsigned char*)(sbl + 4096);
    LAS int* sel_l = (LAS int*)(flag + 4096);
    LAS unsigned long long* Me = (LAS unsigned long long*)(sel_l + 512);
    unsigned* ctrl = (unsigned*)(p.ws + OFF_CTRL); int* rt = (int*)(p.ws + OFF_ROUTE);
    const int tid = tidx(), lane = tid & 63, wid = __builtin_amdgcn_readfirstlane(tid >> 6);
    const bool f32in = xin != nullptr;
    for (int g = blockIdx.x; g < NTOK / 64; g += NBLK) {
        const int tok0 = g * 64;
        __syncthreads();
        RawRow ra, rb_;
        if (wid < 4) router_ln_load(ra, tok0 + RPW * wid, xhi, xlo, xin, mres, lane);
#pragma unroll 1
        for (int st = 0; st <= NLN; ++st) {
            const int sg = st - 1;
            const int t0 = tok0 + SGT * st + RPW * wid;
            if (wid < 4) {
                if (st < NLN) {
#pragma unroll
                    for (int i = 0; i < RPW / 2; ++i) {
                        if (i & 1) { router_ln_load(ra, t0 + i + 1, xhi, xlo, xin, mres, lane); router_ln_finish(rb_, t0 + i, xhi, xlo, f32in, lng, lnb, lane); }
                        else { router_ln_load(rb_, t0 + i + 1, xhi, xlo, xin, mres, lane); router_ln_finish(ra, t0 + i, xhi, xlo, f32in, lng, lnb, lane); }
                    }
                }
            } else if (st >= 1) {
                const int fr = lane & 15, fq = lane >> 4, kq = wid - 4;
                f32x4 acc[MT][4];
#pragma unroll
                for (int mt = 0; mt < MT; ++mt)
#pragma unroll
                    for (int nt = 0; nt < 4; ++nt) acc[mt][nt] = (f32x4){0.f, 0.f, 0.f, 0.f};
                const bf16_t* xah = xhi + (size_t)(tok0 + SGT * sg + fr) * DM + kq * 512 + fq * 8; const bf16_t* xal = xlo + (size_t)(tok0 + SGT * sg + fr) * DM + kq * 512 + fq * 8;
                const bf16_t* bh = rwt + (size_t)fr * DM + kq * 512 + fq * 8;
#pragma unroll 2
                for (int ks = 0; ks < 16; ++ks) {
                    bf16x8 ah[MT], al[MT];
#pragma unroll
                    for (int mt = 0; mt < MT; ++mt) { ah[mt] = *(const bf16x8*)(xah + (size_t)(16 * mt) * DM + ks * 32); al[mt] = *(const bf16x8*)(xal + (size_t)(16 * mt) * DM + ks * 32); }
#pragma unroll
                    for (int nt = 0; nt < 4; ++nt) {
                        const bf16x8 wh = *(const bf16x8*)(bh + (size_t)(16 * nt) * DM + ks * 32), wl = *(const bf16x8*)(bh + (size_t)(64 + 16 * nt) * DM + ks * 32);
#pragma unroll
                        for (int mt = 0; mt < MT; ++mt) {
                            acc[mt][nt] = __builtin_amdgcn_mfma_f32_16x16x32_bf16(ah[mt], wh, acc[mt][nt], 0, 0, 0);
                            acc[mt][nt] = __builtin_amdgcn_mfma_f32_16x16x32_bf16(ah[mt], wl, acc[mt][nt], 0, 0, 0);
                            acc[mt][nt] = __builtin_amdgcn_mfma_f32_16x16x32_bf16(al[mt], wh, acc[mt][nt], 0, 0, 0);
                        }
                    }
                }
#pragma unroll
                for (int mt = 0; mt < MT; ++mt)
#pragma unroll
                    for (int nt = 0; nt < 4; ++nt)
#pragma unroll
                        for (int i = 0; i < 4; ++i) lgp[(kq * SGT + 16 * mt + 4 * fq + i) * 64 + 16 * nt + fr] = acc[mt][nt][i];
            }
            __syncthreads();
            if (wid < 4) {
                if (st < NLN) {
#pragma unroll
                    for (int i = RPW / 2; i < RPW; ++i) {
                        const int tn = i + 1 < RPW ? t0 + i + 1 : (st + 1 < NLN ? t0 + SGT : t0 + i);
                        if (i & 1) { router_ln_load(ra, tn, xhi, xlo, xin, mres, lane); router_ln_finish(rb_, t0 + i, xhi, xlo, f32in, lng, lnb, lane); }
                        else { router_ln_load(rb_, tn, xhi, xlo, xin, mres, lane); router_ln_finish(ra, t0 + i, xhi, xlo, f32in, lng, lnb, lane); }
                    }
                }
                asm volatile("s_waitcnt vmcnt(0)" ::: "memory");
            } else if (st >= 1) {
                const float bias = rb[lane];
                for (int q = 0; q < SPW; ++q) {
                    const int il = SPW * (wid - 4) + q, i = SGT * sg + il, t = tok0 + i;
                    const float z = (lgp[il * 64 + lane] + lgp[(SGT + il) * 64 + lane]) + (lgp[(2 * SGT + il) * 64 + lane] + lgp[(3 * SGT + il) * 64 + lane]);
                    const float score = 1.0f / (1.0f + expf(-z));
                    const float sb = score + bias;
                    sbl[i * 64 + lane] = sb;
                    int rank = 0;
#pragma unroll
                    for (int m4 = 0; m4 < 16; ++m4) { const f32x4 o = *(LAS f32x4*)(sbl + i * 64 + 4 * m4);
                        rank += (int)(o[0] > sb); rank += (int)(o[1] > sb); rank += (int)(o[2] > sb); rank += (int)(o[3] > sb); }
                    bool taken = rank < 8;
                    bool ok = __builtin_popcountll(__ballot(taken)) == 8;
#pragma unroll
                    for (int r = 0; r < 8; ++r) ok = ok && (__builtin_popcountll(__ballot(rank == r)) == 1);
                    float gsum = 0.f;
                    if (ok) {
                        const float gmine = taken ? score : 0.f;
                        gsum = wave_sum(gmine);
                        if (taken) { rt[RT_SEL + (size_t)t * 8 + rank] = lane; ((float*)rt)[RT_GATE + (size_t)t * 8 + rank] = score / gsum * ROUTED_SCALE; sel_l[i * 8 + rank] = lane; }
                    } else {
                        taken = false; int myidx = 0; float mygate = 0.f;
#pragma unroll 1
                        for (int r = 0; r < 8; ++r) {
                            float v = taken ? -__builtin_inff() : sb; int idx = lane;
#pragma unroll
                            for (int o = 32; o >= 1; o >>= 1) { const float ov = __shfl_xor(v, o); const int oi = __shfl_xor(idx, o); if (ov > v || (ov == v && oi < idx)) { v = ov; idx = oi; } }
                            const float gs = __shfl(score, idx);
                            if (lane == idx) taken = true;
                            if (lane == r) { myidx = idx; mygate = gs; }
                            gsum += gs;
                        }
                        if (lane < 8) { rt[RT_SEL + (size_t)t * 8 + lane] = myidx; ((float*)rt)[RT_GATE + (size_t)t * 8 + lane] = mygate / gsum * ROUTED_SCALE; sel_l[i * 8 + lane] = myidx; }
                    }
                    flag[i * 64 + lane] = taken ? 1 : 0;
                }
            }
            __syncthreads();
        }
        if (tid < 64) { unsigned long long M = 0ull;
            for (int i = 0; i < 64; ++i) M |= (unsigned long long)flag[i * 64 + tid] << i;
            Me[tid] = M; ctrl[CW_HIST + g * 64 + tid] = (unsigned)__builtin_popcountll(M); }
        __syncthreads();
        { const int i = tid >> 3, r = tid & 7, e = sel_l[i * 8 + r];
          const unsigned long long M = Me[e], below = (i == 0) ? 0ull : (M & ((1ull << i) - 1ull));
          rt[RT_RANK + (size_t)(tok0 + i) * 8 + r] = __builtin_popcountll(below); }
        __syncthreads();
    }
}
__device__ __forceinline__ void phase_route_pos(const Params& p, LAS unsigned char* lds) {
    LAS int* base_l = (LAS int*)lds; LAS int* cnt_l = base_l + 64; LAS int* rs_l = cnt_l + 64; LAS int* ts_l = rs_l + 64; LAS int* ntr_l = ts_l + 64; LAS int* part_l = ntr_l + 64;
    unsigned* ctrl = (unsigned*)(p.ws + OFF_CTRL); int* rt = (int*)(p.ws + OFF_ROUTE);
    const int tid = tidx(), lane = tid & 63;
    for (int g = blockIdx.x; g < NTOK / 64; g += NBLK) {
        __syncthreads();
        { const int e = tid & 63, pt = tid >> 6; int base = 0, tot = 0;
#pragma unroll 8
          for (int k = 0; k < 32; ++k) { const int gg = pt * 32 + k; const int hv = (int)ctrl[CW_HIST + gg * 64 + e]; tot += hv; base += gg < g ? hv : 0; }
          part_l[(pt * 64 + e) * 2] = base; part_l[(pt * 64 + e) * 2 + 1] = tot; }
        __syncthreads();
        if (tid < 64) { int base = 0, tot = 0;
#pragma unroll
            for (int k = 0; k < 8; ++k) { base += part_l[(k * 64 + tid) * 2]; tot += part_l[(k * 64 + tid) * 2 + 1]; }
            base_l[tid] = base; cnt_l[tid] = tot;
            const int ntl = (tot + 255) >> 8; int inc = ntl;
#pragma unroll
            for (int o = 1; o < 64; o <<= 1) { const int y = __shfl_up(inc, o); if (lane >= o) inc += y; }
            ts_l[tid] = inc - ntl; rs_l[tid] = (inc - ntl) * 256; if (tid == 63) ntr_l[0] = inc; }
        __syncthreads();
        { const int i = tid >> 3, r = tid & 7, t = g * 64 + i;
          const int e = rt[RT_SEL + (size_t)t * 8 + r], rank = rt[RT_RANK + (size_t)t * 8 + r];
          const int pos = rs_l[e] + base_l[e] + rank;
          rt[RT_POS + (size_t)t * 8 + r] = pos; rt[RT_ROWTOK + pos] = t; }
        if (tid < 64) rt[RT_ROWTOK + SH_TILE0 * 256 + g * 64 + tid] = g * 64 + tid;
        if (g < 64) { const int e = g, c = cnt_l[e], ntl = (c + 255) >> 8, padn = ntl * 256 - c, ts = ts_l[e], ntr = ntr_l[0];
            if (tid < padn) rt[RT_ROWTOK + rs_l[e] + c + tid] = 0;
            for (int k = tid; k < ntl; k += NTHREADS) { ctrl[CW_TILE_E + ts + k] = (unsigned)e; ctrl[CW_TILE_RT + ts + k] = (unsigned)(ts + k); }
            if (tid == 0) { ctrl[CW_TILE_E + ntr + g] = 64u; ctrl[CW_TILE_RT + ntr + g] = (unsigned)(SH_TILE0 + g); if (g == 0) ctrl[CW_NTILES] = (unsigned)(ntr + 64); } }
    }
}
template <bool FP8>
__device__ __forceinline__ void phase_combine_ln2(const Params& p, bf16_t* xhi, bf16_t* xlo, const float* g, const float* bt, float* yf) {
    const int lane = tidx() & 63;
    const bf16_t* Ys = (const bf16_t*)(p.ws + OFF_BIG + BG_YS); const int* rt = (const int*)(p.ws + OFF_ROUTE);
    for (int t = gwave(); t < NTOK; t += nwave()) {
        float v[32];
#pragma unroll
        for (int i = 0; i < 32; ++i) v[i] = 0.f;
        constexpr int RG = FP8 ? 5 : 3;
#pragma unroll 1
        for (int r3 = 0; r3 < (9 + RG - 1) / RG; ++r3) {
            u32x4 w[FP8 ? 1 : RG][4]; u32x2 w8[FP8 ? RG : 1][4]; float gt[RG];
#pragma unroll
            for (int q = 0; q < RG; ++q) {
                const int r = r3 * RG + q, rr = r < 8 ? r : 0;
                int pos = rt[RT_POS + (size_t)t * 8 + rr]; gt[q] = ((const float*)rt)[RT_GATE + (size_t)t * 8 + rr];
                if (r == 8) { pos = SH_TILE0 * 256 + t; gt[q] = 1.0f; }
                if (r > 8) gt[q] = 0.f;
                if constexpr (FP8) { const unsigned char* row = (const unsigned char*)Ys + (size_t)pos * DM; gt[q] *= (1.0f / 64.0f);
#pragma unroll
                    for (int j = 0; j < 4; ++j) w8[q][j] = *(const u32x2*)(row + j * 512 + lane * 8); }
                else { const bf16_t* row = Ys + (size_t)pos * DM;
#pragma unroll
                    for (int j = 0; j < 4; ++j) w[q][j] = *(const u32x4*)(row + j * 512 + lane * 8); }
            }
#pragma unroll
            for (int q = 0; q < RG; ++q)
#pragma unroll
                for (int j = 0; j < 4; ++j) {
                    if constexpr (FP8) {
                        const auto f0 = __builtin_amdgcn_cvt_pk_f32_fp8((int)w8[q][j].x, false), f1 = __builtin_amdgcn_cvt_pk_f32_fp8((int)w8[q][j].x, true), f2 = __builtin_amdgcn_cvt_pk_f32_fp8((int)w8[q][j].y, false), f3 = __builtin_amdgcn_cvt_pk_f32_fp8((int)w8[q][j].y, true);
                        v[j * 8 + 0] += gt[q] * f0[0]; v[j * 8 + 1] += gt[q] * f0[1]; v[j * 8 + 2] += gt[q] * f1[0]; v[j * 8 + 3] += gt[q] * f1[1];
                        v[j * 8 + 4] += gt[q] * f2[0]; v[j * 8 + 5] += gt[q] * f2[1]; v[j * 8 + 6] += gt[q] * f3[0]; v[j * 8 + 7] += gt[q] * f3[1];
                    } else {
#pragma unroll
                        for (int i = 0; i < 4; ++i) { v[j * 8 + 2 * i] += gt[q] * __uint_as_float(w[q][j][i] << 16); v[j * 8 + 2 * i + 1] += gt[q] * __uint_as_float(w[q][j][i] & 0xffff0000u); } } }
        }
#pragma unroll
        for (int j = 0; j < 4; ++j) { const size_t o = (size_t)t * DM + j * 512 + lane * 8;
            float a[8]; ld_hilo8(xhi + o, xlo + o, a);
#pragma unroll
            for (int i = 0; i < 8; ++i) v[j * 8 + i] += ALPHA * a[i]; }
        ln_row_store(v, g, bt, yf ? yf + (size_t)t * DM : nullptr, xhi + (size_t)t * DM, xlo + (size_t)t * DM, lane);
    }
}
__device__ __forceinline__ void phase_dsa_prep(const Params& p) {
    const int lane = tidx() & 63;
    const float* proj = (const float*)(p.ws + OFF_BIG + BG_PROJ);
    bf16_t* cq = (bf16_t*)(p.ws + OFF_BIG + BG_CQ); bf16_t* ckv = (bf16_t*)(p.ws + OFF_BIG + BG_CKV); bf16_t* kidx = (bf16_t*)(p.ws + OFF_BIG + BG_KIDX); float* widx = (float*)(p.ws + OFF_BIG + BG_WIDX);
    for (int t = gwave(); t < NTOK; t += nwave()) {
        const float* row = proj + (size_t)t * 1024;
        const f32x4 a0 = *(const f32x4*)(row + lane * 8), a1 = *(const f32x4*)(row + lane * 8 + 4);
        float s = 0.f;
#pragma unroll
        for (int i = 0; i < 4; ++i) s += a0[i] * a0[i] + a1[i] * a1[i];
        const float rq = 1.0f / sqrtf(wave_sum(s) * (1.0f / QLAT) + RMS_EPS);
        const f32x4 g0 = *(const f32x4*)(p.b_q_norm + lane * 8), g1 = *(const f32x4*)(p.b_q_norm + lane * 8 + 4);
        *(bf16x8*)(cq + (size_t)t * QLAT + lane * 8) = pack8(a0 * rq * g0, a1 * rq * g1);
        const f32x4 c0 = *(const f32x4*)(row + 512 + lane * 4);
        float s2 = 0.f;
#pragma unroll
        for (int i = 0; i < 4; ++i) s2 += c0[i] * c0[i];
        const float rk = 1.0f / sqrtf(wave_sum(s2) * (1.0f / KVLAT) + RMS_EPS);
        const f32x4 gk = *(const f32x4*)(p.b_kv_norm + lane * 4);
        const f32x4 ck = c0 * rk * gk;
        u32x2 o; o.x = cvt_pk_bf16(ck[0], ck[1]); o.y = cvt_pk_bf16(ck[2], ck[3]);
        *(u32x2*)(ckv + (size_t)t * KVLAT + lane * 4) = o;
        const float kv = row[768 + lane], kn = __shfl_down(kv, 1);
        if ((lane & 1) == 0) *(unsigned*)(kidx + (size_t)t * IDXD + lane) = cvt_pk_bf16(kv, kn);
        if (lane < 16) widx[(size_t)t * 16 + lane] = row[832 + lane] * 0.25f;
    }
}

__device__ __forceinline__ unsigned f2sortable(float v) { const unsigned b = __float_as_uint(v); return b ^ ((b >> 31) ? 0xffffffffu : 0x80000000u); }
__device__ __forceinline__ void phase_indexer(const Params& p, LAS unsigned char* lds) {
    const int tid = tidx(), wid = __builtin_amdgcn_readfirstlane(tid >> 6), lane = tid & 63, fr = lane & 15, fq = lane >> 4;
    const bf16_t* qidx = (const bf16_t*)(p.ws + OFF_BIG + BG_QIDX); const bf16_t* kidx = (const bf16_t*)(p.ws + OFF_BIG + BG_KIDX); const float* widx = (const float*)(p.ws + OFF_BIG + BG_WIDX);
    int* sel = (int*)(p.ws + OFF_BIG + BG_SEL); int* nsel = (int*)(p.ws + OFF_BIG + BG_NSEL);
    const int skey = tid >> 3, sc = tid & 7;
    const int swr = skey * 128 + ((sc ^ ((skey >> 1) & 7)) << 4);
    const int k32 = lane & 31, hi = lane >> 5;
    LAS unsigned char* rdb[4];
#pragma unroll
    for (int ks = 0; ks < 4; ++ks) rdb[ks] = lds + k32 * 128 + ((((2 * ks + hi)) ^ ((k32 >> 1) & 7)) << 4);
    for (int pr = blockIdx.x; pr < 256; pr += NBLK)
    for (int tk = 0; tk < 8; ++tk) {
        const int b = tk >> 1, pg = (tk & 1) ? 511 - pr : pr;
        const int pos = pg * 8 + wid, t = b * SEQ + pos, nchunks = (pg >> 3) + 1, kmax = nchunks * 64;
        int* selp = sel + (size_t)t * IDXTOPK;
        if (kmax <= IDXTOPK) {
#pragma unroll
            for (int k = 0; k < 4; ++k) if (lane + 64 * k < kmax) selp[lane + 64 * k] = lane + 64 * k;
            if (lane == 0) nsel[t] = kmax;
            continue;
        }
        bf16x8 qa[4];
#pragma unroll
        for (int ks = 0; ks < 4; ++ks) { qa[ks] = (bf16x8){0, 0, 0, 0, 0, 0, 0, 0}; if (k32 < 16) qa[ks] = *(const bf16x8*)(qidx + (size_t)t * 1024 + k32 * 64 + ks * 16 + hi * 8); }
        const f32x4 wA = *(const f32x4*)(widx + (size_t)t * 16 + 4 * hi), wB = *(const f32x4*)(widx + (size_t)t * 16 + 8 + 4 * hi);
        unsigned u[64];
        const bf16_t* kg = kidx + ((size_t)b * SEQ + skey) * IDXD + sc * 8;
        const int nsc = (nchunks + 3) >> 2;
        bf16x8 stg[4];
#pragma unroll
        for (int q = 0; q < 4; ++q) stg[q] = *(const bf16x8*)(kg + (size_t)q * 64 * IDXD);
        __syncthreads();
#pragma unroll
        for (int q = 0; q < 4; ++q) *(LAS bf16x8*)(lds + q * 8192 + swr) = stg[q];
        __syncthreads();
#pragma unroll
        for (int sc4 = 0; sc4 < 16; ++sc4) {
            if (sc4 < nsc) {
                if (sc4 + 1 < nsc) {
#pragma unroll
                    for (int q = 0; q < 4; ++q) stg[q] = *(const bf16x8*)(kg + (size_t)(4 * (sc4 + 1) + q) * 64 * IDXD);
                }
#pragma unroll
                for (int q = 0; q < 4; ++q) {
                    const int j = 4 * sc4 + q;
                    if (j < nchunks) {
                        float part[2];
#pragma unroll
                        for (int T2 = 0; T2 < 2; ++T2) {
                            f32x16 acc = {};
                            if (FOX_PRIO) __builtin_amdgcn_s_setprio(1);
#pragma unroll
                            for (int ks = 0; ks < 4; ++ks) {
                                const bf16x8 kf = *(const LAS bf16x8*)(rdb[ks] + (sc4 & 1) * 32768 + q * 8192 + T2 * 4096);
                                acc = __builtin_amdgcn_mfma_f32_32x32x16_bf16(qa[ks], kf, acc, 0, 0, 0);
                            }
                            if (FOX_PRIO) __builtin_amdgcn_s_setprio(0);
                            float pt = 0.f;
#pragma unroll
                            for (int r = 0; r < 4; ++r) { pt = fmaf(wA[r], __int_as_float(max(__float_as_int(acc[r]), 0)), pt); pt = fmaf(wB[r], __int_as_float(max(__float_as_int(acc[4 + r]), 0)), pt); }
                            part[T2] = pt;
                        }
                        const auto xs = __builtin_amdgcn_permlane32_swap(__float_as_uint(part[0]), __float_as_uint(part[1]), false, false);
                        const float val = hi ? part[1] + __uint_as_float(xs[0]) : part[0] + __uint_as_float(xs[1]);
                        u[j] = f2sortable(val);
                    } else u[j] = 0u;
                }
                if (sc4 + 1 < nsc) {
#pragma unroll
                    for (int q = 0; q < 4; ++q) *(LAS bf16x8*)(lds + ((sc4 + 1) & 1) * 32768 + q * 8192 + swr) = stg[q];
                    __syncthreads();
                }
            } else {
#pragma unroll
                for (int q = 0; q < 4; ++q) u[4 * sc4 + q] = 0u;
            }
        }
        unsigned thr = 0u; int c_gt = 0; bool exact = false;
        for (int bit = 31; bit >= 0; --bit) {
            const unsigned cand = thr | (1u << bit);
            int cnt = 0;
#pragma unroll
            for (int j = 0; j < 64; j += 8) {
                if (j < nchunks) {
                const unsigned long long m0 = __ballot(u[j] >= cand), m1 = __ballot(u[j + 1] >= cand), m2 = __ballot(u[j + 2] >= cand), m3 = __ballot(u[j + 3] >= cand),
                                         m4 = __ballot(u[j + 4] >= cand), m5 = __ballot(u[j + 5] >= cand), m6 = __ballot(u[j + 6] >= cand), m7 = __ballot(u[j + 7] >= cand);
                cnt += ((__builtin_popcountll(m0) + __builtin_popcountll(m1)) + (__builtin_popcountll(m2) + __builtin_popcountll(m3))) +
                       ((__builtin_popcountll(m4) + __builtin_popcountll(m5)) + (__builtin_popcountll(m6) + __builtin_popcountll(m7)));
                }
            }
            if (cnt >= IDXTOPK) thr = cand; else c_gt = cnt;
            if (cnt == IDXTOPK) { exact = true; break; }
        }
        const unsigned t_gt = exact ? thr - 1u : thr;
        const int eq_base = exact ? IDXTOPK : c_gt, quota = IDXTOPK - eq_base;
        LAS int* ssel = (LAS int*)(lds + 65536 + wid * 1024);
        int rg = 0, re = 0;
#pragma unroll
        for (int j = 0; j < 64; ++j) {
            if (j < nchunks) {
            const bool sg = u[j] > t_gt, se = u[j] == thr && !exact;
            const unsigned long long mg = __ballot(sg), me = __ballot(se);
            const int pg_ = rg + __builtin_amdgcn_mbcnt_hi((unsigned)(mg >> 32), __builtin_amdgcn_mbcnt_lo((unsigned)mg, 0u));
            const int pe_ = re + __builtin_amdgcn_mbcnt_hi((unsigned)(me >> 32), __builtin_amdgcn_mbcnt_lo((unsigned)me, 0u));
            const int key = 64 * j + 32 * hi + k32;
            if (sg) ssel[pg_] = key;
            if (se && pe_ < quota) ssel[eq_base + pe_] = key;
            rg += __builtin_popcountll(mg); re += __builtin_popcountll(me);
            }
        }
        *(u32x4*)(selp + 4 * lane) = *(LAS u32x4*)(ssel + 4 * lane);
        if (lane == 0) nsel[t] = IDXTOPK;
    }
}

__device__ __forceinline__ int t5_bucket_dev(int rel) {
    const int n = rel < 0 ? -rel : rel;
    int large = 2 + (31 - __builtin_clz((unsigned)(n * n) | 1u)); large = large > 15 ? 15 : large;
    return (rel > 0 ? 16 : 0) + (n < 8 ? n : large);
}
__device__ __forceinline__ int cg_off(int r, int c) { return r * 512 + ((c ^ ((r & 7) << 1)) << 4); }
__device__ __forceinline__ void phase_sparse_attn(const Params& p, LAS unsigned char* lds) {
    const int tid = tidx(), wid = __builtin_amdgcn_readfirstlane(tid >> 6), lane = tid & 63, fr = lane & 15, fq = lane >> 4;
    LAS unsigned char* cgl = lds + wid * 16384;
    LAS float* rbl = (LAS float*)(lds + 131072);
    LAS int* qctr = (LAS int*)(lds + 133120 + 8 * 1280);
    if (tid == 0) *qctr = 0;
    if (tid < 512) rbl[tid] = p.rel_bias[tid] * 1.4426950408889634f;
    __syncthreads();
    if (wid >= NWAVES - SPA_CW) { cvt_moe_run4(p, cgl, 1, CVT1_SPLIT + blockIdx.x * SPA_CW + (wid - (NWAVES - SPA_CW)), NBLK * SPA_CW, 65 * 768 - CVT0_GU, lane); }
    else {
    const bf16_t* qlat = (const bf16_t*)(p.ws + OFF_BIG + BG_QLAT); const bf16_t* ckv = (const bf16_t*)(p.ws + OFF_BIG + BG_CKV);
    const int* sel = (const int*)(p.ws + OFF_BIG + BG_SEL); const int* nsel = (const int*)(p.ws + OFF_BIG + BG_NSEL);
    bf16_t* olat = (bf16_t*)(p.ws + OFF_BIG + BG_OLAT);
    const int hr = lane >> 5, hc = lane & 31;
    const int q4 = fr >> 2, p4 = fr & 3;
    const int trbase = (int)(uintptr_t)cgl;
    LAS unsigned char* qkb[4]; int trb[8];
#pragma unroll
    for (int jj = 0; jj < 4; ++jj) qkb[jj] = cgl + cg_off(fr, 4 * jj + fq);
#pragma unroll
    for (int m = 0; m < 8; ++m) trb[m] = trbase + cg_off(4 * fq + q4, 2 * m + (p4 >> 1)) + (p4 & 1) * 8;
    LAS int* ssel = (LAS int*)(lds + 133120 + wid * 1280);
    LAS int* bkt = ssel + 256;
    for (;;) {
        int qk = 0; if (lane == 0) qk = __atomic_fetch_add(qctr, 1, __ATOMIC_RELAXED);
        qk = __builtin_amdgcn_readfirstlane(qk); if (qk >= 64) break;
        const int t = blockIdx.x * 8 + (qk & 7) + NBLK * 8 * (qk >> 3);
        const int b = t >> 12, pos = t & 4095, ns = __builtin_amdgcn_readfirstlane(nsel[t]), nch = ns >> 5;
        const int* selp = sel + (size_t)t * IDXTOPK;
        *(LAS u32x4*)(ssel + 4 * lane) = *(const u32x4*)(selp + 4 * lane);
        bf16x8 qb[8];
#pragma unroll
        for (int j = 0; j < 8; ++j) qb[j] = *(const bf16x8*)(qlat + (size_t)t * 4096 + fr * 256 + j * 32 + fq * 8);
        f32x4 acc[16];
#pragma unroll
        for (int n = 0; n < 16; ++n) acc[n] = (f32x4){0.f, 0.f, 0.f, 0.f};
        float mrun = -1e30f, lsum = 0.f;
        const bf16_t* ckb = ckv + (size_t)b * SEQ * KVLAT + hc * 8;
        bf16x8 st[16];
#pragma unroll
        for (int it = 0; it < 16; ++it) { const int key = ssel[2 * it + hr]; st[it] = *(const bf16x8*)(ckb + (size_t)key * KVLAT); }
        for (int ch = 0; ch < nch; ++ch) {
#pragma unroll
            for (int it = 0; it < 16; ++it) *(LAS bf16x8*)(cgl + cg_off(2 * it + hr, hc)) = st[it];
            if (ch + 1 < nch) {
#pragma unroll
                for (int it = 0; it < 16; ++it) { const int key = ssel[(ch + 1) * 32 + 2 * it + hr]; st[it] = *(const bf16x8*)(ckb + (size_t)key * KVLAT); }
            }
            if (lane < 32) bkt[lane] = t5_bucket_dev(ssel[ch * 32 + lane] - pos) * 16;
            f32x4 s0 = (f32x4){0.f, 0.f, 0.f, 0.f}, s1 = (f32x4){0.f, 0.f, 0.f, 0.f};
#pragma unroll
            for (int j = 0; j < 8; ++j) {
                const bf16x8 a0 = *(const LAS bf16x8*)(qkb[j & 3] + (j >> 2) * 256);
                const bf16x8 a1 = *(const LAS bf16x8*)(qkb[j & 3] + (j >> 2) * 256 + 8192);
                s0 = __builtin_amdgcn_mfma_f32_16x16x32_bf16(a0, qb[j], s0, 0, 0, 0);
                s1 = __builtin_amdgcn_mfma_f32_16x16x32_bf16(a1, qb[j], s1, 0, 0, 0);
            }
            const u32x4 bo0 = *(LAS u32x4*)(bkt + 4 * fq), bo1 = *(LAS u32x4*)(bkt + 16 + 4 * fq);
            float cmax = -1e30f;
#pragma unroll
            for (int i = 0; i < 4; ++i) {
                s0[i] = fmaf(s0[i], 0.12751743082459868f, rbl[bo0[i] + fr]);
                s1[i] = fmaf(s1[i], 0.12751743082459868f, rbl[bo1[i] + fr]);
                cmax = fmaxf(cmax, fmaxf(s0[i], s1[i]));
            }
            { const auto x16 = __builtin_amdgcn_permlane16_swap(__float_as_uint(cmax), __float_as_uint(cmax), false, false); cmax = fmaxf(__uint_as_float(x16[0]), __uint_as_float(x16[1]));
              const auto x32 = __builtin_amdgcn_permlane32_swap(__float_as_uint(cmax), __float_as_uint(cmax), false, false); cmax = fmaxf(__uint_as_float(x32[0]), __uint_as_float(x32[1])); }
            if (!__all(cmax - mrun <= 11.5f)) {
                const float mnew = fmaxf(mrun, cmax), alpha = __builtin_amdgcn_exp2f(mrun - mnew);
                mrun = mnew; lsum *= alpha;
#pragma unroll
                for (int n = 0; n < 16; ++n) acc[n] *= alpha;
            }
            float ps = 0.f;
#pragma unroll
            for (int i = 0; i < 4; ++i) { s0[i] = __builtin_amdgcn_exp2f(s0[i] - mrun); s1[i] = __builtin_amdgcn_exp2f(s1[i] - mrun); ps += s0[i] + s1[i]; }
            lsum += ps;
            u32x4 pw; pw.x = cvt_pk_bf16(s0[0], s0[1]); pw.y = cvt_pk_bf16(s0[2], s0[3]); pw.z = cvt_pk_bf16(s1[0], s1[1]); pw.w = cvt_pk_bf16(s1[2], s1[3]);
            const bf16x8 pb = *reinterpret_cast<bf16x8*>(&pw);
#define TRRD2(dst, base, off) asm volatile("ds_read_b64_tr_b16 %0, %1 offset:%2" : "=&v"(dst) : "v"(base), "i"(off) : "memory")
#define PV_4(n0) do { s16x4 l0, h0, l1, h1, l2, h2, l3, h3; \
                TRRD2(l0, trb[((n0) + 0) & 7], (((n0) + 0) >> 3) * 256); TRRD2(h0, trb[((n0) + 0) & 7], (((n0) + 0) >> 3) * 256 + 8192); \
                TRRD2(l1, trb[((n0) + 1) & 7], (((n0) + 1) >> 3) * 256); TRRD2(h1, trb[((n0) + 1) & 7], (((n0) + 1) >> 3) * 256 + 8192); \
                TRRD2(l2, trb[((n0) + 2) & 7], (((n0) + 2) >> 3) * 256); TRRD2(h2, trb[((n0) + 2) & 7], (((n0) + 2) >> 3) * 256 + 8192); \
                TRRD2(l3, trb[((n0) + 3) & 7], (((n0) + 3) >> 3) * 256); TRRD2(h3, trb[((n0) + 3) & 7], (((n0) + 3) >> 3) * 256 + 8192); \
                asm volatile("s_waitcnt lgkmcnt(0)" ::: "memory"); __builtin_amdgcn_sched_barrier(0); \
                acc[(n0) + 0] = __builtin_amdgcn_mfma_f32_16x16x32_bf16((bf16x8){l0[0], l0[1], l0[2], l0[3], h0[0], h0[1], h0[2], h0[3]}, pb, acc[(n0) + 0], 0, 0, 0); \
                acc[(n0) + 1] = __builtin_amdgcn_mfma_f32_16x16x32_bf16((bf16x8){l1[0], l1[1], l1[2], l1[3], h1[0], h1[1], h1[2], h1[3]}, pb, acc[(n0) + 1], 0, 0, 0); \
                acc[(n0) + 2] = __builtin_amdgcn_mfma_f32_16x16x32_bf16((bf16x8){l2[0], l2[1], l2[2], l2[3], h2[0], h2[1], h2[2], h2[3]}, pb, acc[(n0) + 2], 0, 0, 0); \
                acc[(n0) + 3] = __builtin_amdgcn_mfma_f32_16x16x32_bf16((bf16x8){l3[0], l3[1], l3[2], l3[3], h3[0], h3[1], h3[2], h3[3]}, pb, acc[(n0) + 3], 0, 0, 0); \
                __builtin_amdgcn_sched_barrier(0); } while (0)
            PV_4(0); PV_4(4); PV_4(8); PV_4(12);
#undef PV_4
#undef TRRD2
            asm volatile("s_waitcnt lgkmcnt(0)" ::: "memory");
        }
        float lt = lsum; lt += __shfl_xor(lt, 16); lt += __shfl_xor(lt, 32);
        const float inv = 1.0f / lt;
        bf16_t* op = olat + (size_t)t * 4096 + fr * 256 + 4 * fq;
#pragma unroll
        for (int n = 0; n < 16; ++n) { u32x2 o; o.x = cvt_pk_bf16(acc[n][0] * inv, acc[n][1] * inv); o.y = cvt_pk_bf16(acc[n][2] * inv, acc[n][3] * inv); *(u32x2*)(op + 16 * n) = o; }
    }
    }
}

#define XB_TMO      128
#define XB_XCNT(j)  (256  + 64 * (j))
#define XB_XSUB(j)  (1280 + 64 * (j))
#define XB_XGEN(j)  (2304 + 64 * (j))
#define XB_TOP      3328
#define XB_TOPGEN   3392
#define XCD_BAR_WORDS 3456
#define XB_SPIN_CAP (1u << 21)

__device__ __forceinline__ unsigned xb_ld(unsigned* p)              { return __hip_atomic_load(p, __ATOMIC_RELAXED, __HIP_MEMORY_SCOPE_AGENT); }
__device__ __forceinline__ unsigned xb_add(unsigned* p, unsigned v) { return __hip_atomic_fetch_add(p, v, __ATOMIC_RELAXED, __HIP_MEMORY_SCOPE_AGENT); }
__device__ __forceinline__ unsigned xb_xcc_id() { return (unsigned)__builtin_amdgcn_s_getreg((3 << 11) | 20) & 0xFu; }
#define XB_SPIN(cond, bar) do { unsigned _sp = 0; while (cond) { __builtin_amdgcn_s_sleep(1); \
    if ((++_sp & 255u) == 0u) { if (xb_ld(&(bar)[XB_TMO])) break; if (_sp > XB_SPIN_CAP) { atomicAdd(&(bar)[XB_TMO], 1u); break; } } } } while (0)

struct XcdBarrier {
    unsigned* bar; unsigned x;
    volatile LAS unsigned* st;
};

__device__ __forceinline__ XcdBarrier xcd_barrier_post(unsigned* bar, volatile LAS unsigned* st) {
    XcdBarrier b; b.bar = bar; b.x = xb_xcc_id(); b.st = st;
    if (threadIdx.x == 0) (void)xb_add(&bar[XB_XCNT(b.x)], 1u);
    return b;
}
__device__ __forceinline__ void xcd_barrier_complete(unsigned* bar, unsigned x, unsigned& nloc, unsigned& nx) {
    const unsigned G = gridDim.x * gridDim.y * gridDim.z;
    unsigned sum, cnt, mine, sp = 0u;
    for (;;) {
        sum = 0u; cnt = 0u; mine = 0u;
#pragma unroll
        for (unsigned j = 0; j < 16; ++j) { const unsigned c = xb_ld(&bar[XB_XCNT(j)]); sum += c; cnt += (c > 0u) ? 1u : 0u; mine = (j == x) ? c : mine; }
        if (sum == G) break;
        __builtin_amdgcn_s_sleep(1);
        if ((++sp & 255u) == 0u) { if (xb_ld(&bar[XB_TMO])) break; if (sp > XB_SPIN_CAP) { atomicAdd(&bar[XB_TMO], 1u); break; } }
    }
    nloc = mine > 0u ? mine : 1u; nx = cnt > 0u ? cnt : 1u;
}

__device__ __forceinline__ void xcd_barrier(const XcdBarrier& b) {
    asm volatile("s_waitcnt vmcnt(0)" ::: "memory");
    __syncthreads();
    if (threadIdx.x == 0) {
        unsigned* bar = b.bar;
        __builtin_amdgcn_s_waitcnt(0);
        unsigned nloc = b.st[0], nx = b.st[1];
        if (nloc == 0u) { xcd_barrier_complete(bar, b.x, nloc, nx); b.st[0] = nloc; b.st[1] = nx; }
        const unsigned old = xb_add(&bar[XB_XSUB(b.x)], 1u);
        const unsigned gen = old / nloc;
        if (old + 1u == (gen + 1u) * nloc) {
            __builtin_amdgcn_fence(__ATOMIC_RELEASE, "agent");
            asm volatile("s_waitcnt vmcnt(0)" ::: "memory");
            const unsigned og = xb_add(&bar[XB_TOP], 1u);
            const unsigned tg = og / nx;
            if (og + 1u == (tg + 1u) * nx) xb_add(&bar[XB_TOPGEN], 1u);
            else XB_SPIN(xb_ld(&bar[XB_TOPGEN]) == tg, bar);
            __builtin_amdgcn_fence(__ATOMIC_ACQUIRE, "agent");
            xb_add(&bar[XB_XGEN(b.x)], 1u);
            asm volatile("s_waitcnt vmcnt(0)" ::: "memory");
        } else {
            XB_SPIN(xb_ld(&bar[XB_XGEN(b.x)]) == gen, bar);
            __builtin_amdgcn_fence(__ATOMIC_ACQUIRE, "agent");
            asm volatile("s_waitcnt vmcnt(0)" ::: "memory");
        }
    }
    __syncthreads();
}


enum { PH_PROLOGUE = 0, PH_INPROJ_A, PH_NORMS, PH_ATTN_A, PH_OUTPROJ_A, PH_LNR_0, PH_RPOS_0, PH_GU_0, PH_DOWN_0, PH_COMB_0,
       PH_INPROJ_B, PH_DSA_PREP, PH_QPROJ_B, PH_INDEXER, PH_SPATTN, PH_UV_B, PH_OUTPROJ_B, PH_LNR_1, PH_RPOS_1, PH_GU_1, PH_DOWN_1, PH_COMB_1, PH_COUNT };

template <int PH>
__device__ __forceinline__ void run_phase(const Params& p, LAS unsigned char* lds) {
    unsigned char* ws = p.ws;
    unsigned* ctrl = (unsigned*)(ws + OFF_CTRL);
    bf16_t* xb = (bf16_t*)(ws + OFF_XB); bf16_t* xlo = (bf16_t*)(ws + OFF_X2F);
    unsigned char* big = ws + OFF_BIG;
    constexpr int LAYER = (PH >= PH_INPROJ_B) ? 1 : 0;
    if constexpr (PH == PH_PROLOGUE) {
        { float* NRM = (float*)(big + BG_NRM); for (int i = blockIdx.x * NTHREADS + tidx(); i < 2 * 64 * 64 * 2; i += NBLK * NTHREADS) NRM[i] = 0.f; }
        phase_cvt_fox(p, lds); phase_cvt_router(p); phase_cvt_fgate(p); phase_cvt_moe(p, lds, 0, CVT0_SPLIT); phase_cvt_dsa(p, lds); phase_wprep(p); phase_cvt_moe(p, lds, 1, CVT1_SPLIT);
    }
    else if constexpr (PH == PH_INPROJ_A) {
        phase_fgate(p);
        if (blockIdx.x >= NBLK - CVB) {
            const int tid = tidx();
            cvt_moe_run4(p, lds + (tid >> 6) * 9216, 0, CVT0_SPLIT + (blockIdx.x - (NBLK - CVB)) * NWAVES + (tid >> 6), CVB * NWAVES, 65 * 768 - CVT0_GU, tid & 63);
        } else {
            pg8::DenseSched S; S.init(xb, (const bf16_t*)(ws + OFF_WA + WA_WINT), NTOK, 6144, DM, NBLK - CVB);
            pg8::EpiBf16T<true> E; E.O0 = (bf16_t*)(big + BG_Q); E.ld0 = DM; E.O1 = nullptr; E.ld1 = 0; E.split0 = 0; E.split_cols = DM; E.split_stride = (size_t)NTOK * DM; E.nrm = (float*)(big + BG_NRM);
            pg8::gemm_phase(lds, S, E);
        }
    }
    else if constexpr (PH == PH_NORMS) phase_scan(p, lds);
    else if constexpr (PH == PH_ATTN_A) phase_fox_attn(p, lds);
    else if constexpr (PH == PH_OUTPROJ_A) {
        pg8::DenseSched S; S.init((const bf16_t*)(big + BG_O), (const bf16_t*)(ws + OFF_WA + WA_WOUTT), NTOK, DM, DM);
        pg8::EpiBf16 E; E.O0 = (bf16_t*)(big + BG_M); E.ld0 = DM; E.O1 = nullptr; E.ld1 = 0; E.split0 = 1 << 30; E.split_cols = 0; E.split_stride = 0;
        pg8::gemm_phase(lds, S, E);
    }
    else if constexpr (PH == PH_LNR_0) phase_router(p, lds, xb, xlo, (const bf16_t*)(ws + OFF_ROUTE + RWT_BYTE_OFF), p.router_b, p.x, (const bf16_t*)(big + BG_M), p.ln1_g, p.ln1_b);
    else if constexpr (PH == PH_LNR_1) phase_router(p, lds, xb, xlo, (const bf16_t*)(ws + OFF_ROUTE + RWT_BYTE_OFF) + (size_t)128 * DM, p.router_b + NEXP, nullptr, (const bf16_t*)(big + BG_M2), p.ln1_g + DM, p.ln1_b + DM);
    else if constexpr (PH == PH_RPOS_0 || PH == PH_RPOS_1) phase_route_pos(p, lds);
    else if constexpr (PH == PH_GU_0 || PH == PH_GU_1) {
        constexpr int NCV = GU0_CV;
        if (NCV > 0 && (int)(blockIdx.x >> 3) >= (NBLK >> 3) - NCV) {
            const int tid = tidx();
            cvt_moe_run4(p, lds + (tid >> 6) * 9216, LAYER, 65 * 768 - CVT0_GU + ((int)(blockIdx.x >> 3) - ((NBLK >> 3) - NCV)) * 64 + (int)(blockIdx.x & 7) * NWAVES + (tid >> 6), NCV * 64, 65 * 768, tid & 63);
        } else {
            pg8::MoeGuSched S; S.init(ctrl, xb, (const bf16_t*)(ws + OFF_WGU + (size_t)LAYER * MOE_LSTRIDE), (const int*)(ws + OFF_ROUTE) + RT_ROWTOK, -1, (LAS int*)(lds + pg8::STAGE_BYTES), NCV);
            pg8::EpiSwiGLU E; E.H = (bf16_t*)(big + BG_H);
            pg8::gemm_phase(lds, S, E);
        }
    }
    else if constexpr (PH == PH_DOWN_0 || PH == PH_DOWN_1) {
        pg8::MoeDownSched S; S.init(ctrl, (const bf16_t*)(big + BG_H), (const bf16_t*)(ws + OFF_WD + (size_t)LAYER * MOE_LSTRIDE), -1);
        if constexpr (PH == PH_DOWN_1 || YS0_FP8) {
            pg8::EpiFp8 E; E.O = big + BG_YS; E.ldc = DM;
            pg8::gemm_phase(lds, S, E);
        } else {
            pg8::EpiBf16 E; E.O0 = (bf16_t*)(big + BG_YS); E.ld0 = DM; E.O1 = nullptr; E.ld1 = 0; E.split0 = 1 << 30; E.split_cols = 0; E.split_stride = 0;
            pg8::gemm_phase(lds, S, E);
        }
    }
    else if constexpr (PH == PH_COMB_0) phase_combine_ln2<(YS0_FP8 != 0)>(p, xb, xlo, p.ln2_g, p.ln2_b, nullptr);
    else if constexpr (PH == PH_COMB_1) phase_combine_ln2<true>(p, xb, xlo, p.ln2_g + DM, p.ln2_b + DM, p.out);
    else if constexpr (PH == PH_INPROJ_B) {
        pg8::DenseSched S; S.init(xb, (const bf16_t*)(ws + OFF_WA + WA_WBINT), NTOK, 1024, DM);
        pg8::EpiF32 E; E.C = (float*)(big + BG_PROJ); E.ldc = 1024;
        pg8::gemm_phase(lds, S, E);
    }
    else if constexpr (PH == PH_DSA_PREP) phase_dsa_prep(p);
    else if constexpr (PH == PH_QPROJ_B) {
        pg8::DenseSched S; S.init((const bf16_t*)(big + BG_CQ), (const bf16_t*)(ws + OFF_WA + WA_WQ2T), NTOK, 5120, QLAT);
        pg8::EpiBf16 E; E.O0 = (bf16_t*)(big + BG_QLAT); E.ld0 = 4096; E.O1 = (bf16_t*)(big + BG_QIDX); E.ld1 = 1024; E.split0 = 4096; E.split_cols = 0; E.split_stride = 0;
        pg8::gemm_phase(lds, S, E);
    }
    else if constexpr (PH == PH_INDEXER) phase_indexer(p, lds);
    else if constexpr (PH == PH_SPATTN) phase_sparse_attn(p, lds);
    else if constexpr (PH == PH_UV_B) {
        pg8::BlockDiagSched S; S.init((const bf16_t*)(big + BG_OLAT), (const bf16_t*)(ws + OFF_WA + WA_WUVOT), NTOK, DM, 512, 4096);
        pg8::EpiBf16 E; E.O0 = (bf16_t*)(big + BG_O2); E.ld0 = DM; E.O1 = nullptr; E.ld1 = 0; E.split0 = 1 << 30; E.split_cols = 0; E.split_stride = 0;
        pg8::gemm_phase(lds, S, E);
    }
    else if constexpr (PH == PH_OUTPROJ_B) {
        pg8::DenseSched S; S.init((const bf16_t*)(big + BG_O2), (const bf16_t*)(ws + OFF_WA + WA_WOUTTB), NTOK, DM, DM);
        pg8::EpiBf16 E; E.O0 = (bf16_t*)(big + BG_M2); E.ld0 = DM; E.O1 = nullptr; E.ld1 = 0; E.split0 = 1 << 30; E.split_cols = 0; E.split_stride = 0;
        pg8::gemm_phase(lds, S, E);
    }
}

#ifndef MK_LAUNCHES
#define MK_LAUNCHES 1
#endif
constexpr int LDS_BAR_OFF = LDS_BYTES - 16;

template <int PH>
__device__ __forceinline__ void run_from(const Params& p, LAS unsigned char* lds, const XcdBarrier& bar) {
    run_phase<PH>(p, lds);
    if constexpr (PH + 1 < PH_COUNT) { xcd_barrier(bar); run_from<PH + 1>(p, lds, bar); }
}
__global__ void __launch_bounds__(NTHREADS, 2) k_mega(Params p) {
    extern __shared__ __attribute__((aligned(16))) unsigned char smem[];
    LAS unsigned char* lds = (LAS unsigned char*)smem;
    if (threadIdx.x == 0) *(LAS u32x4*)(lds + LDS_BAR_OFF) = (u32x4){0u, 0u, 0u, 0u};
    __syncthreads();
    const XcdBarrier bar = xcd_barrier_post((unsigned*)(p.ws + OFF_CTRL) + CW_BAR, (volatile LAS unsigned*)(lds + LDS_BAR_OFF));
    run_from<0>(p, lds, bar);
}
template <int PH>
__global__ void __launch_bounds__(NTHREADS, 2) k_phase(Params p) {
    extern __shared__ __attribute__((aligned(16))) unsigned char smem[];
    run_phase<PH>(p, (LAS unsigned char*)smem);
}
template <int PH>
static void launch_phases(const Params& p, int grid, hipStream_t stream) {
    static bool done = false;
    if (!done) { done = true; (void)hipFuncSetAttribute((const void*)k_phase<PH>, hipFuncAttributeMaxDynamicSharedMemorySize, LDS_BYTES); }
    hipLaunchKernelGGL(k_phase<PH>, dim3(grid), dim3(NTHREADS), LDS_BYTES, stream, p);
    if constexpr (PH + 1 < PH_COUNT) launch_phases<PH + 1>(p, grid, stream);
}

extern "C" void kernel_launch(void* const* d_in, const int* in_sizes, int n_in, void* d_out, int out_size, void* d_ws, size_t ws_size, hipStream_t stream) {
    if (n_in != 25 || out_size != NTOK * DM || ws_size < WS_END) { fprintf(stderr, "kernel_launch: unexpected shapes (n_in %d out %d ws %zu)\n", n_in, out_size, ws_size); return; }
    Params p{};
    const float** pp = (const float**)&p;
    for (int i = 0; i < 25; ++i) pp[i] = (const float*)d_in[i];
    p.out = (float*)d_out; p.ws = (unsigned char*)d_ws;
    static int grid = 0;
    if (!grid) {
        int dev = 0, cus = 0, per_cu = 0; (void)hipGetDevice(&dev);
        if (hipDeviceGetAttribute(&cus, hipDeviceAttributeMultiprocessorCount, dev) != hipSuccess || cus <= 0) cus = 256;
        (void)hipFuncSetAttribute((const void*)k_mega, hipFuncAttributeMaxDynamicSharedMemorySize, LDS_BYTES);
        if (hipOccupancyMaxActiveBlocksPerMultiprocessor(&per_cu, (const void*)k_mega, NTHREADS, LDS_BYTES) != hipSuccess || per_cu < 1) fprintf(stderr, "kernel_launch: occupancy query reports %d workgroups per CU\n", per_cu);
        if (cus < NBLK) fprintf(stderr, "kernel_launch: built for a %d-CU device, found %d CUs\n", NBLK, cus);
        grid = NBLK;
    }
    (void)hipMemsetAsync((char*)d_ws + OFF_CTRL, 0, CTRL_ZERO_BYTES, stream);
#if MK_LAUNCHES
    hipLaunchKernelGGL(k_mega, dim3(grid), dim3(NTHREADS), LDS_BYTES, stream, p);
#else
    launch_phases<0>(p, grid, stream);
#endif
}
```
